# Optimizing an MI355X kernel written in HIP

```python
import math
import jax, jax.numpy as jnp
from jax import lax
import numpy as np

D_MODEL = 1024
BATCH = 4
SEQ = 8192
DEPTH = 2

N_MIXERS = 2
DIFF_HEAD_DIM = 64
DIFF_HEADS = D_MODEL // (2 * DIFF_HEAD_DIM)
SB_HEAD_DIM = 64
SB_HEADS = D_MODEL // SB_HEAD_DIM
PROJ_WIDTH = 3 * D_MODEL
ROPE_THETA = 500000.0
ROPE_DIMS = DIFF_HEAD_DIM // 4
Q_BLOCK = 128
N_EXPERTS = 32
N_GROUPS = 4
EXPERTS_PER_GROUP = N_EXPERTS // N_GROUPS
TOP_K = 2
D_EXPERT = D_MODEL // 2
EXPERT_BLOCK = 256
NORM_EPS = 1e-6
N_DIFF_LAYERS = (DEPTH + 1) // 2

kernel_name = "hybrid_diffattn_stickbreak_grouped_moe"


def rms_norm(x, g):
    x32 = x.astype(jnp.float32)
    y = x32 * lax.rsqrt(jnp.mean(x32 * x32, axis=-1, keepdims=True) + NORM_EPS)
    return (y * g.astype(jnp.float32)).astype(x.dtype)


def partial_rope(x, positions):
    half = ROPE_DIMS // 2
    inv_freq = jnp.power(jnp.float32(ROPE_THETA), -jnp.arange(half, dtype=jnp.float32) * (2.0 / ROPE_DIMS))
    ang = positions.astype(jnp.float32)[..., None] * inv_freq
    ang = ang.reshape(ang.shape[:2] + (1,) * (x.ndim - 3) + (half,))
    cos, sin = jnp.cos(ang), jnp.sin(ang)
    xr = x[..., :ROPE_DIMS].astype(jnp.float32)
    x1, x2 = xr[..., :half], xr[..., half:]
    rot = jnp.concatenate([x1 * cos - x2 * sin, x2 * cos + x1 * sin], axis=-1)
    return jnp.concatenate([rot.astype(x.dtype), x[..., ROPE_DIMS:]], axis=-1)


def diff_attention(h, positions, w_in, w_out, lam, subln_g, layer_idx):
    B, S, _ = h.shape
    H, DH = DIFF_HEADS, DIFF_HEAD_DIM
    proj = h @ w_in
    q = proj[..., :D_MODEL].reshape(B, S, H, 2, DH)
    k = proj[..., D_MODEL:2 * D_MODEL].reshape(B, S, H, 2, DH)
    v = proj[..., 2 * D_MODEL:].reshape(B, S, H, 2 * DH).astype(jnp.float32)
    q = partial_rope(q, positions).astype(jnp.float32) * (DH ** -0.5)
    k = partial_rope(k, positions).astype(jnp.float32)
    lam_init = 0.8 - 0.6 * math.exp(-0.3 * layer_idx)
    lam32 = lam.astype(jnp.float32)
    lam_full = jnp.exp(jnp.sum(lam32[0] * lam32[1])) - jnp.exp(jnp.sum(lam32[2] * lam32[3])) + lam_init
    nb = S // Q_BLOCK
    qb = q.reshape(B, nb, Q_BLOCK, H, 2, DH).swapaxes(0, 1)
    key_pos = jnp.arange(S)

    def block(args):
        q_blk, i = args
        t = i * Q_BLOCK + jnp.arange(Q_BLOCK)
        causal = key_pos[None, :] <= t[:, None]
        s = jnp.einsum('bqhcd,bkhcd->bhcqk', q_blk, k)
        p = jax.nn.softmax(jnp.where(causal, s, -jnp.inf), axis=-1)
        a = p[:, :, 0] - lam_full * p[:, :, 1]
        return jnp.einsum('bhqk,bkhe->bqhe', a, v)

    o = lax.map(block, (qb, jnp.arange(nb)))
    o = o.swapaxes(0, 1).reshape(B, S, H, 2 * DH)
    o = rms_norm(o, subln_g) * (1.0 - lam_init)
    return o.reshape(B, S, D_MODEL).astype(h.dtype) @ w_out


def stick_breaking_attention(h, w_in, w_out):
    B, S, _ = h.shape
    H, DH = SB_HEADS, SB_HEAD_DIM
    proj = h @ w_in
    q = proj[..., :D_MODEL].reshape(B, S, H, DH).astype(jnp.float32) * (DH ** -0.5)
    k = proj[..., D_MODEL:2 * D_MODEL].reshape(B, S, H, DH).astype(jnp.float32)
    v = proj[..., 2 * D_MODEL:].reshape(B, S, H, DH).astype(jnp.float32)
    nb = S // Q_BLOCK
    qb = q.reshape(B, nb, Q_BLOCK, H, DH).swapaxes(0, 1)
    key_pos = jnp.arange(S)

    def block(args):
        q_blk, i = args
        t = i * Q_BLOCK + jnp.arange(Q_BLOCK)
        strict = key_pos[None, :] < t[:, None]
        z = jnp.einsum('bqhd,bkhd->bhqk', q_blk, k)
        log_beta = jax.nn.log_sigmoid(z)
        log_rest = jnp.where(strict, log_beta - z, 0.0)
        after = lax.cumsum(log_rest, axis=3, reverse=True) - log_rest
        a = jnp.where(strict, jnp.exp(log_beta + after), 0.0)
        return jnp.einsum('bhqk,bkhd->bqhd', a, v)

    o = lax.map(block, (qb, jnp.arange(nb)))
    o = o.swapaxes(0, 1).reshape(B, S, D_MODEL)
    return o.astype(h.dtype) @ w_out


def grouped_moe(h, w_router, b_router, w_gate, w_up, w_down):
    B, S, D = h.shape
    N = B * S
    E, K, EB = N_EXPERTS, TOP_K, EXPERT_BLOCK
    xf = h.reshape(N, D)
    scores = jax.nn.softmax((xf @ w_router).astype(jnp.float32), axis=-1)
    sel = scores + b_router.astype(jnp.float32)
    sel_g = sel.reshape(N, N_GROUPS, EXPERTS_PER_GROUP)
    group_score = lax.top_k(sel_g, K)[0].sum(-1)
    g_best = jnp.argmax(group_score, axis=-1)
    sel_in = jnp.take_along_axis(sel_g, g_best[:, None, None], axis=1)[:, 0]
    _, local = lax.top_k(sel_in, K)
    expert_idx = (g_best[:, None] * EXPERTS_PER_GROUP + local).astype(jnp.int32)
    gate = jnp.take_along_axis(scores, expert_idx, axis=1)
    gate = gate / jnp.sum(gate, axis=-1, keepdims=True)

    flat_e = expert_idx.reshape(-1)
    flat_w = gate.reshape(-1)
    flat_tok = jnp.arange(N * K, dtype=jnp.int32) // K
    order = jnp.argsort(flat_e)
    sorted_e = flat_e[order]
    counts = jnp.zeros((E,), jnp.int32).at[flat_e].add(1)
    padded = ((counts + EB - 1) // EB) * EB
    offs = jnp.cumsum(counts) - counts
    poffs_end = jnp.cumsum(padded)
    poffs = poffs_end - padded
    dest = poffs[sorted_e] + (jnp.arange(N * K, dtype=jnp.int32) - offs[sorted_e])
    P = N * K + E * EB
    n_blk = P // EB
    row_tok = jnp.full((P,), N, jnp.int32).at[dest].set(flat_tok[order])
    row_w = jnp.zeros((P,), jnp.float32).at[dest].set(flat_w[order])
    x_pad = jnp.concatenate([xf, jnp.zeros((1, D), xf.dtype)], axis=0)
    x_rows = x_pad[row_tok].reshape(n_blk, EB, D)
    blk_e = jnp.minimum(jnp.searchsorted(poffs_end, jnp.arange(n_blk) * EB, side='right'), E - 1)

    def expert_block(args):
        xb, e = args
        hid = jax.nn.silu(xb @ w_gate[e]) * (xb @ w_up[e])
        return hid @ w_down[e]

    y_rows = lax.map(expert_block, (x_rows, blk_e)).reshape(P, D)
    y = jax.ops.segment_sum(y_rows.astype(jnp.float32) * row_w[:, None], row_tok, num_segments=N + 1)[:N]
    return y.reshape(B, S, D).astype(h.dtype)


def setup_inputs(seed: int = 0) -> dict:
    key = jax.random.key(seed)
    ks = jax.random.split(key, 17)
    D, E, F = D_MODEL, N_EXPERTS, D_EXPERT
    nrm = jax.random.normal
    x = nrm(ks[0], (BATCH, SEQ, D), jnp.float32)
    c = nrm(ks[1], (BATCH, D), jnp.float32)
    offsets = jax.random.randint(ks[2], (BATCH, 1), 0, 4096, dtype=jnp.int32)
    positions = offsets + jnp.arange(SEQ, dtype=jnp.int32)[None, :]
    w_ada = nrm(ks[3], (DEPTH, D, 6 * D), jnp.float32) * (0.5 * D ** -0.5)
    b_ada = nrm(ks[4], (DEPTH, 6 * D), jnp.float32) * 0.02
    norm_g = 1.0 + 0.02 * nrm(ks[5], (DEPTH, 2, D), jnp.float32)
    w_in = nrm(ks[6], (DEPTH, D, PROJ_WIDTH), jnp.float32) * D ** -0.5
    w_out = nrm(ks[7], (DEPTH, D, D), jnp.float32) * D ** -0.5
    diff_lambda = nrm(ks[8], (N_DIFF_LAYERS, 4, DIFF_HEAD_DIM), jnp.float32) * 0.1
    diff_subln_g = 1.0 + 0.02 * nrm(ks[9], (N_DIFF_LAYERS, 2 * DIFF_HEAD_DIM), jnp.float32)
    w_router = nrm(ks[10], (D, E), jnp.float32) * D ** -0.5
    b_router = nrm(ks[11], (E,), jnp.float32) * 0.01
    w_gate = nrm(ks[12], (DEPTH, E, D, F), jnp.float32) * D ** -0.5
    w_up = nrm(ks[13], (DEPTH, E, D, F), jnp.float32) * D ** -0.5
    w_down = nrm(ks[14], (DEPTH, E, F, D), jnp.float32) * F ** -0.5
    final_norm_g = 1.0 + 0.02 * nrm(ks[15], (D,), jnp.float32)
    return {"x": x, "c": c, "positions": positions, "w_ada": w_ada, "b_ada": b_ada,
            "norm_g": norm_g, "w_in": w_in, "w_out": w_out, "diff_lambda": diff_lambda,
            "diff_subln_g": diff_subln_g, "w_router": w_router, "b_router": b_router,
            "w_gate": w_gate, "w_up": w_up, "w_down": w_down, "final_norm_g": final_norm_g}


def reference(x, c, positions, w_ada, b_ada, norm_g, w_in, w_out, diff_lambda, diff_subln_g,
              w_router, b_router, w_gate, w_up, w_down, final_norm_g):
    c_act = jax.nn.silu(c)
    for i in range(DEPTH):
        mod = c_act @ w_ada[i] + b_ada[i]
        sh_a, sc_a, g_a, sh_m, sc_m, g_m = jnp.split(mod, 6, axis=-1)
        h = rms_norm(x, norm_g[i, 0]) * (1.0 + sc_a[:, None]) + sh_a[:, None]
        if i % N_MIXERS == 0:
            mix = diff_attention(h, positions, w_in[i], w_out[i], diff_lambda[i // N_MIXERS],
                                 diff_subln_g[i // N_MIXERS], i)
        else:
            mix = stick_breaking_attention(h, w_in[i], w_out[i])
        x = x + g_a[:, None] * mix
        h = rms_norm(x, norm_g[i, 1]) * (1.0 + sc_m[:, None]) + sh_m[:, None]
        x = x + g_m[:, None] * grouped_moe(h, w_router, b_router, w_gate[i], w_up[i], w_down[i])
    return rms_norm(x, final_norm_g)
```

```cpp
#include <hip/hip_runtime.h>
#include <hip/hip_bf16.h>
#include <cstdio>
#include <cstdint>
#include <cmath>
namespace pg8 {
#define PG8_LAS __attribute__((address_space(3)))
typedef unsigned short bf16_t;
typedef short bf16x8 __attribute__((ext_vector_type(8)));
typedef float f32x4 __attribute__((ext_vector_type(4)));
typedef unsigned u32x4 __attribute__((ext_vector_type(4)));
constexpr int BM = 256, BK = 64, HALF = 128, HTB = HALF * BK * 2  , STAGE_BYTES = 8 * HTB, NXCD = 8, WGM = 8;

__host__ __device__ __forceinline__ int lds_byte(int r, int c) { const int st = (r >> 4) * 2 + (c >> 5), rr = r & 15, cc = c & 31, ob = rr * 64 + cc * 2; return st * 1024 + (ob ^ (((ob >> 9) & 1) << 5)); }
__host__ __device__ __forceinline__ void stage_rc(int b, int& R, int& C) { const int st = b / 1024, sb = b % 1024, swz = sb ^ (((sb >> 9) & 1) << 5); R = (st >> 1) * 16 + swz / 64; C = (st & 1) * 32 + (swz % 64) / 2; }
__host__ __device__ __forceinline__ int perm32(int rho) { const int n = rho >> 4, i = rho & 15; return 8 * (i >> 2) + 4 * n + (i & 3); }


struct Unit { int pm, pn, e, rb; };

struct StaticOrder {
    int nM, nN, nwg, G, c; const char* A; const char* Bt; int K;
    __device__ void init(const void* A_, const void* Bt_, int M, int N, int K_, int G_, int c_) { A = (const char*)A_; Bt = (const char*)Bt_; K = K_; nM = M / BM; nN = N / BM; nwg = nM * nN; G = G_; c = c_; }
    __device__ bool next(int i, Unit& u) const {
        const long L = (long)i * G + c; if (L >= nwg) return false;
        int wgid = (int)L; { const int q = nwg / NXCD, r = nwg % NXCD, xcd = wgid % NXCD, off = wgid / NXCD; wgid = (xcd < r ? xcd * (q + 1) : r * (q + 1) + (xcd - r) * q) + off; }
        const int nig = WGM * nN, gid = wgid / nig, fm = gid * WGM, gsz = (nM - fm) < WGM ? (nM - fm) : WGM;
        u.pm = fm + ((wgid % nig) % gsz); u.pn = (wgid % nig) / gsz; u.e = 0; u.rb = 0; return true;
    }
    __device__ __forceinline__ const char* a_ptr(const Unit& u) const { return A + (size_t)u.pm * ((size_t)BM * K * 2); }
    __device__ __forceinline__ const char* b_ptr(const Unit& u) const { return Bt + (size_t)u.pn * ((size_t)BM * K * 2); }
    __device__ __forceinline__ unsigned a_rowoff(const Unit&, int R) const { return (unsigned)R * (unsigned)K * 2u; }
};
template <int NPN, bool GATHER_> struct GroupedOrder {
    const PG8_LAS int* cnt; const PG8_LAS int* pre; int G, vc, K, Mtok;
    const char* A; const char* W; size_t wstride; const int* list;
    __device__ bool next(int i, Unit& u) const {
        const int total = pre[32] * NPN; const int L = i * G + vc; if (L >= total) return false;
        const int rbg = L / NPN; int e = 0;
#pragma unroll 1
        for (int j = 1; j < 32; ++j) e += (pre[j] <= rbg) ? 1 : 0;
        e = __builtin_amdgcn_readfirstlane(e);
        u.e = e; u.rb = __builtin_amdgcn_readfirstlane(rbg - pre[e]); u.pm = __builtin_amdgcn_readfirstlane(rbg); u.pn = __builtin_amdgcn_readfirstlane(L % NPN); return true;
    }
    __device__ __forceinline__ const char* a_ptr(const Unit& u) const { return GATHER_ ? A : A + (size_t)u.pm * ((size_t)BM * K * 2); }
    __device__ __forceinline__ const char* b_ptr(const Unit& u) const { return W + (size_t)u.e * wstride + (size_t)u.pn * ((size_t)BM * K * 2); }
    __device__ __forceinline__ unsigned a_rowoff(const Unit& u, int R) const {
        if (!GATHER_) return (unsigned)R * (unsigned)K * 2u;
        const int idx = u.rb * BM + R; int tok = 0; if (idx < cnt[u.e]) tok = list[(size_t)u.e * Mtok + idx] >> 1;
        return (unsigned)tok * (unsigned)K * 2u;
    }
};

__device__ __forceinline__ unsigned cvt_pk_bf16(float lo, float hi) { unsigned r; asm volatile("v_cvt_pk_bf16_f32 %0, %1, %2" : "=v"(r) : "v"(lo), "v"(hi)); return r; }
typedef float f32x2 __attribute__((ext_vector_type(2)));
__device__ __forceinline__ void sincos_rad(float ang, float& s, float& c) {
    double r = (double)ang * 0.15915494309189535; r = r - __builtin_floor(r);
    const float rf = (float)r; s = __builtin_amdgcn_sinf(rf); c = __builtin_amdgcn_cosf(rf);
}
struct EpiQKV {
    static constexpr bool PERM = true, AFTER_DRAIN = false;
    bf16_t* O; size_t split_stride; float scale0; const int* pos; int rope;
    __device__ __forceinline__ void operator()(const f32x4 (&acc)[2][2][4][2], const Unit& u, int wr, int wc, int fr, int fq) const {
        const int t = u.pn >> 2; bf16_t* base = O + (size_t)t * split_stride;
        const float sc = (t == 0) ? scale0 : 1.f;
        const int row0 = u.pm * BM + wr * 64 + fr, col0 = (u.pn & 3) * BM + wc * 32 + 8 * fq;
        const bool dorope = rope && t < 2 && (wc & 1) == 0 && fq < 2;
        const float f0 = fq ? 0.0014142135623842478f : 1.0f, f1 = fq ? 0.00027424818836152554f : 0.1939227432012558f,
                    f2 = fq ? 5.318296098266728e-05f : 0.03760603070259094f, f3 = fq ? 1.0313386155758053e-05f : 0.007292664609849453f;
#pragma unroll
        for (int ai = 0; ai < 2; ++ai)
#pragma unroll
            for (int m = 0; m < 4; ++m) { const int row = row0 + ai * HALF + m * 16; bf16_t* rowp = base + (size_t)row * 1024 + col0;
                float s0 = 0.f, s1 = 0.f, s2 = 0.f, s3 = 0.f, c0 = 1.f, c1 = 1.f, c2 = 1.f, c3 = 1.f;
                if (dorope) { const float p = (float)pos[row]; sincos_rad(p * f0, s0, c0); sincos_rad(p * f1, s1, c1); sincos_rad(p * f2, s2, c2); sincos_rad(p * f3, s3, c3); }
#pragma unroll
                for (int bj = 0; bj < 2; ++bj) { f32x4 v0 = acc[ai][bj][m][0], v1 = acc[ai][bj][m][1];
                    { const float a0 = v0[0], b0 = v0[1], a1 = v0[2], b1 = v0[3], a2 = v1[0], b2 = v1[1], a3 = v1[2], b3 = v1[3];
                      v0[0] = a0 * c0 - b0 * s0; v0[1] = b0 * c0 + a0 * s0; v0[2] = a1 * c1 - b1 * s1; v0[3] = b1 * c1 + a1 * s1;
                      v1[0] = a2 * c2 - b2 * s2; v1[1] = b2 * c2 + a2 * s2; v1[2] = a3 * c3 - b3 * s3; v1[3] = b3 * c3 + a3 * s3; }
                    v0 = v0 * sc; v1 = v1 * sc; u32x4 w; w.x = cvt_pk_bf16(v0[0], v0[1]); w.y = cvt_pk_bf16(v0[2], v0[3]); w.z = cvt_pk_bf16(v1[0], v1[1]); w.w = cvt_pk_bf16(v1[2], v1[3]);
                    *(u32x4*)(rowp + bj * HALF) = w; } }
    }
};
struct EpiOut {
    static constexpr bool PERM = false, AFTER_DRAIN = false;
    const float* xin; float* xout; const float* gate;
    __device__ __forceinline__ void operator()(const f32x4 (&acc)[2][2][4][2], const Unit& u, int wr, int wc, int fr, int fq) const {
        const int b = u.pm >> 5; const float* gp = gate + b * 6144; const int col0 = u.pn * BM + wc * 32 + 4 * fq;
        f32x4 gv[2][2];
#pragma unroll
        for (int bj = 0; bj < 2; ++bj)
#pragma unroll
            for (int n = 0; n < 2; ++n) gv[bj][n] = *(const f32x4*)(gp + col0 + bj * HALF + n * 16);
#pragma unroll
        for (int ai = 0; ai < 2; ++ai)
#pragma unroll
            for (int m = 0; m < 4; ++m) { const size_t off = (size_t)(u.pm * BM + ai * HALF + wr * 64 + m * 16 + fr) * 1024 + col0;
#pragma unroll
                for (int bj = 0; bj < 2; ++bj)
#pragma unroll
                    for (int n = 0; n < 2; ++n) { const f32x4 xv = *(const f32x4*)(xin + off + bj * HALF + n * 16); *(f32x4*)(xout + off + bj * HALF + n * 16) = xv + gv[bj][n] * acc[ai][bj][m][n]; }
                if (m & 1) asm volatile("" ::: "memory"); }
    }
};
__device__ __forceinline__ float silu_mul(float g, float u) { return g * u * __builtin_amdgcn_rcpf(1.0f + __builtin_amdgcn_exp2f(-1.4426950408889634f * g)); }
struct EpiSwiGLU {
    static constexpr bool PERM = true, AFTER_DRAIN = false;
    bf16_t* hid;
    __device__ __forceinline__ void operator()(const f32x4 (&acc)[2][2][4][2], const Unit& u, int wr, int wc, int fr, int fq) const {
        const int row0 = u.pm * BM + wr * 64 + fr, col0 = u.pn * HALF + wc * 32 + 8 * fq;
#pragma unroll
        for (int ai = 0; ai < 2; ++ai)
#pragma unroll
            for (int m = 0; m < 4; ++m) { const f32x4 g0 = acc[ai][0][m][0], g1 = acc[ai][0][m][1], u0 = acc[ai][1][m][0], u1 = acc[ai][1][m][1];
                u32x4 w; w.x = cvt_pk_bf16(silu_mul(g0[0], u0[0]), silu_mul(g0[1], u0[1])); w.y = cvt_pk_bf16(silu_mul(g0[2], u0[2]), silu_mul(g0[3], u0[3]));
                w.z = cvt_pk_bf16(silu_mul(g1[0], u1[0]), silu_mul(g1[1], u1[1])); w.w = cvt_pk_bf16(silu_mul(g1[2], u1[2]), silu_mul(g1[3], u1[3]));
                *(u32x4*)(hid + (size_t)(row0 + ai * HALF + m * 16) * 512 + col0) = w; }
    }
};
struct EpiDown {
    static constexpr bool PERM = true, AFTER_DRAIN = false;
    bf16_t* y2; const int* list; const float* gatew; const PG8_LAS int* cnt; int Mtok;
    __device__ __forceinline__ void operator()(const f32x4 (&acc)[2][2][4][2], const Unit& u, int wr, int wc, int fr, int fq) const {
        const int nvalid = cnt[u.e] - u.rb * BM; const int* lp = list + (size_t)u.e * Mtok + u.rb * BM; const int col0 = u.pn * BM + wc * 32 + 8 * fq;
#pragma unroll
        for (int ai = 0; ai < 2; ++ai)
#pragma unroll
            for (int m = 0; m < 4; ++m) { const int r = ai * HALF + wr * 64 + m * 16 + fr;
                if (r < nvalid) { const int d = lp[r]; const float wg = gatew[d]; bf16_t* rowp = y2 + (size_t)d * 1024 + col0;
#pragma unroll
                    for (int bj = 0; bj < 2; ++bj) { const f32x4 v0 = acc[ai][bj][m][0] * wg, v1 = acc[ai][bj][m][1] * wg;
                        u32x4 w; w.x = cvt_pk_bf16(v0[0], v0[1]); w.y = cvt_pk_bf16(v0[2], v0[3]); w.z = cvt_pk_bf16(v1[0], v1[1]); w.w = cvt_pk_bf16(v1[2], v1[3]);
                        *(u32x4*)(rowp + bj * HALF) = w; } } }
    }
};

template <class Epi, class Sched, bool ALIGN_EPI, bool GATHER>
__device__ __forceinline__ void gemm_phase(PG8_LAS unsigned char* lds, const int K, const Sched& S, const Epi& E) {
    int tid_ = threadIdx.x; asm volatile("" : "+v"(tid_));
    const int tid = tid_, wid = __builtin_amdgcn_readfirstlane(tid >> 6), lane = tid & 63, wr = wid >> 2, wc = wid & 3, fr = lane & 15, fq = lane >> 4;
    const int nt = K / BK;
    unsigned vA0[2], vA1[2], nA0[2], nA1[2], voffB[2]; int RA[2], CA2[2];
#pragma unroll
    for (int i = 0; i < 2; ++i) { int R, C; stage_rc(tid * 16 + i * 8192, R, C); const int Rb = Epi::PERM ? ((R & ~31) + perm32(R & 31)) : R;
        RA[i] = R; CA2[i] = C * 2; voffB[i] = (unsigned)(Rb * K + C) * 2u; }
    const size_t kstep = (size_t)(BK * 2);
    const size_t hstep = (size_t)HALF * K * 2;
    const unsigned ldsw = (unsigned)wid * 1024u;
    const int aoff = lds_byte(wr * 64 + fr, fq * 8), boff = lds_byte(wc * 32 + fr, fq * 8);
#define PG8_SA(b, h) (((b) * 2 + (h)) * HTB)
#define PG8_SB(b, h) ((4 + (b) * 2 + (h)) * HTB)
#define PG8_STAGE(bufoff, gbase, voff) do { _Pragma("unroll") for (int _i = 0; _i < 2; ++_i) \
        __builtin_amdgcn_global_load_lds((const unsigned*)((const char*)(gbase) + (voff)[_i]), (PG8_LAS unsigned*)(lds + (bufoff) + ldsw + _i * 8192), 16, 0, 0); } while (0)
#define PG8_LDA(dst, b, h) do { _Pragma("unroll") for (int m = 0; m < 4; ++m) _Pragma("unroll") for (int k = 0; k < 2; ++k) dst[m][k] = *(const PG8_LAS bf16x8*)(lds + PG8_SA(b, h) + aoff + m * 2048 + k * 1024); } while (0)
#define PG8_LDB(dst, b, h) do { _Pragma("unroll") for (int n = 0; n < 2; ++n) _Pragma("unroll") for (int k = 0; k < 2; ++k) dst[n][k] = *(const PG8_LAS bf16x8*)(lds + PG8_SB(b, h) + boff + n * 2048 + k * 1024); } while (0)
#define PG8_MMA(ai, bj, At, Bt) do { __builtin_amdgcn_s_setprio(1); _Pragma("unroll") for (int m = 0; m < 4; ++m) _Pragma("unroll") for (int n = 0; n < 2; ++n) _Pragma("unroll") for (int k = 0; k < 2; ++k) \
        acc[ai][bj][m][n] = __builtin_amdgcn_mfma_f32_16x16x32_bf16(Bt[n][k], At[m][k], acc[ai][bj][m][n], 0, 0, 0); __builtin_amdgcn_s_setprio(0); } while (0)
#define PG8_WAIT_V(n) asm volatile("s_waitcnt vmcnt(" #n ")" ::: "memory")
#define PG8_WAIT_L(n) asm volatile("s_waitcnt lgkmcnt(" #n ")" ::: "memory")
#define PG8_BAR __builtin_amdgcn_s_barrier()
#define PG8_SCHED __builtin_amdgcn_sched_barrier(0)
#define PG8_AOFFS(u, d0, d1) do { _Pragma("unroll") for (int _i = 0; _i < 2; ++_i) { d0[_i] = S.a_rowoff(u, RA[_i]) + (unsigned)CA2[_i]; d1[_i] = S.a_rowoff(u, HALF + RA[_i]) + (unsigned)CA2[_i]; } } while (0)
    Unit cur, nxt; int ui = 0;
    if (!S.next(0, cur)) return;
    f32x4 acc[2][2][4][2];
#pragma unroll
    for (int a = 0; a < 2; ++a)
#pragma unroll
        for (int b = 0; b < 2; ++b)
#pragma unroll
            for (int m = 0; m < 4; ++m)
#pragma unroll
                for (int n = 0; n < 2; ++n) acc[a][b][m][n] = (f32x4){0.f, 0.f, 0.f, 0.f};
    bf16x8 At[4][2], B0[2][2], B1[2][2];
    const char* cA = S.a_ptr(cur); const char* cB = S.b_ptr(cur);
    PG8_AOFFS(cur, vA0, vA1);
    {
        PG8_STAGE(PG8_SB(0, 0), cB, voffB); PG8_STAGE(PG8_SB(0, 1), cB + hstep, voffB); PG8_STAGE(PG8_SA(0, 0), cA, vA0); PG8_STAGE(PG8_SA(0, 1), cA, vA1);
        if (wr == 1) PG8_BAR;
        PG8_WAIT_V(2); PG8_BAR;
        PG8_STAGE(PG8_SB(1, 0), cB + kstep, voffB); PG8_STAGE(PG8_SA(1, 0), cA + kstep, vA0); PG8_STAGE(PG8_SB(1, 1), cB + hstep + kstep, voffB);
        PG8_WAIT_V(6); PG8_BAR;
    }
    for (;;) {
        const bool has_next = S.next(ui + 1, nxt);
        const char* nA = has_next ? S.a_ptr(nxt) : cA; const char* nB = has_next ? S.b_ptr(nxt) : cB;
        if constexpr (GATHER) { if (has_next) { PG8_AOFFS(nxt, nA0, nA1); } else {
#pragma unroll
            for (int _i = 0; _i < 2; ++_i) { nA0[_i] = vA0[_i]; nA1[_i] = vA1[_i]; } } }
        for (int t = 0; t < nt; t += 2) {
            const bool last = (t == nt - 2);
            const char* a1 = cA + (size_t)(t + 1) * kstep;
            const char* a2 = last ? nA : cA + (size_t)(t + 2) * kstep; const char* b2 = last ? nB : cB + (size_t)(t + 2) * kstep;
            const char* a3 = a2 + kstep; const char* b3 = b2 + kstep;
            PG8_LDB(B0, 0, 0); PG8_LDB(B1, 0, 1); PG8_SCHED; PG8_LDA(At, 0, 0); PG8_STAGE(PG8_SA(1, 1), a1, vA1);
            if constexpr (GATHER) { if (last) {
#pragma unroll
                for (int _i = 0; _i < 2; ++_i) { vA0[_i] = nA0[_i]; vA1[_i] = nA1[_i]; } } }
            PG8_WAIT_V(8); PG8_WAIT_L(0); PG8_BAR; PG8_MMA(0, 0, At, B0); PG8_MMA(0, 1, At, B1); PG8_BAR; PG8_SCHED;
            PG8_LDA(At, 0, 1); PG8_STAGE(PG8_SB(0, 0), b2, voffB); PG8_STAGE(PG8_SB(0, 1), b2 + hstep, voffB); PG8_STAGE(PG8_SA(0, 0), a2, vA0);
            PG8_WAIT_V(8); PG8_WAIT_L(0); PG8_BAR; PG8_MMA(1, 0, At, B0); PG8_MMA(1, 1, At, B1); PG8_BAR; PG8_SCHED;
            PG8_LDB(B0, 1, 0); PG8_LDB(B1, 1, 1); PG8_SCHED; PG8_LDA(At, 1, 0); PG8_STAGE(PG8_SA(0, 1), a2, vA1);
            PG8_WAIT_V(8); PG8_WAIT_L(0); PG8_BAR; PG8_MMA(0, 0, At, B0); PG8_MMA(0, 1, At, B1); PG8_BAR; PG8_SCHED;
            PG8_LDA(At, 1, 1); PG8_STAGE(PG8_SB(1, 0), b3, voffB); PG8_STAGE(PG8_SB(1, 1), b3 + hstep, voffB); PG8_STAGE(PG8_SA(1, 0), a3, vA0);
            PG8_WAIT_V(8); PG8_WAIT_L(0); PG8_BAR; PG8_MMA(1, 0, At, B0); PG8_MMA(1, 1, At, B1); PG8_BAR; PG8_SCHED;
        }
        if constexpr (ALIGN_EPI) { if (wr == 0) PG8_BAR; }
        E(acc, cur, wr, wc, fr, fq);
        if (!has_next) break;
#pragma unroll
        for (int a = 0; a < 2; ++a)
#pragma unroll
            for (int b = 0; b < 2; ++b)
#pragma unroll
                for (int m = 0; m < 4; ++m)
#pragma unroll
                    for (int n = 0; n < 2; ++n) acc[a][b][m][n] = (f32x4){0.f, 0.f, 0.f, 0.f};
        cur = nxt; cA = nA; cB = nB; ++ui;
        if constexpr (ALIGN_EPI) { if (wr == 1) PG8_BAR; }
    }
    PG8_WAIT_V(0);
    if constexpr (!ALIGN_EPI) { if (wr == 0) PG8_BAR; }
    PG8_BAR;
#undef PG8_SA
#undef PG8_SB
#undef PG8_STAGE
#undef PG8_LDA
#undef PG8_LDB
#undef PG8_MMA
#undef PG8_WAIT_V
#undef PG8_WAIT_L
#undef PG8_BAR
#undef PG8_SCHED
#undef PG8_AOFFS
}
}
#include <hip/hip_bf16.h>
#include <cmath>
namespace attn_body {
using bf16=__hip_bfloat16;
using bf16x8=__attribute__((ext_vector_type(8)))short;
using s16x4=__attribute__((ext_vector_type(4)))short;
using f32x16=__attribute__((ext_vector_type(16)))float;
using u32x4=__attribute__((ext_vector_type(4)))unsigned;
constexpr int BATCH=4,NHEAD=16,SEQ=8192,D=64,DM=NHEAD*D;
constexpr int NW=8,QBLK=32,QB=QBLK*NW,KVBLK=64,NQB=SEQ/QB;
constexpr int ATTN_PITCH=DM, ATTN_UNIT_ROWS=QB;
__device__ __forceinline__ int crow(int r,int hi){return (r&3)+8*(r>>2)+4*hi;}
#define SBAR() __builtin_amdgcn_sched_barrier(0)
__device__ __forceinline__ void cmask(f32x16&p0,f32x16&p1,int jb,int qrel,int hi){
  const float NEG=-INFINITY; const int thr=qrel-64*jb-4*hi;
  #pragma unroll
  for(int r=0;r<16;++r){const int kc=(r&3)+8*(r>>2); if(kc>thr)p0[r]=NEG; if(kc+32>thr)p1[r]=NEG;}
}

constexpr int NSLOT=3, SLOTB=8192;
constexpr int LDS_K=0, LDS_V=NSLOT*SLOTB, LDS_WS=2*NSLOT*SLOTB, LDS_OST=LDS_WS+NW*64*4, LDS_BYTES=LDS_OST+NW*4096;
constexpr float C2=0.125f*1.4426950408889634f;
__device__ __forceinline__ void glds16(const void*gsrc,unsigned lds_dst){unsigned keep;
  asm volatile("s_mov_b32 %0, m0\n\ts_mov_b32 m0, %2\n\ts_nop 0\n\tglobal_load_lds_dwordx4 %1, off\n\ts_mov_b32 m0, %0":"=&s"(keep):"v"(gsrc),"s"(lds_dst):"memory");}
__device__ __forceinline__ float max3f(float a,float b,float c){float r;asm("v_max3_f32 %0, %1, %2, %3":"=v"(r):"v"(a),"v"(b),"v"(c));return r;}
__device__ __forceinline__ float max2f(float a,float b){float r;asm("v_max_f32_e32 %0, %1, %2":"=v"(r):"v"(a),"v"(b));return r;}
__device__ __forceinline__ float fadd_s(float a,float b){float r;asm("v_add_f32_e32 %0, %1, %2":"=v"(r):"v"(a),"v"(b));return r;}
__device__ __forceinline__ float fsub_s(float a,float b){float r;asm("v_sub_f32_e32 %0, %1, %2":"=v"(r):"v"(a),"v"(b));return r;}
typedef float f32x2_t __attribute__((ext_vector_type(2))); typedef __bf16 bf16x2_t __attribute__((ext_vector_type(2)));
__device__ __forceinline__ unsigned cvtpk_s(float lo,float hi){f32x2_t v={lo,hi};bf16x2_t b=__builtin_convertvector(v,bf16x2_t);return __builtin_bit_cast(unsigned,b);}
#define WAIT_BAR(N) asm volatile("s_waitcnt vmcnt(" #N ") lgkmcnt(0)\n\ts_barrier":::"memory")

__device__ __forceinline__ void qkt(f32x16&p0,f32x16&p1,const char*Kslot,const bf16x8*qr,const f32x16&negm,int r32,int hi){
  const char*kb=Kslot+hi*1024+r32*16;
  #pragma unroll
  for(int d0=0;d0<4;++d0){
    const bf16x8 b0=*reinterpret_cast<const bf16x8*>(kb+d0*2048);
    const bf16x8 b1=*reinterpret_cast<const bf16x8*>(kb+d0*2048+512);
    if(d0==0){p0=__builtin_amdgcn_mfma_f32_32x32x16_bf16(b0,qr[0],negm,0,0,0);p1=__builtin_amdgcn_mfma_f32_32x32x16_bf16(b1,qr[0],negm,0,0,0);}
    else{p0=__builtin_amdgcn_mfma_f32_32x32x16_bf16(b0,qr[d0],p0,0,0,0);p1=__builtin_amdgcn_mfma_f32_32x32x16_bf16(b1,qr[d0],p1,0,0,0);}}
}
typedef __attribute__((address_space(3))) const char* lds_cptr;
typedef short v4i16_t __attribute__((ext_vector_type(4)));
__device__ __forceinline__ void kload8(bf16x8*kf,lds_cptr kp){
  kf[0]=*(const __attribute__((address_space(3))) bf16x8*)(kp);      kf[1]=*(const __attribute__((address_space(3))) bf16x8*)(kp+512);
  kf[2]=*(const __attribute__((address_space(3))) bf16x8*)(kp+2048); kf[3]=*(const __attribute__((address_space(3))) bf16x8*)(kp+2560);
  kf[4]=*(const __attribute__((address_space(3))) bf16x8*)(kp+4096); kf[5]=*(const __attribute__((address_space(3))) bf16x8*)(kp+4608);
  kf[6]=*(const __attribute__((address_space(3))) bf16x8*)(kp+6144); kf[7]=*(const __attribute__((address_space(3))) bf16x8*)(kp+6656);
}
__device__ __forceinline__ void kload2(bf16x8*kf,lds_cptr kp,int j){ kf[2*j]=*(const __attribute__((address_space(3))) bf16x8*)(kp+j*2048); kf[2*j+1]=*(const __attribute__((address_space(3))) bf16x8*)(kp+j*2048+512); }
__device__ __forceinline__ s16x4 vtr(lds_cptr p){ return __builtin_bit_cast(s16x4,__builtin_amdgcn_ds_read_tr16_b64_v4i16((__attribute__((address_space(3))) v4i16_t*)p)); }
__device__ __forceinline__ float rowmax(const f32x16&p0,const f32x16&p1){
  float a=max3f(p0[0],p0[1],p1[0]),b=max3f(p0[2],p0[3],p1[1]);a=max3f(a,p1[2],p1[3]);
  #pragma unroll
  for(int r=4;r<16;r+=4){a=max3f(a,p0[r],p0[r+1]);b=max3f(b,p0[r+2],p0[r+3]);a=max3f(a,p1[r],p1[r+1]);b=max3f(b,p1[r+2],p1[r+3]);}
  const float m=max2f(a,b);
  auto rr=__builtin_amdgcn_permlane32_swap(__float_as_uint(m),__float_as_uint(m),false,false);
  return max2f(__uint_as_float(rr[0]),__uint_as_float(rr[1]));
}
__device__ __forceinline__ void pv(f32x16*o,int vb,bf16x8 pa0,bf16x8 pa1,bf16x8 pa2,bf16x8 pa3){
  #pragma unroll
  for(int d0=0;d0<2;++d0){s16x4 lo[4],hi[4];
    #pragma unroll
    for(int ks=0;ks<4;++ks){
      asm volatile("ds_read_b64_tr_b16 %0,%1 offset:%c2":"=&v"(lo[ks]):"v"(vb),"i"(d0*4096+ks*1024):"memory");
      asm volatile("ds_read_b64_tr_b16 %0,%1 offset:%c2":"=&v"(hi[ks]):"v"(vb),"i"(d0*4096+ks*1024+512):"memory");}
    asm volatile("s_waitcnt lgkmcnt(0)":::"memory");SBAR();
    #define PK(k) (bf16x8){lo[k][0],lo[k][1],lo[k][2],lo[k][3],hi[k][0],hi[k][1],hi[k][2],hi[k][3]}
    o[d0]=__builtin_amdgcn_mfma_f32_32x32x16_bf16(pa0,PK(0),o[d0],0,0,0);
    o[d0]=__builtin_amdgcn_mfma_f32_32x32x16_bf16(pa1,PK(1),o[d0],0,0,0);
    o[d0]=__builtin_amdgcn_mfma_f32_32x32x16_bf16(pa2,PK(2),o[d0],0,0,0);
    o[d0]=__builtin_amdgcn_mfma_f32_32x32x16_bf16(pa3,PK(3),o[d0],0,0,0);
    #undef PK
  }
}

#ifndef ATTN_STORE16
#define ATTN_STORE16(p,v) (*(u32x4*)(p)=(v))
#endif
template<int THRL> __device__ __forceinline__ void attn_unit(int b,int qcol,int kcol,int vcol,int ocol,int qb,const bf16*Q,const bf16*__restrict__ K,const bf16*__restrict__ V,bf16*O,char*shm){
  int tid_=threadIdx.x; asm volatile("":"+v"(tid_)); const int tid=tid_,lane=tid&63,r32=lane&31,hi=lane>>5; const int wid=__builtin_amdgcn_readfirstlane(tid>>6);
  const long rowbase=(long)b*SEQ; const int q0=qb*QB;
  const bf16*Qw=Q+(rowbase+q0+wid*QBLK)*DM+qcol;
  const bf16*Kh=K+rowbase*DM+kcol,*Vh=V+rowbase*DM+vcol;
  const unsigned lds0=(unsigned)(uintptr_t)shm;
  float*wsf=(float*)(shm+LDS_WS)+wid*64;
  const bf16*ksrc=Kh+(long)lane*DM+wid*8;
  const bf16*vsrc=Vh+(long)(16*(wid&3)+(lane>>2))*DM+(wid>>2)*32+(lane&3)*8;
  const unsigned kdst=lds0+LDS_K+wid*1024, vdst=lds0+LDS_V+wid*1024;
  #define DMA_K(t,slot) glds16(ksrc+(long)(t)*KVBLK*DM,(unsigned)__builtin_amdgcn_readfirstlane(kdst+(slot)))
  #define DMA_V(t,slot) glds16(vsrc+(long)(t)*KVBLK*DM,(unsigned)__builtin_amdgcn_readfirstlane(vdst+(slot)))
  const int vb0=(int)(lds0+LDS_V)+((lane>>4)&1)*32+(lane&3)*8+(4*hi+((lane&15)>>2))*64;
  const char*Kbase=shm+LDS_K; bf16x8 kf[8];
  const lds_cptr shm3=(lds_cptr)shm; const lds_cptr kp0=shm3+LDS_K+hi*1024+r32*16; const lds_cptr vp0=shm3+LDS_V+((lane>>4)&1)*32+(lane&3)*8+(4*hi+((lane&15)>>2))*64;
  const int NT=(q0+QB)/KVBLK;
  DMA_K(0,0);DMA_V(0,0);DMA_K(1,SLOTB);
  bf16x8 qr[4];
  #pragma unroll
  for(int d0=0;d0<4;++d0)qr[d0]=*reinterpret_cast<const bf16x8*>(&Qw[(long)r32*DM+d0*16+hi*8]);
  float mhat=0.f,l_reg=0.f;f32x16 o[2];o[0]=f32x16{};o[1]=f32x16{};f32x16 negm=f32x16{};asm volatile("":"+v"(negm));
  const int qrel=wid*QBLK+r32;
  #define CMASK(P0,P1,t) do{int jb_=(t)-(NT-4); if(jb_>=0)cmask(P0,P1,jb_,qrel,hi);}while(0)
  bool resc=false;
  #define START(P0,P1) do{ const float rm=rowmax(P0,P1); resc=false; \
    { const float dl=rm; mhat=fadd_s(mhat,dl); \
      _Pragma("unroll") for(int r=0;r<16;++r){P0[r]=fsub_s(P0[r],dl);P1[r]=fsub_s(P1[r],dl);} \
      _Pragma("unroll") for(int r=0;r<16;++r)negm[r]=-mhat; asm volatile("":"+v"(negm)); } \
    _Pragma("unroll") for(int r=0;r<16;++r)P0[r]=__builtin_amdgcn_exp2f(P0[r]); }while(0)
  #define RESC() do{ if(resc){ asm volatile("s_waitcnt lgkmcnt(0)":::"memory"); \
      _Pragma("unroll") for(int d_=0;d_<2;++d_) _Pragma("unroll") for(int r=0;r<16;++r)o[d_][r]*=wsf[crow(r,hi)]; } }while(0)
  f32x16 pA0,pA1,pB0,pB1;
  int sl_prev=0,sl_cur=0,sl_next=SLOTB;
  #define ROT() do{sl_prev=sl_cur;sl_cur=sl_next;sl_next=(sl_next==(NSLOT-1)*SLOTB)?0:sl_next+SLOTB;}while(0)
  DMA_K(2,2*SLOTB);
  WAIT_BAR(3);
  qkt(pA0,pA1,Kbase,qr,negm,r32,hi);asm volatile("s_nop 15\n\ts_nop 7":"+v"(pA0),"+v"(pA1));CMASK(pA0,pA1,0);
  START(pA0,pA1);
  _Pragma("unroll") for(int r=0;r<16;++r)pA1[r]=__builtin_amdgcn_exp2f(pA1[r]);
  WAIT_BAR(0);
  DMA_K(3,0);DMA_V(1,SLOTB);
  ROT();
  kload8(kf,kp0+sl_cur);
  WAIT_BAR(2);
  s16x4 vlo[8],vhi[8]; u32x4 pw0,pw1,pw2,pw3;
  #define PKW(P,B) cvtpk_s(P[B],P[B+1])
  #define PAF(k) __builtin_bit_cast(bf16x8,pw##k)
  #define VFR(i) (bf16x8){vlo[i][0],vlo[i][1],vlo[i][2],vlo[i][3],vhi[i][0],vhi[i][1],vhi[i][2],vhi[i][3]}
  #define PIN(x) asm volatile("":"+v"(x))
  #define MX3(a,b,c) __builtin_fmaxf(__builtin_fmaxf((a),(b)),(c))
  #define GAPA(MF,A0,A1,A2,A3,W0,W1,PW) do{ MF; sacc+=A0; sacc+=A1; sacc+=A2; sacc+=A3; PIN(sacc); W0; W1; PIN(PW); SBAR(); }while(0)
  #define EX(v) __builtin_amdgcn_exp2f(v)
  #define GAPB(MF,X,B) do{ MF; X[B]=EX(X[B]); X[B+1]=EX(X[B+1]); X[B+2]=EX(X[B+2]); X[B+3]=EX(X[B+3]); PIN(X); SBAR(); }while(0)
  #define VRD(i) do{ vlo[i]=vtr(vp_+(((i)>>2)*4096+((i)&3)*1024)); vhi[i]=vtr(vp_+(((i)>>2)*4096+((i)&3)*1024+512)); }while(0)
  #define KRD(G,j) do{ if(G){ kload2(kf,kp0+sl_next,j); SBAR(); } }while(0)
  #define STEP(C0,C1,P0,P1,t,GK,GV,GL) do{ SBAR(); \
    const lds_cptr vp_=vp0+sl_prev; \
    VRD(0); SBAR(); float sacc=(P0[0]+P0[1]); \
    GAPA(C0=__builtin_amdgcn_mfma_f32_32x32x16_bf16(kf[0],qr[0],negm,0,0,0), P0[2],P0[3],P0[4],P0[5],     pw0[0]=PKW(P0,0), pw0[1]=PKW(P0,2), pw0); \
    VRD(4); SBAR(); GAPA(C1=__builtin_amdgcn_mfma_f32_32x32x16_bf16(kf[1],qr[0],negm,0,0,0), P0[6],P0[7],P0[8],P0[9],     pw0[2]=PKW(P0,4), pw0[3]=PKW(P0,6), pw0); \
    VRD(1); SBAR(); GAPA(C0=__builtin_amdgcn_mfma_f32_32x32x16_bf16(kf[2],qr[1],C0,0,0,0),   P0[10],P0[11],P0[12],P0[13], pw1[0]=PKW(P0,8), pw1[1]=PKW(P0,10), pw1); \
    VRD(5); SBAR(); GAPA(C1=__builtin_amdgcn_mfma_f32_32x32x16_bf16(kf[3],qr[1],C1,0,0,0),   P0[14],P0[15],P1[0],P1[1],   pw1[2]=PKW(P0,12),pw1[3]=PKW(P0,14), pw1); \
    VRD(2); SBAR(); GAPA(C0=__builtin_amdgcn_mfma_f32_32x32x16_bf16(kf[4],qr[2],C0,0,0,0),   P1[2],P1[3],P1[4],P1[5],     pw2[0]=PKW(P1,0), pw2[1]=PKW(P1,2), pw2); \
    VRD(6); SBAR(); GAPA(C1=__builtin_amdgcn_mfma_f32_32x32x16_bf16(kf[5],qr[2],C1,0,0,0),   P1[6],P1[7],P1[8],P1[9],     pw2[2]=PKW(P1,4), pw2[3]=PKW(P1,6), pw2); \
    VRD(3); SBAR(); GAPA(C0=__builtin_amdgcn_mfma_f32_32x32x16_bf16(kf[6],qr[3],C0,0,0,0),   P1[10],P1[11],P1[12],P1[13], pw3[0]=PKW(P1,8), pw3[1]=PKW(P1,10), pw3); \
    VRD(7); SBAR(); GAPA(C1=__builtin_amdgcn_mfma_f32_32x32x16_bf16(kf[7],qr[3],C1,0,0,0),   P1[14],P1[15],0.f,0.f,       pw3[2]=PKW(P1,12),pw3[3]=PKW(P1,14), pw3); \
    l_reg+=sacc; \
    if(GK){DMA_K((t)+3,sl_cur);} if(GV){DMA_V((t)+1,sl_next);} \
    CMASK(C0,C1,t); \
    { float a=MX3(C0[0],C0[1],C1[0]),b=MX3(C0[2],C0[3],C1[1]); a=MX3(a,C1[2],C1[3]); \
      _Pragma("unroll") for(int r=4;r<16;r+=4){a=MX3(a,C0[r],C0[r+1]);b=MX3(b,C0[r+2],C0[r+3]);a=MX3(a,C1[r],C1[r+1]);b=MX3(b,C1[r+2],C1[r+3]);} \
      float rm=__builtin_fmaxf(a,b); { auto rr=__builtin_amdgcn_permlane32_swap(__float_as_uint(rm),__float_as_uint(rm),false,false); rm=__builtin_fmaxf(__uint_as_float(rr[0]),__uint_as_float(rr[1])); } \
      resc=false; \
      if(__builtin_expect(__any(rm>(float)THRL),0)){ const float dl=__builtin_fmaxf(rm,0.f); mhat+=dl; \
        _Pragma("unroll") for(int r=0;r<16;++r){C0[r]-=dl;C1[r]-=dl;} \
        _Pragma("unroll") for(int r=0;r<16;++r)negm[r]=-mhat; asm volatile("":"+v"(negm)); \
        const float f=__builtin_amdgcn_exp2f(-dl); l_reg*=f; if(hi==0)wsf[r32]=f; resc=true; } } \
    SBAR(); \
    GAPB(o[0]=__builtin_amdgcn_mfma_f32_32x32x16_bf16(PAF(0),VFR(0),o[0],0,0,0), C0,0); \
    GAPB(o[1]=__builtin_amdgcn_mfma_f32_32x32x16_bf16(PAF(0),VFR(4),o[1],0,0,0), C0,4); \
    KRD(GL,0); GAPB(o[0]=__builtin_amdgcn_mfma_f32_32x32x16_bf16(PAF(1),VFR(1),o[0],0,0,0), C0,8); \
    KRD(GL,1); GAPB(o[1]=__builtin_amdgcn_mfma_f32_32x32x16_bf16(PAF(1),VFR(5),o[1],0,0,0), C0,12); \
    KRD(GL,2); GAPB(o[0]=__builtin_amdgcn_mfma_f32_32x32x16_bf16(PAF(2),VFR(2),o[0],0,0,0), C1,0); \
    KRD(GL,3); GAPB(o[1]=__builtin_amdgcn_mfma_f32_32x32x16_bf16(PAF(2),VFR(6),o[1],0,0,0), C1,4); \
    GAPB(o[0]=__builtin_amdgcn_mfma_f32_32x32x16_bf16(PAF(3),VFR(3),o[0],0,0,0), C1,8); \
    GAPB(o[1]=__builtin_amdgcn_mfma_f32_32x32x16_bf16(PAF(3),VFR(7),o[1],0,0,0), C1,12); \
    }while(0)
  int t=1;
  #undef CMASK
  #define CMASK(P0,P1,t) do{}while(0)
  for(;t+5<NT;t+=2){
    STEP(pB0,pB1,pA0,pA1,t,true,true,true);     WAIT_BAR(2); RESC(); ROT();
    STEP(pA0,pA1,pB0,pB1,t+1,true,true,true);   WAIT_BAR(2); RESC(); ROT();
  }
  #undef CMASK
  #define CMASK(P0,P1,t) do{int jb_=(t)-(NT-4); if(jb_>=0)cmask(P0,P1,jb_,qrel,hi);}while(0)
  #define ENDW(tt) do{ if((tt)+3<NT){WAIT_BAR(2);} else if((tt)+2<NT){WAIT_BAR(1);} else {WAIT_BAR(0);} }while(0)
  for(;t+1<NT;t+=2){
    STEP(pB0,pB1,pA0,pA1,t,(t+3<NT),(t+1<NT),(t+1<NT));       ENDW(t);   RESC(); ROT();
    STEP(pA0,pA1,pB0,pB1,t+1,(t+4<NT),(t+2<NT),(t+2<NT));     ENDW(t+1); RESC(); ROT();
  }
  STEP(pB0,pB1,pA0,pA1,NT-1,false,false,false); RESC();
  { float sacc=pB0[0]+pB0[1]; _Pragma("unroll") for(int r=2;r<16;++r)sacc+=pB0[r]; _Pragma("unroll") for(int r=0;r<16;++r)sacc+=pB1[r]; l_reg+=sacc;
    pw0=(u32x4){PKW(pB0,0),PKW(pB0,2),PKW(pB0,4),PKW(pB0,6)};pw1=(u32x4){PKW(pB0,8),PKW(pB0,10),PKW(pB0,12),PKW(pB0,14)};pw2=(u32x4){PKW(pB1,0),PKW(pB1,2),PKW(pB1,4),PKW(pB1,6)};pw3=(u32x4){PKW(pB1,8),PKW(pB1,10),PKW(pB1,12),PKW(pB1,14)};
    SBAR(); pv(o,vb0+sl_cur,PAF(0),PAF(1),PAF(2),PAF(3)); }
  #undef PKW
  #undef PAF
  #undef VFR
  #undef PIN
  #undef MX3
  #undef GAPA
  #undef GAPB
  #undef EX
  #undef VRD
  #undef KRD
  #undef STEP
  #undef ENDW
  {auto rr=__builtin_amdgcn_permlane32_swap(__float_as_uint(l_reg),__float_as_uint(l_reg),false,false);l_reg=__uint_as_float(rr[0])+__uint_as_float(rr[1]);}
  if(hi==0)wsf[32+r32]=l_reg;asm volatile("s_waitcnt lgkmcnt(0)":::"memory");
  float rli[16];
  #pragma unroll
  for(int r=0;r<16;++r)rli[r]=__builtin_amdgcn_rcpf(wsf[32+crow(r,hi)]);
  bf16*Ow=O+(rowbase+q0+wid*QBLK)*DM+ocol;
  { bf16*stg=(bf16*)(shm+LDS_OST)+wid*2048;
    #pragma unroll
    for(int r=0;r<16;++r){const int orow=crow(r,hi);
      #pragma unroll
      for(int d0=0;d0<2;++d0)stg[orow*64+d0*32+r32]=__float2bfloat16(o[d0][r]*rli[r]);}
    asm volatile("s_waitcnt lgkmcnt(0)":::"memory");
    #pragma unroll
    for(int i=0;i<4;++i){const int row=i*8+(lane>>3),ch=lane&7; const u32x4 v=*(const u32x4*)(stg+row*64+ch*8); ATTN_STORE16(Ow+(long)row*DM+ch*8,v);} }
  asm volatile("s_waitcnt lgkmcnt(0)\n\ts_barrier":::"memory");
  #undef DMA_K
  #undef DMA_V
  #undef CMASK
  #undef START
  #undef RESC
  #undef ROT
}

constexpr float SB_DONE=160.f;
typedef __attribute__((address_space(3))) volatile unsigned* lds_vu32;
__device__ __forceinline__ void smask(f32x16&p0,f32x16&p1,int jb,int qrel,int hi){
  const float NEG=-INFINITY; const int thr=qrel-64*jb-4*hi;
  #pragma unroll
  for(int r=0;r<16;++r){const int kc=(r&3)+8*(r>>2); if(kc>=thr)p0[r]=NEG; if(kc+32>=thr)p1[r]=NEG;}
}
__device__ __forceinline__ void sb_unit(int b,int h,int qb,const bf16*Q,const bf16*__restrict__ K,const bf16*__restrict__ V,bf16*O,char*shm){
  int tid_=threadIdx.x; asm volatile("":"+v"(tid_)); const int tid=tid_,lane=tid&63,r32=lane&31,hi=lane>>5; const int wid=__builtin_amdgcn_readfirstlane(tid>>6);
  const long rowbase=(long)b*SEQ; const int q0=qb*QB;
  const bf16*Qw=Q+(rowbase+q0+wid*QBLK)*DM+h*D;
  const bf16*Kh=K+rowbase*DM+h*D,*Vh=V+rowbase*DM+h*D;
  const unsigned lds0=(unsigned)(uintptr_t)shm;
  const bf16*ksrc=Kh+(long)lane*DM+wid*8;
  const bf16*vsrc=Vh+(long)(16*(wid&3)+(lane>>2))*DM+(wid>>2)*32+(lane&3)*8;
  const unsigned kdst=lds0+LDS_K+wid*1024, vdst=lds0+LDS_V+wid*1024;
  #define DMA_K(t,slot) glds16(ksrc+(long)(t)*KVBLK*DM,(unsigned)__builtin_amdgcn_readfirstlane(kdst+(slot)))
  #define DMA_V(t,slot) glds16(vsrc+(long)(t)*KVBLK*DM,(unsigned)__builtin_amdgcn_readfirstlane(vdst+(slot)))
  const int vb0=(int)(lds0+LDS_V)+((lane>>4)&1)*32+(lane&3)*8+(4*hi+((lane&15)>>2))*64;
  const lds_cptr shm3=(lds_cptr)shm; const lds_cptr kp0=shm3+LDS_K+hi*1024+r32*16;
  lds_vu32 flags=(lds_vu32)(shm3+LDS_WS);
  const int NT=(q0+QB)/KVBLK;
  DMA_K(NT-1,0);DMA_V(NT-1,0);
  bf16x8 qr[4];
  #pragma unroll
  for(int d0=0;d0<4;++d0)qr[d0]=*reinterpret_cast<const bf16x8*>(&Qw[(long)r32*DM+d0*16+hi*8]);
  f32x16 o[2];o[0]=f32x16{};o[1]=f32x16{};
  float R=0.f; const int qrel=wid*QBLK+r32; int slot=0;
  for(int t=NT-1;;--t){
    if(t>0){ DMA_K(t-1,slot^SLOTB); DMA_V(t-1,slot^SLOTB); WAIT_BAR(2); } else { WAIT_BAR(0); }
    const int jb=t-(NT-4);
    const bool active=(jb<0)||(64*jb<32*wid+31);
    if(active){
      f32x16 p0,p1;
      { const lds_cptr kb=kp0+slot;
        #pragma unroll
        for(int d0=0;d0<4;++d0){
          const bf16x8 b0=*(const __attribute__((address_space(3))) bf16x8*)(kb+d0*2048);
          const bf16x8 b1=*(const __attribute__((address_space(3))) bf16x8*)(kb+d0*2048+512);
          if(d0==0){const f32x16 z=f32x16{};p0=__builtin_amdgcn_mfma_f32_32x32x16_bf16(b0,qr[0],z,0,0,0);p1=__builtin_amdgcn_mfma_f32_32x32x16_bf16(b1,qr[0],z,0,0,0);}
          else{p0=__builtin_amdgcn_mfma_f32_32x32x16_bf16(b0,qr[d0],p0,0,0,0);p1=__builtin_amdgcn_mfma_f32_32x32x16_bf16(b1,qr[d0],p1,0,0,0);}} }
      if(jb>=0)smask(p0,p1,jb,qrel,hi);
      f32x16 L0,L1;
      #pragma unroll
      for(int r=0;r<16;++r){
        const float u0=p0[r],u1=p1[r];
        float l0=-__builtin_amdgcn_logf(1.0f+__builtin_amdgcn_exp2f(u0)); if(u0>60.f)l0=-u0;
        float l1=-__builtin_amdgcn_logf(1.0f+__builtin_amdgcn_exp2f(u1)); if(u1>60.f)l1=-u1;
        L0[r]=l0;L1[r]=l1; }
      float own[8],oth[8],base[8];
      #pragma unroll
      for(int m=0;m<4;++m){ own[m]=(L0[4*m]+L0[4*m+1])+(L0[4*m+2]+L0[4*m+3]); own[4+m]=(L1[4*m]+L1[4*m+1])+(L1[4*m+2]+L1[4*m+3]); }
      #pragma unroll
      for(int m=0;m<8;++m){ auto rr=__builtin_amdgcn_permlane32_swap(__float_as_uint(own[m]),__float_as_uint(own[m]),false,false); oth[m]=__uint_as_float(hi?rr[0]:rr[1]); }
      float tot=0.f;
      #pragma unroll
      for(int m=7;m>=0;--m){ base[m]=R+tot+(hi?0.f:oth[m]); tot+=own[m]+oth[m]; }
      R+=tot;
      #pragma unroll
      for(int m=0;m<4;++m){
        { const float a3=base[m],a2=a3+L0[4*m+3],a1=a2+L0[4*m+2],a0=a1+L0[4*m+1];
          p0[4*m+0]=__builtin_amdgcn_exp2f(L0[4*m+0]+p0[4*m+0]+a0); p0[4*m+1]=__builtin_amdgcn_exp2f(L0[4*m+1]+p0[4*m+1]+a1);
          p0[4*m+2]=__builtin_amdgcn_exp2f(L0[4*m+2]+p0[4*m+2]+a2); p0[4*m+3]=__builtin_amdgcn_exp2f(L0[4*m+3]+p0[4*m+3]+a3); }
        { const float a3=base[4+m],a2=a3+L1[4*m+3],a1=a2+L1[4*m+2],a0=a1+L1[4*m+1];
          p1[4*m+0]=__builtin_amdgcn_exp2f(L1[4*m+0]+p1[4*m+0]+a0); p1[4*m+1]=__builtin_amdgcn_exp2f(L1[4*m+1]+p1[4*m+1]+a1);
          p1[4*m+2]=__builtin_amdgcn_exp2f(L1[4*m+2]+p1[4*m+2]+a2); p1[4*m+3]=__builtin_amdgcn_exp2f(L1[4*m+3]+p1[4*m+3]+a3); } }
      #define PKW(P,B) cvtpk_s(P[B],P[B+1])
      u32x4 pw0=(u32x4){PKW(p0,0),PKW(p0,2),PKW(p0,4),PKW(p0,6)},pw1=(u32x4){PKW(p0,8),PKW(p0,10),PKW(p0,12),PKW(p0,14)},pw2=(u32x4){PKW(p1,0),PKW(p1,2),PKW(p1,4),PKW(p1,6)},pw3=(u32x4){PKW(p1,8),PKW(p1,10),PKW(p1,12),PKW(p1,14)};
      #undef PKW
      SBAR(); pv(o,vb0+slot,__builtin_bit_cast(bf16x8,pw0),__builtin_bit_cast(bf16x8,pw1),__builtin_bit_cast(bf16x8,pw2),__builtin_bit_cast(bf16x8,pw3));
    }
    const unsigned mydone=__all(R<-SB_DONE)?1u:0u;
    if(lane==0)flags[wid*16]=mydone;
    asm volatile("s_waitcnt lgkmcnt(0)\n\ts_barrier":::"memory");
    unsigned alld=flags[0]&flags[16]&flags[32]&flags[48]&flags[64]&flags[80]&flags[96]&flags[112];
    alld=(unsigned)__builtin_amdgcn_readfirstlane((int)alld);
    if(alld||t==0)break;
    slot^=SLOTB;
  }
  asm volatile("s_waitcnt vmcnt(0) lgkmcnt(0)\n\ts_barrier":::"memory");
  bf16*Ow=O+(rowbase+q0+wid*QBLK)*DM+h*D;
  { bf16*stg=(bf16*)(shm+LDS_OST)+wid*2048;
    #pragma unroll
    for(int r=0;r<16;++r){const int orow=crow(r,hi);
      #pragma unroll
      for(int d0=0;d0<2;++d0)stg[orow*64+d0*32+r32]=__float2bfloat16(o[d0][r]);}
    asm volatile("s_waitcnt lgkmcnt(0)":::"memory");
    #pragma unroll
    for(int i=0;i<4;++i){const int row=i*8+(lane>>3),ch=lane&7; const u32x4 v=*(const u32x4*)(stg+row*64+ch*8); ATTN_STORE16(Ow+(long)row*DM+ch*8,v);} }
  asm volatile("s_waitcnt lgkmcnt(0)\n\ts_barrier":::"memory");
  #undef DMA_K
  #undef DMA_V
}
constexpr int ATTN_LDS_BYTES=LDS_BYTES;
template<int THRL> __device__ __forceinline__ void diff_attn_phase(char*lds,const bf16*Q,const bf16*K,const bf16*V,bf16*OA,bf16*OB,int G,int vcu){
  for(int i=0;;++i){ const int grp=(vcu>>3)+(G>>3)*(i>>2); if(grp>=BATCH*32)break; const int s=vcu&7,ii=i&3; const int qb=(ii==0)?s:(ii==1)?15-s:(ii==2)?16+s:31-s;
    const int b=grp>>5,rem=grp&31,hh=rem>>1,vh=rem&1; const int qcol=hh*64,vcol=(hh>>1)*128+vh*64;
    attn_unit<THRL>(b,qcol,qcol,vcol,vcol,qb,Q,K,V,(hh&1)?OB:OA,lds); }
}
__device__ __forceinline__ void sb_attn_phase(char*lds,const bf16*Q,const bf16*K,const bf16*V,bf16*O,int G,int vcu){
  for(int i=0;;++i){ const int grp=(vcu>>3)+(G>>3)*(i>>2); if(grp>=BATCH*NHEAD)break; const int qb=(vcu&7)*4+(i&3);
    sb_unit(grp>>4,grp&15,qb,Q,K,V,O,lds); }
}
#undef SBAR
#undef WAIT_BAR
}

constexpr int NWAVES = 8;
constexpr int BATCH = 4, T = 8192, D = 1024, M = BATCH * T, NQKV = 3 * D, NE = 32, FF = 512;
constexpr float NORM_EPS = 1e-6f;
constexpr float C2 = 0.125f * 1.4426950408889634f;
constexpr float LAM_INIT0 = 0.2f;

constexpr size_t MiB = 1u << 20;
constexpr size_t WS_CTL = 0, CTL_ZERO_BYTES = 1 * MiB;
constexpr size_t WS_MOD = 1 * MiB;
constexpr size_t WS_GATEW = 1 * MiB + 256 * 1024;
constexpr size_t WS_WQKV = 2 * MiB, WS_WO = 14 * MiB, WS_W1 = 18 * MiB, WS_W2 = 146 * MiB;
constexpr size_t WS_HB = 210 * MiB;
constexpr size_t WS_Q = 274 * MiB, WS_K = 338 * MiB, WS_V = 402 * MiB, WS_OA = 466 * MiB;
constexpr size_t WS_Y2 = 274 * MiB;
constexpr size_t WS_HID = 402 * MiB;
constexpr size_t WS_LIST = 474 * MiB;
constexpr size_t WS_END = 530 * MiB;
constexpr int CW_TMO = 0, CW_CODE = 1, CW_BAR = 4096, CW_CNT = 8192;

constexpr int RING_OFF = 0, RING_BYTES = 135168;
constexpr int LDSCTL_OFF = RING_BYTES, MISC_OFF = LDSCTL_OFF + 320;
constexpr int TAB_CNT = LDSCTL_OFF + 512, TAB_PRE = LDSCTL_OFF + 640, TAB_BR = LDSCTL_OFF + 896, TAB_LCNT = LDSCTL_OFF + 1024, TAB_LBASE = LDSCTL_OFF + 1152;
constexpr int TAB_ASG_E = LDSCTL_OFF + 1280, TAB_ASG_S = LDSCTL_OFF + 2304, TAB_ASG_D = LDSCTL_OFF + 3328;
constexpr int LDS_BYTES = 147456;
static_assert(TAB_ASG_D + 1024 <= LDS_BYTES, "LDS map");
#define GAS __attribute__((address_space(1)))
#define LAS __attribute__((address_space(3)))
typedef unsigned short bf16;
typedef unsigned v4u __attribute__((ext_vector_type(4)));
typedef float f32x4 __attribute__((ext_vector_type(4)));
typedef short bf16x8 __attribute__((ext_vector_type(8)));
typedef GAS unsigned gu32;
typedef GAS unsigned long long gu64;
#define RLX_AGENT __ATOMIC_RELAXED, __HIP_MEMORY_SCOPE_AGENT
#define LDS_WAIT() asm volatile("s_waitcnt lgkmcnt(0)" ::: "memory")
#define VM_WAIT() asm volatile("s_waitcnt vmcnt(0)" ::: "memory")
__device__ __forceinline__ unsigned long long rt() { return __builtin_amdgcn_s_memrealtime(); }
__device__ __forceinline__ unsigned f2bf(float f) { unsigned u = __builtin_bit_cast(unsigned, f); return (u + 0x7fffu + ((u >> 16) & 1u)) >> 16; }
__device__ __forceinline__ unsigned pk2(float lo, float hi) { return f2bf(lo) | (f2bf(hi) << 16); }

#define XB_TMO      128
#define XB_XCNT(j)  (256  + 64 * (j))
#define XB_XSUB(j)  (1280 + 64 * (j))
#define XB_XGEN(j)  (2304 + 64 * (j))
#define XB_TOP      3328
#define XB_TOPGEN   3392
#define XCD_BAR_WORDS 3456
#define XB_SPIN_CAP (1u << 18)

__device__ __forceinline__ unsigned xb_ld(unsigned* p)              { return __hip_atomic_load(p, __ATOMIC_RELAXED, __HIP_MEMORY_SCOPE_AGENT); }
__device__ __forceinline__ unsigned xb_add(unsigned* p, unsigned v) { return __hip_atomic_fetch_add(p, v, __ATOMIC_RELAXED, __HIP_MEMORY_SCOPE_AGENT); }
__device__ __forceinline__ unsigned xb_xcc_id() { return (unsigned)__builtin_amdgcn_s_getreg((3 << 11) | 20) & 0xFu; }
#define XB_SPIN(cond, bar) do { unsigned _sp = 0; while (cond) { __builtin_amdgcn_s_sleep(1); \
    if ((++_sp & 255u) == 0u) { if (xb_ld(&(bar)[XB_TMO])) break; if (_sp > XB_SPIN_CAP) { atomicAdd(&(bar)[XB_TMO], 1u); break; } } } } while (0)

struct XcdBarrier {
    unsigned* bar; unsigned x;
    volatile LAS unsigned* st;
};

__device__ __forceinline__ XcdBarrier xcd_barrier_post(unsigned* bar, volatile LAS unsigned* st) {
    XcdBarrier b; b.bar = bar; b.x = xb_xcc_id(); b.st = st;
    if (threadIdx.x == 0) (void)xb_add(&bar[XB_XCNT(b.x)], 1u);
    return b;
}
__device__ __forceinline__ void xcd_barrier_complete(unsigned* bar, unsigned x, unsigned& nloc, unsigned& nx) {
    const unsigned G = gridDim.x * gridDim.y * gridDim.z;
    unsigned sum, cnt, mine, sp = 0u;
    for (;;) {
        sum = 0u; cnt = 0u; mine = 0u;
#pragma unroll
        for (unsigned j = 0; j < 16; ++j) { const unsigned c = xb_ld(&bar[XB_XCNT(j)]); sum += c; cnt += (c > 0u) ? 1u : 0u; mine = (j == x) ? c : mine; }
        if (sum == G) break;
        __builtin_amdgcn_s_sleep(1);
        if ((++sp & 255u) == 0u) { if (xb_ld(&bar[XB_TMO])) break; if (sp > XB_SPIN_CAP) { atomicAdd(&bar[XB_TMO], 1u); break; } }
    }
    nloc = mine > 0u ? mine : 1u; nx = cnt > 0u ? cnt : 1u;
}

__device__ __forceinline__ void xcd_barrier(const XcdBarrier& b) {
    asm volatile("s_waitcnt vmcnt(0)" ::: "memory");
    __syncthreads();
    if (threadIdx.x == 0) {
        unsigned* bar = b.bar;
        __builtin_amdgcn_s_waitcnt(0);
        unsigned nloc = b.st[0], nx = b.st[1];
        if (nloc == 0u) { xcd_barrier_complete(bar, b.x, nloc, nx); b.st[0] = nloc; b.st[1] = nx; }
        const unsigned old = xb_add(&bar[XB_XSUB(b.x)], 1u);
        const unsigned gen = old / nloc;
        if (old + 1u == (gen + 1u) * nloc) {
            __builtin_amdgcn_fence(__ATOMIC_RELEASE, "agent");
            asm volatile("s_waitcnt vmcnt(0)" ::: "memory");
            const unsigned og = xb_add(&bar[XB_TOP], 1u);
            const unsigned tg = og / nx;
            if (og + 1u == (tg + 1u) * nx) xb_add(&bar[XB_TOPGEN], 1u);
            else XB_SPIN(xb_ld(&bar[XB_TOPGEN]) == tg, bar);
            __builtin_amdgcn_fence(__ATOMIC_ACQUIRE, "agent");
            xb_add(&bar[XB_XGEN(b.x)], 1u);
            asm volatile("s_waitcnt vmcnt(0)" ::: "memory");
        } else {
            XB_SPIN(xb_ld(&bar[XB_XGEN(b.x)]) == gen, bar);
            __builtin_amdgcn_fence(__ATOMIC_ACQUIRE, "agent");
            asm volatile("s_waitcnt vmcnt(0)" ::: "memory");
        }
    }
    __syncthreads();
}

struct Args { const void* in[16]; float* out; unsigned char* ws; };
struct Frame {
    LAS unsigned char* lds;
    volatile LAS unsigned* MISC;
    gu32* ctl;
    int tid, lane, wave;
    int vcu, G;
    const Args* a;
};
#define FIN(i)   ((const float*)F.a->in[i])
#define F_x FIN(0)
#define F_c FIN(1)
#define F_pos ((const int*)F.a->in[2])
#define F_w_ada FIN(3)
#define F_b_ada FIN(4)
#define F_norm_g FIN(5)
#define F_w_in FIN(6)
#define F_w_out FIN(7)
#define F_diff_lambda FIN(8)
#define F_subln_g FIN(9)
#define F_w_router FIN(10)
#define F_b_router FIN(11)
#define F_w_gate FIN(12)
#define F_w_up FIN(13)
#define F_w_down FIN(14)
#define F_final_g FIN(15)
#define F_out (F.a->out)
#define F_mod ((float*)(F.a->ws + WS_MOD))
#define F_gatew ((float*)(F.a->ws + WS_GATEW))
#define F_Wqkv_t ((bf16*)(F.a->ws + WS_WQKV))
#define F_Wo_t ((bf16*)(F.a->ws + WS_WO))
#define F_W1_t ((bf16*)(F.a->ws + WS_W1))
#define F_W2_t ((bf16*)(F.a->ws + WS_W2))
#define F_HB ((bf16*)(F.a->ws + WS_HB))
#define F_QB ((bf16*)(F.a->ws + WS_Q))
#define F_KB ((bf16*)(F.a->ws + WS_K))
#define F_VB ((bf16*)(F.a->ws + WS_V))
#define F_OA ((bf16*)(F.a->ws + WS_OA))
#define F_Y2 ((bf16*)(F.a->ws + WS_Y2))
#define F_HID ((bf16*)(F.a->ws + WS_HID))
#define F_list ((int*)(F.a->ws + WS_LIST))
typedef unsigned long long u64;
__device__ __forceinline__ float wave_sum(float v) {
#pragma unroll
    for (int o = 1; o < 64; o <<= 1) v += __shfl_xor(v, o);
    return v;
}
__device__ __forceinline__ float bf_lo(unsigned w) { return __uint_as_float(w << 16); }
__device__ __forceinline__ float bf_hi(unsigned w) { return __uint_as_float(w & 0xffff0000u); }
__device__ __forceinline__ f32x4 bf4_to_f32(u64 w) { const unsigned lo = (unsigned)w, hi = (unsigned)(w >> 32); return (f32x4){bf_lo(lo), bf_hi(lo), bf_lo(hi), bf_hi(hi)}; }
__device__ __forceinline__ u64 f32_to_bf4(f32x4 v) { return (u64)pk2(v.x, v.y) | ((u64)pk2(v.z, v.w) << 32); }

__device__ __forceinline__ int rowmap(int mode, int n) {
    if (mode == 1) { if (n >= 2048) return n; const int d = n & 63; const int p = d < 8 ? 2 * d : (d < 16 ? 2 * (d - 8) + 1 : d); return (n & ~63) + p; }
    if (mode == 2) return 256 * (n >> 7) + (n & 127);
    if (mode == 3) return 256 * (n >> 7) + 128 + (n & 127);
    return n;
}
__device__ __forceinline__ void p0_transpose_item(const float* W, int K, int N, bf16* WT, int mode, LAS float* scr, int item, int lane) {
    const int nblk = N / 32, kb = item / nblk, nb = item % nblk, k0 = 64 * kb, n0 = 32 * nb;
#pragma unroll 8
    for (int i = 0; i < 32; ++i) { const int kk = 2 * i + (lane >> 5); scr[kk * 33 + (lane & 31)] = W[(size_t)(k0 + kk) * N + n0 + (lane & 31)]; }
    LDS_WAIT(); asm volatile("" ::: "memory");
    const int c = lane & 7;
#pragma unroll
    for (int j = 0; j < 4; ++j) { const int n = (lane >> 3) + 8 * j; const LAS float* s = scr + (8 * c) * 33 + n;
        v4u o; o.x = pk2(s[0 * 33], s[1 * 33]); o.y = pk2(s[2 * 33], s[3 * 33]); o.z = pk2(s[4 * 33], s[5 * 33]); o.w = pk2(s[6 * 33], s[7 * 33]);
        *(GAS v4u*)(WT + (size_t)rowmap(mode, n0 + n) * K + k0 + 8 * c) = o; }
    LDS_WAIT(); asm volatile("" ::: "memory");
}
__device__ __forceinline__ void p0_prologue(Frame& F) {
    {
        LAS float* sc = (LAS float*)(F.lds);
        LAS float* red = (LAS float*)(F.lds + 16384);
        for (int i = F.tid; i < BATCH * D; i += NWAVES * 64) { const float cv = F_c[i]; sc[i] = cv / (1.f + __expf(-cv)); }
        __syncthreads();
        const int kg = F.tid >> 5, cc = F.tid & 31;
        for (int task = blockIdx.x; task < 2 * 192; task += F.G) {
            const int l = task / 192, col0 = (task % 192) * 32;
            const float* W = F_w_ada + (size_t)l * D * 6144 + col0 + cc;
            float a0 = 0.f, a1 = 0.f, a2 = 0.f, a3 = 0.f;
#pragma unroll 8
            for (int k = kg * 64; k < kg * 64 + 64; ++k) { const float w = W[(size_t)k * 6144]; a0 += sc[k] * w; a1 += sc[1024 + k] * w; a2 += sc[2048 + k] * w; a3 += sc[3072 + k] * w; }
            red[(kg * 4 + 0) * 32 + cc] = a0; red[(kg * 4 + 1) * 32 + cc] = a1; red[(kg * 4 + 2) * 32 + cc] = a2; red[(kg * 4 + 3) * 32 + cc] = a3;
            __syncthreads();
            if (F.tid < 128) { const int b = F.tid >> 5; float s = F_b_ada[l * 6144 + col0 + cc];
#pragma unroll
                for (int g = 0; g < 16; ++g) s += red[(g * 4 + b) * 32 + cc];
                F_mod[(size_t)(l * 4 + b) * 6144 + col0 + cc] = s; }
            __syncthreads();
        }
    }
    LAS float* scr = (LAS float*)(F.lds + RING_OFF + F.wave * 16384);
    const int gw = F.vcu * NWAVES + F.wave, NGW = F.G * NWAVES;
    constexpr int I_IN = (D / 64) * (NQKV / 32), I_O = (D / 64) * (D / 32), I_GU = (D / 64) * (FF / 32), I_DN = (FF / 64) * (D / 32);
    constexpr int N_IN = 2 * I_IN, N_O = 2 * I_O, N_GU = 2 * NE * 2 * I_GU, N_DN = 2 * NE * I_DN;
    for (int it = gw; it < N_IN + N_O + N_GU + N_DN; it += NGW) {
        int r = it;
        if (r < N_IN) { const int l = r / I_IN; p0_transpose_item(F_w_in + (size_t)l * D * NQKV, D, NQKV, F_Wqkv_t + (size_t)l * NQKV * D, l == 0 ? 1 : 0, scr, r % I_IN, F.lane); continue; } r -= N_IN;
        if (r < N_O) { const int l = r / I_O; p0_transpose_item(F_w_out + (size_t)l * D * D, D, D, F_Wo_t + (size_t)l * D * D, 0, scr, r % I_O, F.lane); continue; } r -= N_O;
        if (r < N_GU) { const int mat = r / I_GU, le = mat >> 1, gu = mat & 1; p0_transpose_item((gu ? F_w_up : F_w_gate) + (size_t)le * D * FF, D, FF, F_W1_t + (size_t)le * 2 * FF * D, 2 + gu, scr, r % I_GU, F.lane); continue; } r -= N_GU;
        { const int le = r / I_DN; p0_transpose_item(F_w_down + (size_t)le * FF * D, FF, D, F_W2_t + (size_t)le * D * FF, 0, scr, r % I_DN, F.lane); }
    }
}

template <bool COMBINE> __device__ __forceinline__ void n1_phase(Frame& F, const int l, const float* xin, float* xout) {
    const int gw = F.vcu * NWAVES + F.wave, NGW = F.G * NWAVES, RPW = (M + NGW - 1) / NGW;
    const int m0 = gw * RPW, m1 = (m0 + RPW < M) ? m0 + RPW : M;
    int bcur = -1; f32x4 gs[4], sh[4], gm[4];
#pragma unroll
    for (int j = 0; j < 4; ++j) { gs[j] = (f32x4){0.f, 0.f, 0.f, 0.f}; sh[j] = gs[j]; gm[j] = gs[j]; }
    const float* ng = F_norm_g + (size_t)(l * 2 + 0) * D;
    for (int m = m0; m < m1; ++m) {
        const int b = m / T;
        if (b != bcur) { bcur = b; const float* mp = F_mod + (size_t)(l * 4 + b) * 6144;
#pragma unroll
            for (int j = 0; j < 4; ++j) { const int col = 4 * F.lane + 256 * j; const f32x4 g = *(const f32x4*)(ng + col), sc = *(const f32x4*)(mp + 1024 + col);
                gs[j] = g * (sc + 1.0f); sh[j] = *(const f32x4*)(mp + col);
                if (COMBINE) gm[j] = *(const f32x4*)(F_mod + (size_t)((l - 1) * 4 + b) * 6144 + 5120 + col); } }
        const GAS f32x4* xr = (const GAS f32x4*)(xin + (size_t)m * D) + F.lane;
        f32x4 v[4];
#pragma unroll
        for (int j = 0; j < 4; ++j) v[j] = xr[64 * j];
        if (COMBINE) { const GAS u64* ya = (const GAS u64*)(F_Y2 + (size_t)(2 * m) * D) + F.lane; const GAS u64* yb = ya + D / 4;
            GAS f32x4* xo = (GAS f32x4*)(xout + (size_t)m * D) + F.lane;
#pragma unroll
            for (int j = 0; j < 4; ++j) { const f32x4 fa = bf4_to_f32(ya[64 * j]), fb = bf4_to_f32(yb[64 * j]); v[j] = v[j] + gm[j] * (fa + fb); xo[64 * j] = v[j]; } }
        float s2 = 0.f;
#pragma unroll
        for (int j = 0; j < 4; ++j) s2 += (v[j].x * v[j].x + v[j].y * v[j].y) + (v[j].z * v[j].z + v[j].w * v[j].w);
        const float rstd = __builtin_amdgcn_rsqf(wave_sum(s2) * (1.f / D) + NORM_EPS);
        GAS u64* o8 = (GAS u64*)(F_HB + (size_t)m * D) + F.lane;
#pragma unroll
        for (int j = 0; j < 4; ++j) o8[64 * j] = f32_to_bf4(v[j] * rstd * gs[j] + sh[j]);
    }
}
__device__ __forceinline__ void nsub_phase(Frame& F) {
    const int gw = F.vcu * NWAVES + F.wave, NGW = F.G * NWAVES, RPW = (M + NGW - 1) / NGW;
    const int m0 = gw * RPW, m1 = (m0 + RPW < M) ? m0 + RPW : M;
    const float s1 = wave_sum(F_diff_lambda[F.lane] * F_diff_lambda[64 + F.lane]), s2l = wave_sum(F_diff_lambda[128 + F.lane] * F_diff_lambda[192 + F.lane]);
    const float lam = __expf(s1) - __expf(s2l) + LAM_INIT0;
    const f32x4 sg = *(const f32x4*)(F_subln_g + 4 * (F.lane & 31)) * (1.0f - LAM_INIT0);
    const bf16* O1 = (const bf16*)F_out; const bf16* O2 = O1 + (size_t)M * D;
    for (int m = m0; m < m1; ++m) {
        const GAS u64* pa = (const GAS u64*)(O1 + (size_t)m * D) + F.lane; const GAS u64* pb = (const GAS u64*)(O2 + (size_t)m * D) + F.lane;
        GAS u64* o8 = (GAS u64*)(F_HB + (size_t)m * D) + F.lane;
        u64 wa[4], wb[4];
#pragma unroll
        for (int j = 0; j < 4; ++j) { wa[j] = pa[64 * j]; wb[j] = pb[64 * j]; }
#pragma unroll
        for (int j = 0; j < 4; ++j) { const f32x4 o = bf4_to_f32(wa[j]) - bf4_to_f32(wb[j]) * lam;
            float ss = (o.x * o.x + o.y * o.y) + (o.z * o.z + o.w * o.w);
#pragma unroll
            for (int d = 1; d < 32; d <<= 1) ss += __shfl_xor(ss, d);
            const float r = __builtin_amdgcn_rsqf(ss * (1.f / 128.f) + NORM_EPS);
            o8[64 * j] = f32_to_bf4(o * r * sg); }
    }
}
__device__ __forceinline__ void final_phase(Frame& F, const float* xin, float* xout) {
    const int gw = F.vcu * NWAVES + F.wave, NGW = F.G * NWAVES, RPW = (M + NGW - 1) / NGW;
    const int m0 = gw * RPW, m1 = (m0 + RPW < M) ? m0 + RPW : M;
    int bcur = -1; f32x4 fg[4], gm[4];
#pragma unroll
    for (int j = 0; j < 4; ++j) { fg[j] = *(const f32x4*)(F_final_g + 4 * F.lane + 256 * j); gm[j] = (f32x4){0.f, 0.f, 0.f, 0.f}; }
    for (int m = m0; m < m1; ++m) {
        const int b = m / T;
        if (b != bcur) { bcur = b;
#pragma unroll
            for (int j = 0; j < 4; ++j) gm[j] = *(const f32x4*)(F_mod + (size_t)(1 * 4 + b) * 6144 + 5120 + 4 * F.lane + 256 * j); }
        const GAS f32x4* xr = (const GAS f32x4*)(xin + (size_t)m * D) + F.lane;
        const GAS u64* ya = (const GAS u64*)(F_Y2 + (size_t)(2 * m) * D) + F.lane; const GAS u64* yb = ya + D / 4;
        f32x4 v[4]; float s2 = 0.f;
#pragma unroll
        for (int j = 0; j < 4; ++j) { v[j] = xr[64 * j] + gm[j] * (bf4_to_f32(ya[64 * j]) + bf4_to_f32(yb[64 * j])); s2 += (v[j].x * v[j].x + v[j].y * v[j].y) + (v[j].z * v[j].z + v[j].w * v[j].w); }
        const float rstd = __builtin_amdgcn_rsqf(wave_sum(s2) * (1.f / D) + NORM_EPS);
        GAS f32x4* xo = (GAS f32x4*)(xout + (size_t)m * D) + F.lane;
#pragma unroll
        for (int j = 0; j < 4; ++j) xo[64 * j] = v[j] * rstd * fg[j];
    }
}
__device__ __forceinline__ int crow_(int r, int hi) { return (r & 3) + 8 * (r >> 2) + 4 * hi; }
__device__ __forceinline__ void n2_phase(Frame& F, const int l, const float* xin) {
    typedef float f32x16 __attribute__((ext_vector_type(16)));
    LAS float* tileA = (LAS float*)F.lds;
    LAS float* part = (LAS float*)F.lds;
    LAS float* logit = (LAS float*)(F.lds + 65536);
    LAS int* lcnt = (LAS int*)(F.lds + TAB_LCNT); LAS int* lbase = (LAS int*)(F.lds + TAB_LBASE);
    LAS int* asg_e = (LAS int*)(F.lds + TAB_ASG_E); LAS int* asg_s = (LAS int*)(F.lds + TAB_ASG_S); LAS int* asg_d = (LAS int*)(F.lds + TAB_ASG_D);
    LAS float* br = (LAS float*)(F.lds + TAB_BR);
    if (F.tid < 32) { lcnt[F.tid] = 0; br[F.tid] = F_b_router[F.tid]; }
    __syncthreads();
    gu32* gcnt = F.ctl + CW_CNT + 64 * l;
    const float* ng = F_norm_g + (size_t)(l * 2 + 1) * D;
    int bcur = -1; f32x4 gs[4], sh[4];
#pragma unroll
    for (int j = 0; j < 4; ++j) { gs[j] = (f32x4){0.f, 0.f, 0.f, 0.f}; sh[j] = gs[j]; }
    for (int tb = F.vcu * 4; tb < M / 32; tb += F.G * 4) {
#pragma unroll 1
        for (int ti = 0; ti < 4; ++ti) {
            const int row0 = (tb + ti) * 32, b = row0 / T;
            if (b != bcur) { bcur = b; const float* mp = F_mod + (size_t)(l * 4 + b) * 6144 + 3072;
#pragma unroll
                for (int j = 0; j < 4; ++j) { const int col = 4 * F.lane + 256 * j; const f32x4 g = *(const f32x4*)(ng + col), sc = *(const f32x4*)(mp + 1024 + col);
                    gs[j] = g * (sc + 1.0f); sh[j] = *(const f32x4*)(mp + col); } }
#pragma unroll 1
            for (int rr = 0; rr < 4; ++rr) { const int r = 4 * F.wave + rr, m = row0 + r;
                const GAS f32x4* xr = (const GAS f32x4*)(xin + (size_t)m * D) + F.lane;
                f32x4 v[4]; float s2 = 0.f;
#pragma unroll
                for (int j = 0; j < 4; ++j) { v[j] = xr[64 * j]; s2 += (v[j].x * v[j].x + v[j].y * v[j].y) + (v[j].z * v[j].z + v[j].w * v[j].w); }
                const float rstd = __builtin_amdgcn_rsqf(wave_sum(s2) * (1.f / D) + NORM_EPS);
                GAS u64* o8 = (GAS u64*)(F_HB + (size_t)m * D) + F.lane;
#pragma unroll
                for (int j = 0; j < 4; ++j) { const f32x4 h = v[j] * rstd * gs[j] + sh[j]; o8[64 * j] = f32_to_bf4(h); *(LAS f32x4*)(tileA + r * 1028 + 4 * F.lane + 256 * j) = h; } }
            __syncthreads();
            f32x16 acc = {};
            { const int i = F.lane & 31, kk = F.lane >> 5;
#pragma unroll 4
                for (int t = 0; t < 16; ++t) { const int kb = 128 * F.wave + 8 * t + 4 * kk; const f32x4 a4 = *(const LAS f32x4*)(tileA + i * 1028 + kb);
                    const float b0 = F_w_router[(kb + 0) * 32 + i], b1 = F_w_router[(kb + 1) * 32 + i], b2 = F_w_router[(kb + 2) * 32 + i], b3 = F_w_router[(kb + 3) * 32 + i];
                    acc = __builtin_amdgcn_mfma_f32_32x32x2f32(a4.x, b0, acc, 0, 0, 0); acc = __builtin_amdgcn_mfma_f32_32x32x2f32(a4.y, b1, acc, 0, 0, 0);
                    acc = __builtin_amdgcn_mfma_f32_32x32x2f32(a4.z, b2, acc, 0, 0, 0); acc = __builtin_amdgcn_mfma_f32_32x32x2f32(a4.w, b3, acc, 0, 0, 0); } }
            __syncthreads();
            { const int i = F.lane & 31, kk = F.lane >> 5;
#pragma unroll
                for (int r = 0; r < 16; ++r) part[(F.wave * 32 + crow_(r, kk)) * 33 + i] = acc[r]; }
            __syncthreads();
            { const int row = F.tid >> 4;
#pragma unroll
                for (int e2 = 0; e2 < 32; e2 += 16) { const int e = (F.tid & 15) + e2; float s = 0.f;
#pragma unroll
                    for (int w = 0; w < 8; ++w) s += part[(w * 32 + row) * 33 + e];
                    logit[row * 33 + e] = s; } }
            __syncthreads();
            if (F.tid < 32) { const int row = F.tid, m = row0 + row; const LAS float* lg = logit + row * 33;
                float mx = lg[0];
#pragma unroll
                for (int e = 1; e < 32; ++e) mx = fmaxf(mx, lg[e]);
                float sum = 0.f;
#pragma unroll
                for (int e = 0; e < 32; ++e) sum += __expf(lg[e] - mx);
                const float inv = 1.0f / sum;
                float bestg = -INFINITY; int gb = 0;
#pragma unroll
                for (int g = 0; g < 4; ++g) { float t1 = -INFINITY, t2 = -INFINITY;
#pragma unroll
                    for (int jj = 0; jj < 8; ++jj) { const int e = 8 * g + jj; const float v = __expf(lg[e] - mx) * inv + br[e]; if (v > t1) { t2 = t1; t1 = v; } else if (v > t2) t2 = v; }
                    const float gsv = t1 + t2; if (gsv > bestg) { bestg = gsv; gb = g; } }
                float t1 = -INFINITY, t2 = -INFINITY; int i1 = 0, i2 = 0;
#pragma unroll
                for (int jj = 0; jj < 8; ++jj) { const int e = 8 * gb + jj; const float v = __expf(lg[e] - mx) * inv + br[e]; if (v > t1) { t2 = t1; i2 = i1; t1 = v; i1 = jj; } else if (v > t2) { t2 = v; i2 = jj; } }
                const int e1 = 8 * gb + i1, e2 = 8 * gb + i2;
                const float sc1 = __expf(lg[e1] - mx) * inv, sc2 = __expf(lg[e2] - mx) * inv, ig = 1.0f / (sc1 + sc2);
                const int a = (ti * 32 + row) * 2;
                asg_e[a] = e1; asg_s[a] = atomicAdd((int*)(lcnt + e1), 1); asg_d[a] = 2 * m; F_gatew[2 * m] = sc1 * ig;
                asg_e[a + 1] = e2; asg_s[a + 1] = atomicAdd((int*)(lcnt + e2), 1); asg_d[a + 1] = 2 * m + 1; F_gatew[2 * m + 1] = sc2 * ig; }
            __syncthreads();
        }
        if (F.tid < 32) { const int cnum = lcnt[F.tid]; lbase[F.tid] = cnum ? (int)__hip_atomic_fetch_add(gcnt + F.tid, (unsigned)cnum, RLX_AGENT) : 0; lcnt[F.tid] = 0; }
        __syncthreads();
        if (F.tid < 256) { const int e = asg_e[F.tid]; F_list[(size_t)e * M + lbase[e] + asg_s[F.tid]] = asg_d[F.tid]; }
        __syncthreads();
    }
}
__device__ __forceinline__ void load_counts(Frame& F, const int l) {
    LAS int* cnt = (LAS int*)(F.lds + TAB_CNT); LAS int* pre = (LAS int*)(F.lds + TAB_PRE);
    if (F.tid < 32) cnt[F.tid] = (int)__hip_atomic_load(F.ctl + CW_CNT + 64 * l + F.tid, RLX_AGENT);
    __syncthreads();
    if (F.tid == 0) { int s = 0; for (int e = 0; e < 32; ++e) { pre[e] = s; s += (cnt[e] + 255) >> 8; } pre[32] = s; }
    __syncthreads();
}

__global__ void __launch_bounds__(NWAVES * 64, 2) fwd_kernel(Args args) {
    extern __shared__ __attribute__((aligned(16))) unsigned char lds[];
    Frame F;
    F.lds = (LAS unsigned char*)lds;
    F.MISC = (volatile LAS unsigned*)(F.lds + MISC_OFF);
    F.tid = threadIdx.x; F.lane = F.tid & 63; F.wave = __builtin_amdgcn_readfirstlane(F.tid >> 6);
    F.G = gridDim.x; { const int bx = blockIdx.x; F.vcu = (F.G % 8 == 0) ? (bx % 8) * (F.G / 8) + bx / 8 : bx; }
    F.a = &args; F.ctl = (gu32*)(args.ws + WS_CTL);
    for (int u = F.tid; u < (LDS_BYTES - LDSCTL_OFF) / 4; u += NWAVES * 64) ((LAS unsigned*)(F.lds + LDSCTL_OFF))[u] = 0u;
    __syncthreads();
    XcdBarrier bar = xcd_barrier_post((unsigned*)(F.ctl + CW_BAR), F.MISC + 8);
#define GRID_BAR() xcd_barrier(bar)
#ifndef PH_MASK
#define PH_MASK 0xFFFFFFu
#endif
#define PH(k) if constexpr (((PH_MASK) >> (k)) & 1u)
#define PHASE_BEGIN() do { int t_ = threadIdx.x; asm volatile("" : "+v"(t_)); F.tid = t_; F.lane = t_ & 63; } while (0)
    const LAS int* tcnt = (const LAS int*)(F.lds + TAB_CNT); const LAS int* tpre = (const LAS int*)(F.lds + TAB_PRE);

    PH(0) { PHASE_BEGIN();
    p0_prologue(F);
    }
    GRID_BAR();
    PH(1) { PHASE_BEGIN();

    n1_phase<false>(F, 0, F_x, nullptr);
    }
    GRID_BAR();
    PH(2) { PHASE_BEGIN();
    {
        pg8::StaticOrder S; S.init(F_HB, F_Wqkv_t, M, NQKV, D, F.G, (int)blockIdx.x);
        pg8::EpiQKV E{F_QB, (size_t)(WS_K - WS_Q) / 2, C2, F_pos, 1};
        pg8::gemm_phase<pg8::EpiQKV, pg8::StaticOrder, true, false>(F.lds + RING_OFF, D, S, E);
    }
    }
    GRID_BAR();
    PH(3) { PHASE_BEGIN();
    {
        attn_body::bf16* O1 = (attn_body::bf16*)F_out;
        attn_body::diff_attn_phase<8>((char*)lds + RING_OFF, (const attn_body::bf16*)F_QB, (const attn_body::bf16*)F_KB, (const attn_body::bf16*)F_VB, O1, O1 + (size_t)M * D, F.G, F.vcu);
    }
    }
    GRID_BAR();
    PH(4) { PHASE_BEGIN();
    nsub_phase(F);
    }
    GRID_BAR();
    PH(5) { PHASE_BEGIN();
    {
        pg8::StaticOrder S; S.init(F_HB, F_Wo_t, M, D, D, F.G, (int)blockIdx.x);
        pg8::EpiOut E{F_x, F_out, F_mod + 2048};
        pg8::gemm_phase<pg8::EpiOut, pg8::StaticOrder, true, false>(F.lds + RING_OFF, D, S, E);
    }
    }
    GRID_BAR();
    PH(6) { PHASE_BEGIN();
    n2_phase(F, 0, F_out);
    }
    GRID_BAR();
    PH(7) { PHASE_BEGIN();
    load_counts(F, 0);
    {
        pg8::GroupedOrder<4, true> S{tcnt, tpre, F.G, F.vcu, D, M, (const char*)F_HB, (const char*)F_W1_t, (size_t)2 * FF * D * 2, F_list};
        pg8::EpiSwiGLU E{F_HID};
        pg8::gemm_phase<pg8::EpiSwiGLU, pg8::GroupedOrder<4, true>, true, true>(F.lds + RING_OFF, D, S, E);
    }
    }
    GRID_BAR();
    PH(8) { PHASE_BEGIN();
    {
        pg8::GroupedOrder<4, false> S{tcnt, tpre, F.G, F.vcu, FF, M, (const char*)F_HID, (const char*)F_W2_t, (size_t)D * FF * 2, F_list};
        pg8::EpiDown E{F_Y2, F_list, F_gatew, tcnt, M};
        pg8::gemm_phase<pg8::EpiDown, pg8::GroupedOrder<4, false>, true, false>(F.lds + RING_OFF, FF, S, E);
    }
    }
    GRID_BAR();
    PH(9) { PHASE_BEGIN();

    n1_phase<true>(F, 1, F_out, F_out);
    }
    GRID_BAR();
    PH(10) { PHASE_BEGIN();
    {
        pg8::StaticOrder S; S.init(F_HB, F_Wqkv_t + (size_t)NQKV * D, M, NQKV, D, F.G, (int)blockIdx.x);
        pg8::EpiQKV E{F_QB, (size_t)(WS_K - WS_Q) / 2, C2, F_pos, 0};
        pg8::gemm_phase<pg8::EpiQKV, pg8::StaticOrder, true, false>(F.lds + RING_OFF, D, S, E);
    }
    }
    GRID_BAR();
    PH(11) { PHASE_BEGIN();
    attn_body::sb_attn_phase((char*)lds + RING_OFF, (const attn_body::bf16*)F_QB, (const attn_body::bf16*)F_KB, (const attn_body::bf16*)F_VB, (attn_body::bf16*)F_OA, F.G, F.vcu);
    }
    GRID_BAR();
    PH(12) { PHASE_BEGIN();
    {
        pg8::StaticOrder S; S.init(F_OA, F_Wo_t + (size_t)D * D, M, D, D, F.G, (int)blockIdx.x);
        pg8::EpiOut E{F_out, F_out, F_mod + 4 * 6144 + 2048};
        pg8::gemm_phase<pg8::EpiOut, pg8::StaticOrder, true, false>(F.lds + RING_OFF, D, S, E);
    }
    }
    GRID_BAR();
    PH(13) { PHASE_BEGIN();
    n2_phase(F, 1, F_out);
    }
    GRID_BAR();
    PH(14) { PHASE_BEGIN();
    load_counts(F, 1);
    {
        pg8::GroupedOrder<4, true> S{tcnt, tpre, F.G, F.vcu, D, M, (const char*)F_HB, (const char*)(F_W1_t + (size_t)NE * 2 * FF * D), (size_t)2 * FF * D * 2, F_list};
        pg8::EpiSwiGLU E{F_HID};
        pg8::gemm_phase<pg8::EpiSwiGLU, pg8::GroupedOrder<4, true>, true, true>(F.lds + RING_OFF, D, S, E);
    }
    }
    GRID_BAR();
    PH(15) { PHASE_BEGIN();
    {
        pg8::GroupedOrder<4, false> S{tcnt, tpre, F.G, F.vcu, FF, M, (const char*)F_HID, (const char*)(F_W2_t + (size_t)NE * D * FF), (size_t)D * FF * 2, F_list};
        pg8::EpiDown E{F_Y2, F_list, F_gatew, tcnt, M};
        pg8::gemm_phase<pg8::EpiDown, pg8::GroupedOrder<4, false>, true, false>(F.lds + RING_OFF, FF, S, E);
    }
    }
    GRID_BAR();
    PH(16) { PHASE_BEGIN();
    final_phase(F, F_out, F_out);

    }
#undef GRID_BAR
}

extern "C" void kernel_launch(void* const* d_in, const int* in_sizes, int n_in, void* d_out, int out_size, void* d_ws, size_t ws_size, hipStream_t stream) {
    static int grid = 0;
    if (grid == 0) {
        if (n_in != 16 || in_sizes[0] != M * D || out_size != M * D || ws_size < WS_END) { fprintf(stderr, "kernel_launch: built for 16 inputs, x and out of %d floats, >= %zu bytes of workspace; got n_in %d, in0 %d, out %d, ws %zu; nothing launched\n", M * D, (size_t)WS_END, n_in, n_in > 0 ? in_sizes[0] : -1, out_size, ws_size); grid = -1; return; }
        int dev = 0, cus = 0, per_cu = 0;
        if (hipGetDevice(&dev) != hipSuccess || hipDeviceGetAttribute(&cus, hipDeviceAttributeMultiprocessorCount, dev) != hipSuccess) { fprintf(stderr, "kernel_launch: hipGetDevice / hipDeviceGetAttribute failed\n"); grid = -1; return; }
        if (hipFuncSetAttribute((const void*)fwd_kernel, hipFuncAttributeMaxDynamicSharedMemorySize, LDS_BYTES) != hipSuccess) { fprintf(stderr, "kernel_launch: hipFuncSetAttribute failed\n"); grid = -1; return; }
        if (hipOccupancyMaxActiveBlocksPerMultiprocessor(&per_cu, (const void*)fwd_kernel, NWAVES * 64, LDS_BYTES) != hipSuccess || per_cu < 1) { fprintf(stderr, "kernel_launch: occupancy query reports %d workgroups per CU\n", per_cu); }
        (void)hipGetLastError();
        grid = cus;
        if (grid > 256) grid = 256;
        grid -= grid % 8;
    }
    if (grid <= 0) return;
    if (hipMemsetAsync((char*)d_ws + WS_CTL, 0, CTL_ZERO_BYTES, stream) != hipSuccess) { fprintf(stderr, "kernel_launch: hipMemsetAsync failed\n"); return; }
    Args a{};
    for (int i = 0; i < 16; ++i) a.in[i] = d_in[i];
    a.out = (float*)d_out; a.ws = (unsigned char*)d_ws;
    hipLaunchKernelGGL(fwd_kernel, dim3(grid), dim3(NWAVES * 64), LDS_BYTES, stream, a);
    const hipError_t le = hipPeekAtLastError();
    if (le != hipSuccess) fprintf(stderr, "kernel_launch: launch failed: %s\n", hipGetErrorName(le));
}
```

```cpp
#include <hip/hip_runtime.h>
#include <hip/hip_bf16.h>
#include <cstdio>
#include <cstdint>
#include <cmath>
__device__ __forceinline__ int lane_id_() { return (int)__builtin_amdgcn_mbcnt_hi(~0u, __builtin_amdgcn_mbcnt_lo(~0u, 0u)); }
namespace pg8 {
#define PG8_LAS __attribute__((address_space(3)))
typedef unsigned short bf16_t;
typedef short bf16x8 __attribute__((ext_vector_type(8)));
typedef float f32x4 __attribute__((ext_vector_type(4)));
typedef unsigned u32x4 __attribute__((ext_vector_type(4)));
constexpr int BM = 256, BK = 64, HALF = 128, HTB = HALF * BK * 2  , STAGE_BYTES = 8 * HTB, NXCD = 8, WGM = 8;

__host__ __device__ __forceinline__ int lds_byte(int r, int c) { const int st = (r >> 4) * 2 + (c >> 5), rr = r & 15, cc = c & 31, ob = rr * 64 + cc * 2; return st * 1024 + (ob ^ (((ob >> 9) & 1) << 5)); }
__host__ __device__ __forceinline__ void stage_rc(int b, int& R, int& C) { const int st = b / 1024, sb = b % 1024, swz = sb ^ (((sb >> 9) & 1) << 5); R = (st >> 1) * 16 + swz / 64; C = (st & 1) * 32 + (swz % 64) / 2; }
__host__ __device__ __forceinline__ int perm32(int rho) { const int n = rho >> 4, i = rho & 15; return 8 * (i >> 2) + 4 * n + (i & 3); }


struct Unit { int pm, pn, e, rb; };

struct StaticOrder {
    int nM, nN, nwg, G, c; const char* A; const char* Bt; int K;
    __device__ void init(const void* A_, const void* Bt_, int M, int N, int K_, int G_, int c_) { A = (const char*)A_; Bt = (const char*)Bt_; K = K_; nM = M / BM; nN = N / BM; nwg = nM * nN; G = G_; c = c_; }
    __device__ bool next(int i, Unit& u) const {
        const long L = (long)i * G + c; if (L >= nwg) return false;
        int wgid = (int)L; { const int q = nwg / NXCD, r = nwg % NXCD, xcd = wgid % NXCD, off = wgid / NXCD; wgid = (xcd < r ? xcd * (q + 1) : r * (q + 1) + (xcd - r) * q) + off; }
        const int nig = WGM * nN, gid = wgid / nig, fm = gid * WGM, gsz = (nM - fm) < WGM ? (nM - fm) : WGM;
        u.pm = fm + ((wgid % nig) % gsz); u.pn = (wgid % nig) / gsz; u.e = 0; u.rb = 0; return true;
    }
    __device__ __forceinline__ const char* a_ptr(const Unit& u) const { return A + (size_t)u.pm * ((size_t)BM * K * 2); }
    __device__ __forceinline__ const char* b_ptr(const Unit& u) const { return Bt + (size_t)u.pn * ((size_t)BM * K * 2); }
    __device__ __forceinline__ unsigned a_rowoff(const Unit&, int R) const { return (unsigned)R * (unsigned)K * 2u; }
};
template <int NPN, bool GATHER_> struct GroupedOrder {
    const PG8_LAS int* cnt; const PG8_LAS int* pre; int G, vc, K, Mtok;
    const char* A; const char* W; size_t wstride; const int* list;
    __device__ bool next(int i, Unit& u) const {
        const int total = pre[32] * NPN; const int L = i * G + vc; if (L >= total) return false;
        const int rbg = L / NPN; int e = 0;
#pragma unroll 1
        for (int j = 1; j < 32; ++j) e += (pre[j] <= rbg) ? 1 : 0;
        e = __builtin_amdgcn_readfirstlane(e); const int rb = __builtin_amdgcn_readfirstlane(rbg - pre[e]);
        u.e = e; u.rb = rb; u.pm = __builtin_amdgcn_readfirstlane(rbg); u.pn = __builtin_amdgcn_readfirstlane(L % NPN); return true;
    }
    __device__ __forceinline__ const char* a_ptr(const Unit& u) const { return GATHER_ ? A : A + (size_t)u.pm * ((size_t)BM * K * 2); }
    __device__ __forceinline__ const char* b_ptr(const Unit& u) const { return W + (size_t)u.e * wstride + (size_t)u.pn * ((size_t)BM * K * 2); }
    __device__ __forceinline__ unsigned a_rowoff(const Unit& u, int R) const {
        if (!GATHER_) return (unsigned)R * (unsigned)K * 2u;
        const int idx = u.rb * BM + R; int tok = 0; if (idx < cnt[u.e]) tok = list[(size_t)u.e * Mtok + idx] >> 1;
        return (unsigned)tok * (unsigned)K * 2u;
    }
};

__device__ __forceinline__ unsigned cvt_pk_bf16(float lo, float hi) { unsigned r; asm volatile("v_cvt_pk_bf16_f32 %0, %1, %2" : "=v"(r) : "v"(lo), "v"(hi)); return r; }
typedef float f32x2 __attribute__((ext_vector_type(2)));
__device__ __forceinline__ void sincos_rad(float ang, float& s, float& c) {
    double r = (double)ang * 0.15915494309189535; r = r - __builtin_floor(r);
    const float rf = (float)r; s = __builtin_amdgcn_sinf(rf); c = __builtin_amdgcn_cosf(rf);
}
struct EpiQKV {
    static constexpr bool PERM = true, AFTER_DRAIN = false, HAS_META = false;
    bf16_t* O; size_t split_stride; float scale0; const int* pos; int rope;
    __device__ __forceinline__ void operator()(const f32x4 (&acc)[2][2][4][2], const Unit& u, int wr, int wc, int fr, int fq) const {
        const int t = u.pn >> 2; bf16_t* base = O + (size_t)t * split_stride;
        const float sc = (t == 0) ? scale0 : 1.f;
        const int row0 = u.pm * BM + wr * 64 + fr, col0 = (u.pn & 3) * BM + wc * 32 + 8 * fq;
        const bool dorope = rope && t < 2 && (wc & 1) == 0 && fq < 2;
        const float f0 = fq ? 0.0014142135623842478f : 1.0f, f1 = fq ? 0.00027424818836152554f : 0.1939227432012558f,
                    f2 = fq ? 5.318296098266728e-05f : 0.03760603070259094f, f3 = fq ? 1.0313386155758053e-05f : 0.007292664609849453f;
#pragma unroll
        for (int ai = 0; ai < 2; ++ai)
#pragma unroll
            for (int m = 0; m < 4; ++m) { const int row = row0 + ai * HALF + m * 16; bf16_t* rowp = base + (size_t)row * 1024 + col0;
                float s0 = 0.f, s1 = 0.f, s2 = 0.f, s3 = 0.f, c0 = 1.f, c1 = 1.f, c2 = 1.f, c3 = 1.f;
                if (dorope) { const float p = (float)pos[row]; sincos_rad(p * f0, s0, c0); sincos_rad(p * f1, s1, c1); sincos_rad(p * f2, s2, c2); sincos_rad(p * f3, s3, c3); }
#pragma unroll
                for (int bj = 0; bj < 2; ++bj) { f32x4 v0 = acc[ai][bj][m][0], v1 = acc[ai][bj][m][1];
                    { const float a0 = v0[0], b0 = v0[1], a1 = v0[2], b1 = v0[3], a2 = v1[0], b2 = v1[1], a3 = v1[2], b3 = v1[3];
                      v0[0] = a0 * c0 - b0 * s0; v0[1] = b0 * c0 + a0 * s0; v0[2] = a1 * c1 - b1 * s1; v0[3] = b1 * c1 + a1 * s1;
                      v1[0] = a2 * c2 - b2 * s2; v1[1] = b2 * c2 + a2 * s2; v1[2] = a3 * c3 - b3 * s3; v1[3] = b3 * c3 + a3 * s3; }
                    v0 = v0 * sc; v1 = v1 * sc; u32x4 w; w.x = cvt_pk_bf16(v0[0], v0[1]); w.y = cvt_pk_bf16(v0[2], v0[3]); w.z = cvt_pk_bf16(v1[0], v1[1]); w.w = cvt_pk_bf16(v1[2], v1[3]);
                    *(u32x4*)(rowp + bj * HALF) = w; } }
    }
};
struct EpiPlain {
    static constexpr bool PERM = true, AFTER_DRAIN = false, HAS_META = false;
    bf16_t* O; int ldc;
    __device__ __forceinline__ void operator()(const f32x4 (&acc)[2][2][4][2], const Unit& u, int wr, int wc, int fr, int fq) const {
        const int row0 = u.pm * BM + wr * 64 + fr, col0 = u.pn * BM + wc * 32 + 8 * fq;
#pragma unroll
        for (int ai = 0; ai < 2; ++ai)
#pragma unroll
            for (int m = 0; m < 4; ++m) { bf16_t* rowp = O + (size_t)(row0 + ai * HALF + m * 16) * ldc + col0;
#pragma unroll
                for (int bj = 0; bj < 2; ++bj) { const f32x4 v0 = acc[ai][bj][m][0], v1 = acc[ai][bj][m][1];
                    u32x4 w; w.x = cvt_pk_bf16(v0[0], v0[1]); w.y = cvt_pk_bf16(v0[2], v0[3]); w.z = cvt_pk_bf16(v1[0], v1[1]); w.w = cvt_pk_bf16(v1[2], v1[3]);
                    *(u32x4*)(rowp + bj * HALF) = w; } }
    }
};
__device__ __forceinline__ float silu_mul(float g, float u) { return g * u * __builtin_amdgcn_rcpf(1.0f + __builtin_amdgcn_exp2f(-1.4426950408889634f * g)); }
struct EpiSwiGLU {
    static constexpr bool PERM = true, AFTER_DRAIN = false, HAS_META = false;
    bf16_t* hid;
    __device__ __forceinline__ void operator()(const f32x4 (&acc)[2][2][4][2], const Unit& u, int wr, int wc, int fr, int fq) const {
        const int row0 = u.pm * BM + wr * 64 + fr, col0 = u.pn * HALF + wc * 32 + 8 * fq;
#pragma unroll
        for (int ai = 0; ai < 2; ++ai)
#pragma unroll
            for (int m = 0; m < 4; ++m) { const f32x4 g0 = acc[ai][0][m][0], g1 = acc[ai][0][m][1], u0 = acc[ai][1][m][0], u1 = acc[ai][1][m][1];
                u32x4 w; w.x = cvt_pk_bf16(silu_mul(g0[0], u0[0]), silu_mul(g0[1], u0[1])); w.y = cvt_pk_bf16(silu_mul(g0[2], u0[2]), silu_mul(g0[3], u0[3]));
                w.z = cvt_pk_bf16(silu_mul(g1[0], u1[0]), silu_mul(g1[1], u1[1])); w.w = cvt_pk_bf16(silu_mul(g1[2], u1[2]), silu_mul(g1[3], u1[3]));
                *(u32x4*)(hid + (size_t)(row0 + ai * HALF + m * 16) * 512 + col0) = w; }
    }
};
struct EpiDown {
    static constexpr bool PERM = true, AFTER_DRAIN = false, HAS_META = true;
    bf16_t* y2; const int* list; const PG8_LAS int* cnt; int Mtok;
    __device__ __forceinline__ void prefetch(int (&dd)[8], const Unit& u, int wr, int fr) const {
        const int nvalid = cnt[u.e] - u.rb * BM; const int* lp = list + (size_t)u.e * Mtok + u.rb * BM;
#pragma unroll
        for (int ai = 0; ai < 2; ++ai)
#pragma unroll
            for (int m = 0; m < 4; ++m) { const int r = ai * HALF + wr * 64 + m * 16 + fr; dd[ai * 4 + m] = (r < nvalid) ? lp[r] : -1; }
    }
    __device__ __forceinline__ void operator()(const f32x4 (&acc)[2][2][4][2], const Unit& u, int wr, int wc, int fr, int fq, const int (&dd)[8]) const {
        const int col0 = u.pn * BM + wc * 32 + 8 * fq;
#pragma unroll
        for (int ai = 0; ai < 2; ++ai)
#pragma unroll
            for (int m = 0; m < 4; ++m) if (dd[ai * 4 + m] >= 0) { bf16_t* rowp = y2 + (size_t)dd[ai * 4 + m] * 1024 + col0;
#pragma unroll
                for (int bj = 0; bj < 2; ++bj) { const f32x4 v0 = acc[ai][bj][m][0], v1 = acc[ai][bj][m][1];
                    u32x4 w; w.x = cvt_pk_bf16(v0[0], v0[1]); w.y = cvt_pk_bf16(v0[2], v0[3]); w.z = cvt_pk_bf16(v1[0], v1[1]); w.w = cvt_pk_bf16(v1[2], v1[3]);
                    *(u32x4*)(rowp + bj * HALF) = w; } }
    }
};

template <class Epi, class Sched, bool ALIGN_EPI, bool GATHER>
__device__ __forceinline__ void gemm_phase(PG8_LAS unsigned char* lds, const int K, const Sched& S, const Epi& E, const int wv) {
    int tid_ = wv * 64 + lane_id_(); asm volatile("" : "+v"(tid_));
    const int tid = tid_, wid = __builtin_amdgcn_readfirstlane(tid >> 6), lane = tid & 63, wr = wid >> 2, wc = wid & 3, fr = lane & 15, fq = lane >> 4;
    const int nt = K / BK;
    unsigned vA0[2], vA1[2], nA0[2], nA1[2], voffB[2]; int RA[2], CA2[2];
#pragma unroll
    for (int i = 0; i < 2; ++i) { int R, C; stage_rc(tid * 16 + i * 8192, R, C); const int Rb = Epi::PERM ? ((R & ~31) + perm32(R & 31)) : R;
        RA[i] = R; CA2[i] = C * 2; voffB[i] = (unsigned)(Rb * K + C) * 2u; }
    const size_t kstep = (size_t)(BK * 2);
    const size_t hstep = (size_t)HALF * K * 2;
    const unsigned ldsw = (unsigned)wid * 1024u;
    const int aoff = lds_byte(wr * 64 + fr, fq * 8), boff = lds_byte(wc * 32 + fr, fq * 8);
#define PG8_SA(b, h) (((b) * 2 + (h)) * HTB)
#define PG8_SB(b, h) ((4 + (b) * 2 + (h)) * HTB)
#define PG8_STAGE(bufoff, gbase, voff) do { _Pragma("unroll") for (int _i = 0; _i < 2; ++_i) \
        __builtin_amdgcn_global_load_lds((const unsigned*)((const char*)(gbase) + (voff)[_i]), (PG8_LAS unsigned*)(lds + (bufoff) + ldsw + _i * 8192), 16, 0, 0); } while (0)
#define PG8_LDA(dst, b, h) do { _Pragma("unroll") for (int m = 0; m < 4; ++m) _Pragma("unroll") for (int k = 0; k < 2; ++k) dst[m][k] = *(const PG8_LAS bf16x8*)(lds + PG8_SA(b, h) + aoff + m * 2048 + k * 1024); } while (0)
#define PG8_LDB(dst, b, h) do { _Pragma("unroll") for (int n = 0; n < 2; ++n) _Pragma("unroll") for (int k = 0; k < 2; ++k) dst[n][k] = *(const PG8_LAS bf16x8*)(lds + PG8_SB(b, h) + boff + n * 2048 + k * 1024); } while (0)
#define PG8_MMA(ai, bj, At, Bt) do { __builtin_amdgcn_s_setprio(1); _Pragma("unroll") for (int m = 0; m < 4; ++m) _Pragma("unroll") for (int n = 0; n < 2; ++n) _Pragma("unroll") for (int k = 0; k < 2; ++k) \
        acc[ai][bj][m][n] = __builtin_amdgcn_mfma_f32_16x16x32_bf16(Bt[n][k], At[m][k], acc[ai][bj][m][n], 0, 0, 0); __builtin_amdgcn_s_setprio(0); } while (0)
#define PG8_WAIT_V(n) asm volatile("s_waitcnt vmcnt(" #n ")" ::: "memory")
#define PG8_WAIT_L(n) asm volatile("s_waitcnt lgkmcnt(" #n ")" ::: "memory")
#define PG8_BAR __builtin_amdgcn_s_barrier()
#define PG8_SCHED __builtin_amdgcn_sched_barrier(0)
#define PG8_AOFFS(u, d0, d1) do { _Pragma("unroll") for (int _i = 0; _i < 2; ++_i) { d0[_i] = S.a_rowoff(u, RA[_i]) + (unsigned)CA2[_i]; d1[_i] = S.a_rowoff(u, HALF + RA[_i]) + (unsigned)CA2[_i]; } } while (0)
    Unit cur, nxt; int ui = 0;
    if (!S.next(0, cur)) return;
    f32x4 acc[2][2][4][2];
#pragma unroll
    for (int a = 0; a < 2; ++a)
#pragma unroll
        for (int b = 0; b < 2; ++b)
#pragma unroll
            for (int m = 0; m < 4; ++m)
#pragma unroll
                for (int n = 0; n < 2; ++n) acc[a][b][m][n] = (f32x4){0.f, 0.f, 0.f, 0.f};
    bf16x8 At[4][2], B0[2][2], B1[2][2]; int meta[8];
    const char* cA = S.a_ptr(cur); const char* cB = S.b_ptr(cur);
    PG8_AOFFS(cur, vA0, vA1);
    {
        PG8_STAGE(PG8_SB(0, 0), cB, voffB); PG8_STAGE(PG8_SB(0, 1), cB + hstep, voffB); PG8_STAGE(PG8_SA(0, 0), cA, vA0); PG8_STAGE(PG8_SA(0, 1), cA, vA1);
        if (wr == 1) PG8_BAR;
        PG8_WAIT_V(2); PG8_BAR;
        PG8_STAGE(PG8_SB(1, 0), cB + kstep, voffB); PG8_STAGE(PG8_SA(1, 0), cA + kstep, vA0); PG8_STAGE(PG8_SB(1, 1), cB + hstep + kstep, voffB);
        PG8_WAIT_V(6); PG8_BAR;
    }
    for (;;) {
        const bool has_next = S.next(ui + 1, nxt);
        if constexpr (Epi::HAS_META) E.prefetch(meta, cur, wr, fr);
        const char* nA = has_next ? S.a_ptr(nxt) : cA; const char* nB = has_next ? S.b_ptr(nxt) : cB;
        if constexpr (GATHER) { if (has_next) { PG8_AOFFS(nxt, nA0, nA1); } else {
#pragma unroll
            for (int _i = 0; _i < 2; ++_i) { nA0[_i] = vA0[_i]; nA1[_i] = vA1[_i]; } } }
        for (int t = 0; t < nt; t += 2) {
            const bool last = (t == nt - 2);
            const char* a1 = cA + (size_t)(t + 1) * kstep;
            const char* a2 = last ? nA : cA + (size_t)(t + 2) * kstep; const char* b2 = last ? nB : cB + (size_t)(t + 2) * kstep;
            const char* a3 = a2 + kstep; const char* b3 = b2 + kstep;
            PG8_LDB(B0, 0, 0); PG8_LDB(B1, 0, 1); PG8_SCHED; PG8_LDA(At, 0, 0); PG8_STAGE(PG8_SA(1, 1), a1, vA1);
            if constexpr (GATHER) { if (last) {
#pragma unroll
                for (int _i = 0; _i < 2; ++_i) { vA0[_i] = nA0[_i]; vA1[_i] = nA1[_i]; } } }
            PG8_WAIT_V(8); PG8_WAIT_L(0); PG8_BAR; PG8_MMA(0, 0, At, B0); PG8_MMA(0, 1, At, B1); PG8_BAR; PG8_SCHED;
            PG8_LDA(At, 0, 1); PG8_STAGE(PG8_SB(0, 0), b2, voffB); PG8_STAGE(PG8_SB(0, 1), b2 + hstep, voffB); PG8_STAGE(PG8_SA(0, 0), a2, vA0);
            PG8_WAIT_V(8); PG8_WAIT_L(0); PG8_BAR; PG8_MMA(1, 0, At, B0); PG8_MMA(1, 1, At, B1); PG8_BAR; PG8_SCHED;
            PG8_LDB(B0, 1, 0); PG8_LDB(B1, 1, 1); PG8_SCHED; PG8_LDA(At, 1, 0); PG8_STAGE(PG8_SA(0, 1), a2, vA1);
            PG8_WAIT_V(8); PG8_WAIT_L(0); PG8_BAR; PG8_MMA(0, 0, At, B0); PG8_MMA(0, 1, At, B1); PG8_BAR; PG8_SCHED;
            PG8_LDA(At, 1, 1); PG8_STAGE(PG8_SB(1, 0), b3, voffB); PG8_STAGE(PG8_SB(1, 1), b3 + hstep, voffB); PG8_STAGE(PG8_SA(1, 0), a3, vA0);
            PG8_WAIT_V(8); PG8_WAIT_L(0); PG8_BAR; PG8_MMA(1, 0, At, B0); PG8_MMA(1, 1, At, B1); PG8_BAR; PG8_SCHED;
        }
        if constexpr (ALIGN_EPI) { if (wr == 0) PG8_BAR; }
        if constexpr (Epi::HAS_META) E(acc, cur, wr, wc, fr, fq, meta); else E(acc, cur, wr, wc, fr, fq);
        if (!has_next) break;
#pragma unroll
        for (int a = 0; a < 2; ++a)
#pragma unroll
            for (int b = 0; b < 2; ++b)
#pragma unroll
                for (int m = 0; m < 4; ++m)
#pragma unroll
                    for (int n = 0; n < 2; ++n) acc[a][b][m][n] = (f32x4){0.f, 0.f, 0.f, 0.f};
        cur = nxt; cA = nA; cB = nB; ++ui;
        if constexpr (ALIGN_EPI) { if (wr == 1) PG8_BAR; }
    }
    PG8_WAIT_V(0);
    if constexpr (!ALIGN_EPI) { if (wr == 0) PG8_BAR; }
    PG8_BAR;
#undef PG8_SA
#undef PG8_SB
#undef PG8_STAGE
#undef PG8_LDA
#undef PG8_LDB
#undef PG8_MMA
#undef PG8_WAIT_V
#undef PG8_WAIT_L
#undef PG8_BAR
#undef PG8_SCHED
#undef PG8_AOFFS
}
}
#include <hip/hip_bf16.h>
#include <cmath>
namespace attn_body {
using bf16=__hip_bfloat16;
using bf16x8=__attribute__((ext_vector_type(8)))short;
using s16x4=__attribute__((ext_vector_type(4)))short;
using f32x16=__attribute__((ext_vector_type(16)))float;
using u32x4=__attribute__((ext_vector_type(4)))unsigned;
constexpr int BATCH=4,NHEAD=16,SEQ=8192,D=64,DM=NHEAD*D;
constexpr int NW=8,QBLK=32,QB=QBLK*NW,KVBLK=64,NQB=SEQ/QB;
constexpr int ATTN_PITCH=DM, ATTN_UNIT_ROWS=QB;
__device__ __forceinline__ int crow(int r,int hi){return (r&3)+8*(r>>2)+4*hi;}
#define SBAR() __builtin_amdgcn_sched_barrier(0)
__device__ __forceinline__ void cmask(f32x16&p0,f32x16&p1,int jb,int qrel,int hi){
  const float NEG=-INFINITY; const int thr=qrel-64*jb-4*hi;
  #pragma unroll
  for(int r=0;r<16;++r){const int kc=(r&3)+8*(r>>2); if(kc>thr)p0[r]=NEG; if(kc+32>thr)p1[r]=NEG;}
}

constexpr int NSLOT=3, SLOTB=8192;
constexpr int LDS_K=0, LDS_V=NSLOT*SLOTB, LDS_WS=2*NSLOT*SLOTB, LDS_OST=LDS_WS+NW*64*4, LDS_BYTES=LDS_OST+NW*4096;
constexpr float C2=0.125f*1.4426950408889634f;
__device__ __forceinline__ void glds16(const void*gsrc,unsigned lds_dst){unsigned keep;
  asm volatile("s_mov_b32 %0, m0\n\ts_mov_b32 m0, %2\n\ts_nop 0\n\tglobal_load_lds_dwordx4 %1, off\n\ts_mov_b32 m0, %0":"=&s"(keep):"v"(gsrc),"s"(lds_dst):"memory");}
__device__ __forceinline__ void glds16s(const void*sbase,unsigned voff,unsigned lds_dst){unsigned keep;
  asm volatile("s_mov_b32 %0, m0\n\ts_mov_b32 m0, %3\n\ts_nop 0\n\tglobal_load_lds_dwordx4 %1, %2\n\ts_mov_b32 m0, %0":"=&s"(keep):"v"(voff),"s"(sbase),"s"(lds_dst):"memory");}
__device__ __forceinline__ float max3f(float a,float b,float c){float r;asm("v_max3_f32 %0, %1, %2, %3":"=v"(r):"v"(a),"v"(b),"v"(c));return r;}
__device__ __forceinline__ float max2f(float a,float b){float r;asm("v_max_f32_e32 %0, %1, %2":"=v"(r):"v"(a),"v"(b));return r;}
__device__ __forceinline__ float fadd_s(float a,float b){float r;asm("v_add_f32_e32 %0, %1, %2":"=v"(r):"v"(a),"v"(b));return r;}
__device__ __forceinline__ float fsub_s(float a,float b){float r;asm("v_sub_f32_e32 %0, %1, %2":"=v"(r):"v"(a),"v"(b));return r;}
typedef float f32x2_t __attribute__((ext_vector_type(2))); typedef __bf16 bf16x2_t __attribute__((ext_vector_type(2)));
__device__ __forceinline__ unsigned cvtpk_s(float lo,float hi){f32x2_t v={lo,hi};bf16x2_t b=__builtin_convertvector(v,bf16x2_t);return __builtin_bit_cast(unsigned,b);}
#define WAIT_BAR(N) asm volatile("s_waitcnt vmcnt(" #N ") lgkmcnt(0)\n\ts_barrier":::"memory")

__device__ __forceinline__ void qkt(f32x16&p0,f32x16&p1,const char*Kslot,const bf16x8*qr,const f32x16&negm,int r32,int hi){
  const char*kb=Kslot+hi*1024+r32*16;
  #pragma unroll
  for(int d0=0;d0<4;++d0){
    const bf16x8 b0=*reinterpret_cast<const bf16x8*>(kb+d0*2048);
    const bf16x8 b1=*reinterpret_cast<const bf16x8*>(kb+d0*2048+512);
    if(d0==0){p0=__builtin_amdgcn_mfma_f32_32x32x16_bf16(b0,qr[0],negm,0,0,0);p1=__builtin_amdgcn_mfma_f32_32x32x16_bf16(b1,qr[0],negm,0,0,0);}
    else{p0=__builtin_amdgcn_mfma_f32_32x32x16_bf16(b0,qr[d0],p0,0,0,0);p1=__builtin_amdgcn_mfma_f32_32x32x16_bf16(b1,qr[d0],p1,0,0,0);}}
}
typedef __attribute__((address_space(3))) const char* lds_cptr;
typedef short v4i16_t __attribute__((ext_vector_type(4)));
__device__ __forceinline__ void kload8(bf16x8*kf,lds_cptr kp){
  kf[0]=*(const __attribute__((address_space(3))) bf16x8*)(kp);      kf[1]=*(const __attribute__((address_space(3))) bf16x8*)(kp+512);
  kf[2]=*(const __attribute__((address_space(3))) bf16x8*)(kp+2048); kf[3]=*(const __attribute__((address_space(3))) bf16x8*)(kp+2560);
  kf[4]=*(const __attribute__((address_space(3))) bf16x8*)(kp+4096); kf[5]=*(const __attribute__((address_space(3))) bf16x8*)(kp+4608);
  kf[6]=*(const __attribute__((address_space(3))) bf16x8*)(kp+6144); kf[7]=*(const __attribute__((address_space(3))) bf16x8*)(kp+6656);
}
__device__ __forceinline__ void kload2(bf16x8*kf,lds_cptr kp,int j){ kf[2*j]=*(const __attribute__((address_space(3))) bf16x8*)(kp+j*2048); kf[2*j+1]=*(const __attribute__((address_space(3))) bf16x8*)(kp+j*2048+512); }
__device__ __forceinline__ s16x4 vtr(lds_cptr p){ return __builtin_bit_cast(s16x4,__builtin_amdgcn_ds_read_tr16_b64_v4i16((__attribute__((address_space(3))) v4i16_t*)p)); }
__device__ __forceinline__ float rowmax(const f32x16&p0,const f32x16&p1){
  float a=max3f(p0[0],p0[1],p1[0]),b=max3f(p0[2],p0[3],p1[1]);a=max3f(a,p1[2],p1[3]);
  #pragma unroll
  for(int r=4;r<16;r+=4){a=max3f(a,p0[r],p0[r+1]);b=max3f(b,p0[r+2],p0[r+3]);a=max3f(a,p1[r],p1[r+1]);b=max3f(b,p1[r+2],p1[r+3]);}
  const float m=max2f(a,b);
  auto rr=__builtin_amdgcn_permlane32_swap(__float_as_uint(m),__float_as_uint(m),false,false);
  return max2f(__uint_as_float(rr[0]),__uint_as_float(rr[1]));
}
__device__ __forceinline__ void pv(f32x16*o,int vb,bf16x8 pa0,bf16x8 pa1,bf16x8 pa2,bf16x8 pa3){
  #pragma unroll
  for(int d0=0;d0<2;++d0){s16x4 lo[4],hi[4];
    #pragma unroll
    for(int ks=0;ks<4;++ks){
      asm volatile("ds_read_b64_tr_b16 %0,%1 offset:%c2":"=&v"(lo[ks]):"v"(vb),"i"(d0*4096+ks*1024):"memory");
      asm volatile("ds_read_b64_tr_b16 %0,%1 offset:%c2":"=&v"(hi[ks]):"v"(vb),"i"(d0*4096+ks*1024+512):"memory");}
    asm volatile("s_waitcnt lgkmcnt(0)":::"memory");SBAR();
    #define PK(k) (bf16x8){lo[k][0],lo[k][1],lo[k][2],lo[k][3],hi[k][0],hi[k][1],hi[k][2],hi[k][3]}
    o[d0]=__builtin_amdgcn_mfma_f32_32x32x16_bf16(pa0,PK(0),o[d0],0,0,0);
    o[d0]=__builtin_amdgcn_mfma_f32_32x32x16_bf16(pa1,PK(1),o[d0],0,0,0);
    o[d0]=__builtin_amdgcn_mfma_f32_32x32x16_bf16(pa2,PK(2),o[d0],0,0,0);
    o[d0]=__builtin_amdgcn_mfma_f32_32x32x16_bf16(pa3,PK(3),o[d0],0,0,0);
    #undef PK
  }
}

#ifndef ATTN_STORE16
#define ATTN_STORE16(p,v) (*(u32x4*)(p)=(v))
#endif
constexpr int LDS2_WS=LDS_V+NSLOT*2*SLOTB, LDS2_OST=LDS2_WS+NW*64*4, LDS2_BYTES=LDS2_OST+NW*4096;
__device__ __forceinline__ void pv4(f32x16*o,int vb,bf16x8 pa0,bf16x8 pa1,bf16x8 pa2,bf16x8 pa3){
  #pragma unroll
  for(int d0=0;d0<4;++d0){s16x4 lo[4],hi[4];
    #pragma unroll
    for(int ks=0;ks<4;++ks){
      asm volatile("ds_read_b64_tr_b16 %0,%1 offset:%c2":"=&v"(lo[ks]):"v"(vb),"i"(d0*4096+ks*1024):"memory");
      asm volatile("ds_read_b64_tr_b16 %0,%1 offset:%c2":"=&v"(hi[ks]):"v"(vb),"i"(d0*4096+ks*1024+512):"memory");}
    asm volatile("s_waitcnt lgkmcnt(0)":::"memory");SBAR();
    #define PK(k) (bf16x8){lo[k][0],lo[k][1],lo[k][2],lo[k][3],hi[k][0],hi[k][1],hi[k][2],hi[k][3]}
    o[d0]=__builtin_amdgcn_mfma_f32_32x32x16_bf16(pa0,PK(0),o[d0],0,0,0);
    o[d0]=__builtin_amdgcn_mfma_f32_32x32x16_bf16(pa1,PK(1),o[d0],0,0,0);
    o[d0]=__builtin_amdgcn_mfma_f32_32x32x16_bf16(pa2,PK(2),o[d0],0,0,0);
    o[d0]=__builtin_amdgcn_mfma_f32_32x32x16_bf16(pa3,PK(3),o[d0],0,0,0);
    #undef PK
  }
}
template<int THRL,bool COMBINE> __device__ __forceinline__ void attn_unit128(int b,int qcol,int kcol,int vcol,int ocol,int qb,const bf16*Q,const bf16*__restrict__ K,const bf16*__restrict__ V,bf16*O,char*shm,const int wv,
    bf16*HBo,const float lam,const float*subg,const float osc){
  int tid_=wv*64+lane_id_(); asm volatile("":"+v"(tid_)); const int tid=tid_,lane=tid&63,r32=lane&31,hi=lane>>5; const int wid=__builtin_amdgcn_readfirstlane(tid>>6);
  const long rowbase=(long)b*SEQ; const int q0=qb*QB;
  const bf16*Qw=Q+(rowbase+q0+wid*QBLK)*DM+qcol;
  const bf16*Kh=K+rowbase*DM+kcol,*Vh=V+rowbase*DM+vcol;
  const unsigned lds0=(unsigned)(uintptr_t)shm;
  float*wsf=(float*)(shm+LDS2_WS)+wid*64;
  const unsigned koff=(unsigned)(lane*DM+wid*8)*2u, voff=(unsigned)((16*(wid&3)+(lane>>2))*DM+(wid>>2)*32+(lane&3)*8)*2u;
  const unsigned kdst=lds0+LDS_K+wid*1024, vdst=lds0+LDS_V+wid*1024;
  #define DMA_K(t,slot) glds16s(Kh+(long)(t)*KVBLK*DM,koff,(unsigned)__builtin_amdgcn_readfirstlane(kdst+(slot)))
  #define DMA_V(t,slot) do{ glds16s(Vh+(long)(t)*KVBLK*DM,voff,(unsigned)__builtin_amdgcn_readfirstlane(vdst+2*(slot))); glds16s(Vh+(long)(t)*KVBLK*DM+64,voff,(unsigned)__builtin_amdgcn_readfirstlane(vdst+2*(slot)+8192)); }while(0)
  const int vb0=(int)(lds0+LDS_V)+((lane>>4)&1)*32+(lane&3)*8+(4*hi+((lane&15)>>2))*64;
  const char*Kbase=shm+LDS_K; bf16x8 kf[8];
  const lds_cptr shm3=(lds_cptr)shm; const lds_cptr kp0=shm3+LDS_K+hi*1024+r32*16; const lds_cptr vp0=shm3+LDS_V+((lane>>4)&1)*32+(lane&3)*8+(4*hi+((lane&15)>>2))*64;
  const int NT=(q0+QB)/KVBLK;
  DMA_K(0,0);DMA_V(0,0);DMA_K(1,SLOTB);
  bf16x8 qr[4];
  #pragma unroll
  for(int d0=0;d0<4;++d0)qr[d0]=*reinterpret_cast<const bf16x8*>(&Qw[(long)r32*DM+d0*16+hi*8]);
  float mhat=0.f,l_reg=0.f;float z_=0.f; asm volatile("":"+v"(z_));
  f32x16 o[4]; f32x16 negm;
  _Pragma("unroll") for(int r=0;r<16;++r){o[0][r]=z_;o[1][r]=z_;o[2][r]=z_;o[3][r]=z_;negm[r]=z_;} asm volatile("":"+v"(negm));
  const int qrel=wid*QBLK+r32;
  #define CMASK(P0,P1,t) do{int jb_=(t)-(NT-4); if(jb_>=0)cmask(P0,P1,jb_,qrel,hi);}while(0)
  bool resc=false;
  #define START(P0,P1) do{ const float rm=rowmax(P0,P1); resc=false; \
    { const float dl=rm; mhat=fadd_s(mhat,dl); \
      _Pragma("unroll") for(int r=0;r<16;++r){P0[r]=fsub_s(P0[r],dl);P1[r]=fsub_s(P1[r],dl);} \
      _Pragma("unroll") for(int r=0;r<16;++r)negm[r]=-mhat; asm volatile("":"+v"(negm)); } \
    _Pragma("unroll") for(int r=0;r<16;++r)P0[r]=__builtin_amdgcn_exp2f(P0[r]); }while(0)
  #define RESC() do{ if(resc){ asm volatile("s_waitcnt lgkmcnt(0)":::"memory"); \
      _Pragma("unroll") for(int d_=0;d_<4;++d_) _Pragma("unroll") for(int r=0;r<16;++r)o[d_][r]*=wsf[crow(r,hi)]; } }while(0)
  f32x16 pA0,pA1,pB0,pB1;
  int sl_prev=0,sl_cur=0,sl_next=SLOTB;
  #define ROT() do{sl_prev=sl_cur;sl_cur=sl_next;sl_next=(sl_next==(NSLOT-1)*SLOTB)?0:sl_next+SLOTB;}while(0)
  DMA_K(2,2*SLOTB);
  WAIT_BAR(3);
  qkt(pA0,pA1,Kbase,qr,negm,r32,hi);asm volatile("s_nop 15\n\ts_nop 7":"+v"(pA0),"+v"(pA1));CMASK(pA0,pA1,0);
  START(pA0,pA1);
  _Pragma("unroll") for(int r=0;r<16;++r)pA1[r]=__builtin_amdgcn_exp2f(pA1[r]);
  WAIT_BAR(0);
  DMA_K(3,0);DMA_V(1,SLOTB);
  ROT();
  kload8(kf,kp0+sl_cur);
  WAIT_BAR(3);
  s16x4 vlo[8],vhi[8]; u32x4 pw0,pw1,pw2,pw3;
  #define PKW(P,B) cvtpk_s(P[B],P[B+1])
  #define PAF(k) __builtin_bit_cast(bf16x8,pw##k)
  #define VFR(i) (bf16x8){vlo[i][0],vlo[i][1],vlo[i][2],vlo[i][3],vhi[i][0],vhi[i][1],vhi[i][2],vhi[i][3]}
  #define PIN(x) asm volatile("":"+v"(x))
  #define MX3(a,b,c) __builtin_fmaxf(__builtin_fmaxf((a),(b)),(c))
  #define GAPA(MF,A0,A1,A2,A3,W0,W1,PW) do{ MF; sacc+=A0; sacc+=A1; sacc+=A2; sacc+=A3; PIN(sacc); W0; W1; PIN(PW); SBAR(); }while(0)
  #define EX(v) __builtin_amdgcn_exp2f(v)
  #define GAPB(MF,X,B) do{ MF; X[B]=EX(X[B]); X[B+1]=EX(X[B+1]); PIN(X); SBAR(); }while(0)
  #define VRD(f) do{ vlo[(f)&7]=vtr(vp_+(((f)&3)*4096+((f)>>2)*1024)); vhi[(f)&7]=vtr(vp_+(((f)&3)*4096+((f)>>2)*1024+512)); }while(0)
  #define KRD(G,j) do{ if(G){ kload2(kf,kp0+sl_next,j); SBAR(); } }while(0)
  #define PVM(f) o[(f)&3]=__builtin_amdgcn_mfma_f32_32x32x16_bf16(PAFN((f)>>2),VFR((f)&7),o[(f)&3],0,0,0)
  #define PAFN(k) ((k)==0?PAF(0):(k)==1?PAF(1):(k)==2?PAF(2):PAF(3))
  #define STEP(C0,C1,P0,P1,t,GK,GV,GL) do{ SBAR(); \
    const lds_cptr vp_=vp0+2*sl_prev; \
    float sacc=(P0[0]+P0[1]); \
    GAPA(C0=__builtin_amdgcn_mfma_f32_32x32x16_bf16(kf[0],qr[0],negm,0,0,0), P0[2],P0[3],P0[4],P0[5],     pw0[0]=PKW(P0,0), pw0[1]=PKW(P0,2), pw0); \
    GAPA(C1=__builtin_amdgcn_mfma_f32_32x32x16_bf16(kf[1],qr[0],negm,0,0,0), P0[6],P0[7],P0[8],P0[9],     pw0[2]=PKW(P0,4), pw0[3]=PKW(P0,6), pw0); \
    VRD(0); SBAR(); GAPA(C0=__builtin_amdgcn_mfma_f32_32x32x16_bf16(kf[2],qr[1],C0,0,0,0),   P0[10],P0[11],P0[12],P0[13], pw1[0]=PKW(P0,8), pw1[1]=PKW(P0,10), pw1); \
    VRD(1); SBAR(); GAPA(C1=__builtin_amdgcn_mfma_f32_32x32x16_bf16(kf[3],qr[1],C1,0,0,0),   P0[14],P0[15],P1[0],P1[1],   pw1[2]=PKW(P0,12),pw1[3]=PKW(P0,14), pw1); \
    VRD(2); SBAR(); GAPA(C0=__builtin_amdgcn_mfma_f32_32x32x16_bf16(kf[4],qr[2],C0,0,0,0),   P1[2],P1[3],P1[4],P1[5],     pw2[0]=PKW(P1,0), pw2[1]=PKW(P1,2), pw2); \
    VRD(3); SBAR(); GAPA(C1=__builtin_amdgcn_mfma_f32_32x32x16_bf16(kf[5],qr[2],C1,0,0,0),   P1[6],P1[7],P1[8],P1[9],     pw2[2]=PKW(P1,4), pw2[3]=PKW(P1,6), pw2); \
    VRD(4); SBAR(); GAPA(C0=__builtin_amdgcn_mfma_f32_32x32x16_bf16(kf[6],qr[3],C0,0,0,0),   P1[10],P1[11],P1[12],P1[13], pw3[0]=PKW(P1,8), pw3[1]=PKW(P1,10), pw3); \
    VRD(5); SBAR(); GAPA(C1=__builtin_amdgcn_mfma_f32_32x32x16_bf16(kf[7],qr[3],C1,0,0,0),   P1[14],P1[15],0.f,0.f,       pw3[2]=PKW(P1,12),pw3[3]=PKW(P1,14), pw3); \
    l_reg+=sacc; \
    if(GK){DMA_K((t)+3,sl_cur);} if(GV){DMA_V((t)+1,sl_next);} \
    CMASK(C0,C1,t); \
    { float a=MX3(C0[0],C0[1],C1[0]),b=MX3(C0[2],C0[3],C1[1]); a=MX3(a,C1[2],C1[3]); \
      _Pragma("unroll") for(int r=4;r<16;r+=4){a=MX3(a,C0[r],C0[r+1]);b=MX3(b,C0[r+2],C0[r+3]);a=MX3(a,C1[r],C1[r+1]);b=MX3(b,C1[r+2],C1[r+3]);} \
      float rm=__builtin_fmaxf(a,b); { auto rr=__builtin_amdgcn_permlane32_swap(__float_as_uint(rm),__float_as_uint(rm),false,false); rm=__builtin_fmaxf(__uint_as_float(rr[0]),__uint_as_float(rr[1])); } \
      resc=false; \
      if(__builtin_expect(__any(rm>(float)THRL),0)){ const float dl=__builtin_fmaxf(rm,0.f); mhat+=dl; \
        _Pragma("unroll") for(int r=0;r<16;++r){C0[r]-=dl;C1[r]-=dl;} \
        _Pragma("unroll") for(int r=0;r<16;++r)negm[r]=-mhat; asm volatile("":"+v"(negm)); \
        const float f=__builtin_amdgcn_exp2f(-dl); l_reg*=f; if(hi==0)wsf[r32]=f; resc=true; } } \
    SBAR(); \
    VRD(6);  SBAR(); GAPB(PVM(0),  C0,0); \
    VRD(7);  SBAR(); GAPB(PVM(1),  C0,2); \
    VRD(8);  SBAR(); GAPB(PVM(2),  C0,4); \
    VRD(9);  SBAR(); GAPB(PVM(3),  C0,6); \
    VRD(10); SBAR(); GAPB(PVM(4),  C0,8); \
    VRD(11); SBAR(); GAPB(PVM(5),  C0,10); \
    VRD(12); SBAR(); GAPB(PVM(6),  C0,12); \
    VRD(13); SBAR(); GAPB(PVM(7),  C0,14); \
    VRD(14); SBAR(); GAPB(PVM(8),  C1,0); \
    VRD(15); SBAR(); GAPB(PVM(9),  C1,2); \
    GAPB(PVM(10), C1,4); \
    GAPB(PVM(11), C1,6); \
    KRD(GL,0); GAPB(PVM(12), C1,8); \
    KRD(GL,1); GAPB(PVM(13), C1,10); \
    KRD(GL,2); GAPB(PVM(14), C1,12); \
    KRD(GL,3); GAPB(PVM(15), C1,14); \
    }while(0)
  int t=1;
  #undef CMASK
  #define CMASK(P0,P1,t) do{}while(0)
  for(;t+5<NT;t+=2){
    STEP(pB0,pB1,pA0,pA1,t,true,true,true);     WAIT_BAR(3); RESC(); ROT();
    STEP(pA0,pA1,pB0,pB1,t+1,true,true,true);   WAIT_BAR(3); RESC(); ROT();
  }
  #undef CMASK
  #define CMASK(P0,P1,t) do{int jb_=(t)-(NT-4); if(jb_>=0)cmask(P0,P1,jb_,qrel,hi);}while(0)
  #define ENDW(tt) do{ if((tt)+3<NT){WAIT_BAR(3);} else if((tt)+2<NT){WAIT_BAR(2);} else {WAIT_BAR(0);} }while(0)
  for(;t+1<NT;t+=2){
    STEP(pB0,pB1,pA0,pA1,t,(t+3<NT),(t+1<NT),(t+1<NT));       ENDW(t);   RESC(); ROT();
    STEP(pA0,pA1,pB0,pB1,t+1,(t+4<NT),(t+2<NT),(t+2<NT));     ENDW(t+1); RESC(); ROT();
  }
  STEP(pB0,pB1,pA0,pA1,NT-1,false,false,false); RESC();
  { float sacc=pB0[0]+pB0[1]; _Pragma("unroll") for(int r=2;r<16;++r)sacc+=pB0[r]; _Pragma("unroll") for(int r=0;r<16;++r)sacc+=pB1[r]; l_reg+=sacc;
    pw0=(u32x4){PKW(pB0,0),PKW(pB0,2),PKW(pB0,4),PKW(pB0,6)};pw1=(u32x4){PKW(pB0,8),PKW(pB0,10),PKW(pB0,12),PKW(pB0,14)};pw2=(u32x4){PKW(pB1,0),PKW(pB1,2),PKW(pB1,4),PKW(pB1,6)};pw3=(u32x4){PKW(pB1,8),PKW(pB1,10),PKW(pB1,12),PKW(pB1,14)};
    SBAR(); pv4(o,vb0+2*sl_cur,PAF(0),PAF(1),PAF(2),PAF(3)); }
  #undef PKW
  #undef PAF
  #undef VFR
  #undef PIN
  #undef MX3
  #undef GAPA
  #undef GAPB
  #undef EX
  #undef VRD
  #undef KRD
  #undef STEP
  #undef PVM
  #undef PAFN
  #undef ENDW
  {auto rr=__builtin_amdgcn_permlane32_swap(__float_as_uint(l_reg),__float_as_uint(l_reg),false,false);l_reg=__uint_as_float(rr[0])+__uint_as_float(rr[1]);}
  if(hi==0)wsf[32+r32]=l_reg;asm volatile("s_waitcnt lgkmcnt(0)":::"memory");
  float rli[16];
  #pragma unroll
  for(int r=0;r<16;++r)rli[r]=__builtin_amdgcn_rcpf(wsf[32+crow(r,hi)]);
  bf16*Ow=O+(rowbase+q0+wid*QBLK)*DM+ocol;
  bf16*stg=(bf16*)(shm+LDS2_OST)+wid*2048;
  if constexpr(!COMBINE){
    #pragma unroll
    for(int hf=0;hf<2;++hf){
      #pragma unroll
      for(int r=0;r<16;++r){const int orow=crow(r,hi);
        #pragma unroll
        for(int d0=0;d0<2;++d0)stg[orow*64+d0*32+r32]=__float2bfloat16(o[2*hf+d0][r]*rli[r]);}
      asm volatile("s_waitcnt lgkmcnt(0)":::"memory");
      #pragma unroll
      for(int i=0;i<4;++i){const int row=i*8+(lane>>3),ch=lane&7; const u32x4 v=*(const u32x4*)(stg+row*64+ch*8); ATTN_STORE16(Ow+(long)row*DM+hf*64+ch*8,v);}
      asm volatile("s_waitcnt lgkmcnt(0)":::"memory"); }
  } else {
    const int ch=lane&7,rw=lane>>3;
    u32x4 v1[2][4];
    #pragma unroll
    for(int hf=0;hf<2;++hf)
      #pragma unroll
      for(int i=0;i<4;++i)v1[hf][i]=*(const u32x4*)(Ow+(long)(i*8+rw)*DM+hf*64+ch*8);
    float cv[2][4][8]; float ss[4]={0.f,0.f,0.f,0.f};
    #pragma unroll
    for(int hf=0;hf<2;++hf){
      #pragma unroll
      for(int r=0;r<16;++r){const int orow=crow(r,hi);
        #pragma unroll
        for(int d0=0;d0<2;++d0)stg[orow*64+d0*32+r32]=__float2bfloat16(o[2*hf+d0][r]*rli[r]);}
      asm volatile("s_waitcnt lgkmcnt(0)":::"memory");
      #pragma unroll
      for(int i=0;i<4;++i){ const u32x4 v2=*(const u32x4*)(stg+(i*8+rw)*64+ch*8);
        #pragma unroll
        for(int e=0;e<4;++e){ const unsigned a=v1[hf][i][e],c2=v2[e];
          const float c0=__uint_as_float(a<<16)-lam*__uint_as_float(c2<<16), c1=__uint_as_float(a&0xffff0000u)-lam*__uint_as_float(c2&0xffff0000u);
          cv[hf][i][2*e]=c0; cv[hf][i][2*e+1]=c1; ss[i]+=c0*c0+c1*c1; } }
      asm volatile("s_waitcnt lgkmcnt(0)":::"memory"); }
    float rs[4];
    #pragma unroll
    for(int i=0;i<4;++i){ float t=ss[i];
      t+=__int_as_float(__builtin_amdgcn_ds_swizzle(__float_as_int(t),(1<<10)|0x1f)); t+=__int_as_float(__builtin_amdgcn_ds_swizzle(__float_as_int(t),(2<<10)|0x1f)); t+=__int_as_float(__builtin_amdgcn_ds_swizzle(__float_as_int(t),(4<<10)|0x1f));
      rs[i]=__builtin_amdgcn_rsqf(t*(1.f/128.f)+1e-6f)*osc; }
    bf16*Hw=HBo+(rowbase+q0+wid*QBLK)*DM+ocol;
    #pragma unroll
    for(int hf=0;hf<2;++hf){ float g8[8];
      #pragma unroll
      for(int e=0;e<8;++e)g8[e]=subg[hf*64+ch*8+e];
      #pragma unroll
      for(int i=0;i<4;++i){ u32x4 w;
        #pragma unroll
        for(int e=0;e<4;++e)w[e]=cvtpk_s(cv[hf][i][2*e]*rs[i]*g8[2*e],cv[hf][i][2*e+1]*rs[i]*g8[2*e+1]);
        ATTN_STORE16(Hw+(long)(i*8+rw)*DM+hf*64+ch*8,w); } }
  }
  asm volatile("s_waitcnt lgkmcnt(0)\n\ts_barrier":::"memory");
  #undef DMA_K
  #undef DMA_V
  #undef CMASK
  #undef START
  #undef RESC
  #undef ROT
}

typedef __attribute__((address_space(3))) volatile unsigned* lds_vu32;
__device__ __forceinline__ void smask(f32x16&p0,f32x16&p1,int jb,int qrel,int hi){
  const float NEG=-INFINITY; const int thr=qrel-64*jb-4*hi;
  #pragma unroll
  for(int r=0;r<16;++r){const int kc=(r&3)+8*(r>>2); if(kc>=thr)p0[r]=NEG; if(kc+32>=thr)p1[r]=NEG;}
}
typedef __attribute__((address_space(3))) u32x4* lds_v4p;
__device__ __forceinline__ void sb_item(int b,int h,int rb,const bf16*Q,const bf16*__restrict__ K,const bf16*__restrict__ V,bf16*O,char*shm,const int wv){
  int tid_=wv*64+lane_id_(); asm volatile("":"+v"(tid_)); const int tid=tid_,lane=tid&63,r32=lane&31,hi=lane>>5; const int wid=__builtin_amdgcn_readfirstlane(tid>>6);
  const long rowbase=(long)b*SEQ; const int r0=rb*QBLK;
  const bf16*Qw=Q+(rowbase+r0)*DM+h*D;
  const bf16*Kh=K+rowbase*DM+h*D,*Vh=V+rowbase*DM+h*D;
  char*wl=shm+wid*16384;
  const lds_cptr wl3=(lds_cptr)wl;
  const unsigned lds0=(unsigned)(uintptr_t)wl;
  const int vb=(int)lds0+8192+((lane>>4)&1)*32+(lane&3)*8+(4*hi+((lane&15)>>2))*64;
  const int lrow=lane>>3,lch=lane&7;
  const lds_v4p kw0=(lds_v4p)(wl3+lch*1024+((lrow^(2*lch))<<4)), kw1=(lds_v4p)(wl3+lch*1024+(((lrow|8)^(2*lch))<<4));
  const lds_v4p vw=(lds_v4p)(wl3+8192+(lch>>2)*4096+lrow*64+(lch&3)*16);
  const bf16*kbase=Kh+(long)lrow*DM+lch*8;
  const bf16*vbase=Vh+(long)lrow*DM+lch*8;
  int koff4[4];
  #pragma unroll
  for(int d0=0;d0<4;++d0)koff4[d0]=(2*d0+hi)*1024+((r32^(2*(2*d0+hi)))<<4);
  bf16x8 qr[4];
  #pragma unroll
  for(int d0=0;d0<4;++d0)qr[d0]=*reinterpret_cast<const bf16x8*>(&Qw[(long)r32*DM+d0*16+hi*8]);
  int t=(r0+QBLK-2)>>6;
  u32x4 ks[8],vs[8]; bf16x8 kf[8];
  #define SB_LD(tt) do{ _Pragma("unroll") for(int i=0;i<8;++i){ ks[i]=*reinterpret_cast<const u32x4*>(kbase+(long)(64*(tt)+8*i)*DM); vs[i]=*reinterpret_cast<const u32x4*>(vbase+(long)(64*(tt)+8*i)*DM); } }while(0)
  #define SB_ST() do{ _Pragma("unroll") for(int i=0;i<8;++i){ if(i&1) kw1[(i>>1)*16]=ks[i]; else kw0[(i>>1)*16]=ks[i]; vw[32*i]=vs[i]; } }while(0)
  #define SB_KF() do{ _Pragma("unroll") for(int d0=0;d0<4;++d0){ kf[2*d0]=*(const __attribute__((address_space(3))) bf16x8*)(wl3+koff4[d0]); kf[2*d0+1]=*(const __attribute__((address_space(3))) bf16x8*)(wl3+koff4[d0]+512); } }while(0)
  SB_LD(t); SB_ST();
  f32x16 o[2];o[0]=f32x16{};o[1]=f32x16{};
  float Cc=1.f; bool first=true;
  for(;;){
    const bool more=t>0; const int tn=more?t-1:0;
    SB_LD(tn);
    SB_KF();
    f32x16 p0,p1;
    #pragma unroll
    for(int d0=0;d0<4;++d0){
      if(d0==0){const f32x16 z=f32x16{};p0=__builtin_amdgcn_mfma_f32_32x32x16_bf16(kf[0],qr[0],z,0,0,0);p1=__builtin_amdgcn_mfma_f32_32x32x16_bf16(kf[1],qr[0],z,0,0,0);}
      else{p0=__builtin_amdgcn_mfma_f32_32x32x16_bf16(kf[2*d0],qr[d0],p0,0,0,0);p1=__builtin_amdgcn_mfma_f32_32x32x16_bf16(kf[2*d0+1],qr[d0],p1,0,0,0);}}
    if(first){ const float NEG=-INFINITY; const int thr=r0+r32-64*t-4*hi;
      #pragma unroll
      for(int r=0;r<16;++r){const int kc=(r&3)+8*(r>>2); if(kc>=thr)p0[r]=NEG; if(kc+32>=thr)p1[r]=NEG;} }
    f32x16 W0,W1;
    #pragma unroll
    for(int r=0;r<16;++r){
      const float e0=__builtin_amdgcn_exp2f(p0[r]),e1=__builtin_amdgcn_exp2f(p1[r]);
      const float w0=__builtin_amdgcn_rcpf(1.0f+e0),w1=__builtin_amdgcn_rcpf(1.0f+e1);
      W0[r]=w0;W1[r]=w1;p0[r]=1.0f-w0;p1[r]=1.0f-w1; }
    float own[8],oth[8],base[8];
    #pragma unroll
    for(int m=0;m<4;++m){ own[m]=(W0[4*m]*W0[4*m+1])*(W0[4*m+2]*W0[4*m+3]); own[4+m]=(W1[4*m]*W1[4*m+1])*(W1[4*m+2]*W1[4*m+3]); }
    #pragma unroll
    for(int m=0;m<8;++m){ auto rr=__builtin_amdgcn_permlane32_swap(__float_as_uint(own[m]),__float_as_uint(own[m]),false,false); oth[m]=__uint_as_float(hi?rr[0]:rr[1]); }
    float tot=Cc;
    #pragma unroll
    for(int m=7;m>=0;--m){ base[m]=hi?tot:tot*oth[m]; tot*=own[m]*oth[m]; }
    Cc=tot;
    #pragma unroll
    for(int m=0;m<4;++m){
      { const float a3=base[m],a2=a3*W0[4*m+3],a1=a2*W0[4*m+2],a0=a1*W0[4*m+1];
        p0[4*m+0]*=a0; p0[4*m+1]*=a1; p0[4*m+2]*=a2; p0[4*m+3]*=a3; }
      { const float a3=base[4+m],a2=a3*W1[4*m+3],a1=a2*W1[4*m+2],a0=a1*W1[4*m+1];
        p1[4*m+0]*=a0; p1[4*m+1]*=a1; p1[4*m+2]*=a2; p1[4*m+3]*=a3; } }
    #define PKW(P,B) cvtpk_s(P[B],P[B+1])
    u32x4 pw0=(u32x4){PKW(p0,0),PKW(p0,2),PKW(p0,4),PKW(p0,6)},pw1=(u32x4){PKW(p0,8),PKW(p0,10),PKW(p0,12),PKW(p0,14)},pw2=(u32x4){PKW(p1,0),PKW(p1,2),PKW(p1,4),PKW(p1,6)},pw3=(u32x4){PKW(p1,8),PKW(p1,10),PKW(p1,12),PKW(p1,14)};
    #undef PKW
    pv(o,vb,__builtin_bit_cast(bf16x8,pw0),__builtin_bit_cast(bf16x8,pw1),__builtin_bit_cast(bf16x8,pw2),__builtin_bit_cast(bf16x8,pw3));
    if(!more||__all(Cc==0.f))break;
    SB_ST();
    --t; first=false;
  }
  #undef SB_LD
  #undef SB_ST
  #undef SB_KF
  bf16*Ow=O+(rowbase+r0)*DM+h*D;
  { bf16*stg=(bf16*)wl;
    #pragma unroll
    for(int r=0;r<16;++r){const int orow=crow(r,hi);
      #pragma unroll
      for(int d0=0;d0<2;++d0)stg[orow*64+d0*32+r32]=__float2bfloat16(o[d0][r]);}
    asm volatile("s_waitcnt lgkmcnt(0)":::"memory");
    #pragma unroll
    for(int i=0;i<4;++i){const int row=i*8+(lane>>3),ch=lane&7; const u32x4 v=*(const u32x4*)(stg+row*64+ch*8); ATTN_STORE16(Ow+(long)row*DM+ch*8,v);} }
  asm volatile("s_waitcnt lgkmcnt(0)":::"memory");
}
constexpr int ATTN_LDS_BYTES=LDS2_BYTES;
template<int THRL> __device__ __forceinline__ void diff_attn_phase(char*lds,const bf16*Q,const bf16*K,const bf16*V,bf16*OA,bf16*HBo,const float lam,const float*subg,const float osc,int G,int vcu,const int wv){
  for(int i=0;;++i){ const int grp=(vcu>>3)+(G>>3)*(i>>2); if(grp>=BATCH*(NHEAD/2))break; const int s=vcu&7,ii=i&3; const int qb=(ii==0)?s:(ii==1)?15-s:(ii==2)?16+s:31-s;
    const int b=grp>>3,h=grp&7; const int vcol=h*128;
    attn_unit128<THRL,false>(b,(2*h)*64,(2*h)*64,vcol,vcol,qb,Q,K,V,OA,lds,wv,HBo,lam,subg,osc);
    attn_unit128<THRL,true>(b,(2*h+1)*64,(2*h+1)*64,vcol,vcol,qb,Q,K,V,OA,lds,wv,HBo,lam,subg,osc); }
}
__device__ __forceinline__ void sb_attn_phase(char*lds,const bf16*Q,const bf16*K,const bf16*V,bf16*O,int G,int vcu,const int wv){
  const int wid=wv;
  for(int i=0;;++i){ const int grp=(vcu>>3)+(G>>3)*(i>>2); if(grp>=BATCH*NHEAD)break; const int rb=(((i&3)*8+(vcu&7))*8+wid);
    sb_item(grp>>4,grp&15,rb,Q,K,V,O,lds,wv); }
}
#undef SBAR
#undef WAIT_BAR
}

constexpr int NWAVES = 8;
constexpr int BATCH = 4, T = 8192, D = 1024, M = BATCH * T, NQKV = 3 * D, NE = 32, FF = 512;
constexpr float NORM_EPS = 1e-6f;
constexpr float C2 = 0.125f * 1.4426950408889634f;
constexpr float LAM_INIT0 = 0.2f;

constexpr size_t MiB = 1u << 20;
constexpr size_t WS_CTL = 0, CTL_ZERO_BYTES = 64 * 1024;
constexpr size_t WS_MOD = 1 * MiB;
constexpr size_t WS_GATEW = 1 * MiB + 256 * 1024;
constexpr size_t WS_WQKV = 2 * MiB, WS_WO = 14 * MiB, WS_W1 = 18 * MiB, WS_W2 = 146 * MiB;
constexpr size_t WS_HB = 210 * MiB;
constexpr size_t WS_Q = 274 * MiB, WS_K = 338 * MiB, WS_V = 402 * MiB, WS_OA = 466 * MiB;
constexpr size_t WS_Y2 = 274 * MiB;
constexpr size_t WS_HID = 402 * MiB;
constexpr size_t WS_LIST = 474 * MiB;
constexpr size_t WS_END = 530 * MiB;
constexpr int CW_TMO = 0, CW_CODE = 1, CW_BAR = 4096, CW_CNT = 8192;

constexpr int RING_OFF = 0, RING_BYTES = 135168;
constexpr int LDSCTL_OFF = RING_BYTES, MISC_OFF = LDSCTL_OFF + 320;
constexpr int TAB_CNT = LDSCTL_OFF + 512, TAB_PRE = LDSCTL_OFF + 640, TAB_BR = LDSCTL_OFF + 896, TAB_LCNT = LDSCTL_OFF + 1024, TAB_LBASE = LDSCTL_OFF + 1152;
constexpr int TAB_ASG_E = LDSCTL_OFF + 1280, TAB_ASG_S = LDSCTL_OFF + 2304, TAB_ASG_D = LDSCTL_OFF + 3328;
constexpr int LDS_BYTES = 147456;
static_assert(TAB_ASG_D + 1024 <= LDS_BYTES, "LDS map");
#define GAS __attribute__((address_space(1)))
#define LAS __attribute__((address_space(3)))
typedef unsigned short bf16;
typedef unsigned v4u __attribute__((ext_vector_type(4)));
typedef float f32x4 __attribute__((ext_vector_type(4)));
typedef short bf16x8 __attribute__((ext_vector_type(8)));
typedef GAS unsigned gu32;
typedef GAS unsigned long long gu64;
#define RLX_AGENT __ATOMIC_RELAXED, __HIP_MEMORY_SCOPE_AGENT
#define LDS_WAIT() asm volatile("s_waitcnt lgkmcnt(0)" ::: "memory")
#define VM_WAIT() asm volatile("s_waitcnt vmcnt(0)" ::: "memory")
__device__ __forceinline__ unsigned long long rt() { return __builtin_amdgcn_s_memrealtime(); }
__device__ __forceinline__ unsigned f2bf(float f) { unsigned u = __builtin_bit_cast(unsigned, f); return (u + 0x7fffu + ((u >> 16) & 1u)) >> 16; }
__device__ __forceinline__ unsigned pk2(float lo, float hi) { return f2bf(lo) | (f2bf(hi) << 16); }

#define XB_TMO      128
#define XB_XCNT(j)  (256  + 64 * (j))
#define XB_XSUB(j)  (1280 + 64 * (j))
#define XB_XGEN(j)  (2304 + 64 * (j))
#define XB_TOP      3328
#define XB_TOPGEN   3392
#define XCD_BAR_WORDS 3456
#define XB_SPIN_CAP (1u << 18)

__device__ __forceinline__ unsigned xb_ld(unsigned* p)              { return __hip_atomic_load(p, __ATOMIC_RELAXED, __HIP_MEMORY_SCOPE_AGENT); }
__device__ __forceinline__ unsigned xb_add(unsigned* p, unsigned v) { return __hip_atomic_fetch_add(p, v, __ATOMIC_RELAXED, __HIP_MEMORY_SCOPE_AGENT); }
__device__ __forceinline__ unsigned xb_xcc_id() { return (unsigned)__builtin_amdgcn_s_getreg((3 << 11) | 20) & 0xFu; }
#define XB_SPIN(cond, bar) do { unsigned _sp = 0; while (cond) { __builtin_amdgcn_s_sleep(1); \
    if ((++_sp & 255u) == 0u) { if (xb_ld(&(bar)[XB_TMO])) break; if (_sp > XB_SPIN_CAP) { atomicAdd(&(bar)[XB_TMO], 1u); break; } } } } while (0)

struct XcdBarrier {
    unsigned* bar; unsigned x; int wv;
    volatile LAS unsigned* st;
};

__device__ __forceinline__ XcdBarrier xcd_barrier_post(unsigned* bar, volatile LAS unsigned* st, int wv) {
    XcdBarrier b; b.bar = bar; b.x = xb_xcc_id(); b.st = st; b.wv = wv;
    if (threadIdx.x == 0) (void)xb_add(&bar[XB_XCNT(b.x)], 1u);
    return b;
}
__device__ __forceinline__ void xcd_barrier_complete(unsigned* bar, unsigned x, unsigned& nloc, unsigned& nx) {
    const unsigned G = gridDim.x * gridDim.y * gridDim.z;
    unsigned sum, cnt, mine, sp = 0u;
    for (;;) {
        sum = 0u; cnt = 0u; mine = 0u;
#pragma unroll
        for (unsigned j = 0; j < 16; ++j) { const unsigned c = xb_ld(&bar[XB_XCNT(j)]); sum += c; cnt += (c > 0u) ? 1u : 0u; mine = (j == x) ? c : mine; }
        if (sum == G) break;
        __builtin_amdgcn_s_sleep(1);
        if ((++sp & 255u) == 0u) { if (xb_ld(&bar[XB_TMO])) break; if (sp > XB_SPIN_CAP) { atomicAdd(&bar[XB_TMO], 1u); break; } }
    }
    nloc = mine > 0u ? mine : 1u; nx = cnt > 0u ? cnt : 1u;
}

__device__ __forceinline__ void xcd_barrier(const XcdBarrier& b) {
    asm volatile("s_waitcnt vmcnt(0)" ::: "memory");
    __syncthreads();
    if (b.wv == 0 && lane_id_() == 0) {
        unsigned* bar = b.bar; unsigned bx_ = b.x; asm volatile("" : "+s"(bx_));
        __builtin_amdgcn_s_waitcnt(0);
        unsigned nloc = b.st[0], nx = b.st[1];
        if (nloc == 0u) { xcd_barrier_complete(bar, bx_, nloc, nx); b.st[0] = nloc; b.st[1] = nx; }
        const unsigned old = xb_add(&bar[XB_XSUB(bx_)], 1u);
        const unsigned gen = old / nloc;
        if (old + 1u == (gen + 1u) * nloc) {
            __builtin_amdgcn_fence(__ATOMIC_RELEASE, "agent");
            asm volatile("s_waitcnt vmcnt(0)" ::: "memory");
            const unsigned og = xb_add(&bar[XB_TOP], 1u);
            const unsigned tg = og / nx;
            if (og + 1u == (tg + 1u) * nx) xb_add(&bar[XB_TOPGEN], 1u);
            else XB_SPIN(xb_ld(&bar[XB_TOPGEN]) == tg, bar);
            __builtin_amdgcn_fence(__ATOMIC_ACQUIRE, "agent");
            xb_add(&bar[XB_XGEN(bx_)], 1u);
            asm volatile("s_waitcnt vmcnt(0)" ::: "memory");
        } else {
            XB_SPIN(xb_ld(&bar[XB_XGEN(bx_)]) == gen, bar);
            __builtin_amdgcn_fence(__ATOMIC_ACQUIRE, "agent");
            asm volatile("s_waitcnt vmcnt(0)" ::: "memory");
        }
    }
    __syncthreads();
}

struct Args { const void* in[16]; float* out; unsigned char* ws; };
struct Frame {
    LAS unsigned char* lds;
    volatile LAS unsigned* MISC;
    gu32* ctl;
    int tid, lane, wave;
    int vcu, G;
    const __attribute__((address_space(4))) Args* a;
};
#define FIN(i)   ((const float*)F.a->in[i])
#define F_x FIN(0)
#define F_c FIN(1)
#define F_pos ((const int*)F.a->in[2])
#define F_w_ada FIN(3)
#define F_b_ada FIN(4)
#define F_norm_g FIN(5)
#define F_w_in FIN(6)
#define F_w_out FIN(7)
#define F_diff_lambda FIN(8)
#define F_subln_g FIN(9)
#define F_w_router FIN(10)
#define F_b_router FIN(11)
#define F_w_gate FIN(12)
#define F_w_up FIN(13)
#define F_w_down FIN(14)
#define F_final_g FIN(15)
#define F_out (F.a->out)
#define F_mod ((float*)(F.a->ws + WS_MOD))
#define F_gatew ((float*)(F.a->ws + WS_GATEW))
#define F_Wqkv_t ((bf16*)(F.a->ws + WS_WQKV))
#define F_Wo_t ((bf16*)(F.a->ws + WS_WO))
#define F_W1_t ((bf16*)(F.a->ws + WS_W1))
#define F_W2_t ((bf16*)(F.a->ws + WS_W2))
#define F_HB ((bf16*)(F.a->ws + WS_HB))
#define F_QB ((bf16*)(F.a->ws + WS_Q))
#define F_KB ((bf16*)(F.a->ws + WS_K))
#define F_VB ((bf16*)(F.a->ws + WS_V))
#define F_OA ((bf16*)(F.a->ws + WS_OA))
#define F_Y2 ((bf16*)(F.a->ws + WS_Y2))
#define F_HID ((bf16*)(F.a->ws + WS_HID))
#define F_list ((int*)(F.a->ws + WS_LIST))
typedef unsigned long long u64;
template <int X> __device__ __forceinline__ float swz_xor(float v) { return __int_as_float(__builtin_amdgcn_ds_swizzle(__float_as_int(v), (X << 10) | 0x1f)); }
__device__ __forceinline__ float half_sum(float v) {
    v += swz_xor<1>(v); v += swz_xor<2>(v); v += swz_xor<4>(v); v += swz_xor<8>(v); v += swz_xor<16>(v); return v;
}
__device__ __forceinline__ float wave_sum(float v) {
    v = half_sum(v);
    const auto rr = __builtin_amdgcn_permlane32_swap(__float_as_uint(v), __float_as_uint(v), false, false);
    return __uint_as_float(rr[0]) + __uint_as_float(rr[1]);
}
__device__ __forceinline__ float bf_lo(unsigned w) { return __uint_as_float(w << 16); }
__device__ __forceinline__ float bf_hi(unsigned w) { return __uint_as_float(w & 0xffff0000u); }
__device__ __forceinline__ f32x4 bf4_to_f32(u64 w) { const unsigned lo = (unsigned)w, hi = (unsigned)(w >> 32); return (f32x4){bf_lo(lo), bf_hi(lo), bf_lo(hi), bf_hi(hi)}; }
__device__ __forceinline__ u64 f32_to_bf4(f32x4 v) { return (u64)pk2(v.x, v.y) | ((u64)pk2(v.z, v.w) << 32); }

__device__ __forceinline__ int rowmap(int mode, int n) {
    if (mode == 1) { if (n >= 2048) return n; const int d = n & 63; const int p = d < 8 ? 2 * d : (d < 16 ? 2 * (d - 8) + 1 : d); return (n & ~63) + p; }
    if (mode == 2) return 256 * (n >> 7) + (n & 127);
    if (mode == 3) return 256 * (n >> 7) + 128 + (n & 127);
    return n;
}
struct P0Item { const float* W; bf16* WT; int N, K, mode, k0, n0; };
__device__ __forceinline__ void p0_item_load(f32x4 (&w)[16], const P0Item& it, int lane) {
    const float* p = it.W + (size_t)(it.k0 + (lane >> 4)) * it.N + it.n0 + 4 * (lane & 15);
#pragma unroll
    for (int i = 0; i < 16; ++i) w[i] = *(const f32x4*)(p + (size_t)(4 * i) * it.N);
}
__device__ __forceinline__ void p0_item_store(const f32x4 (&w)[16], const P0Item& it, LAS float* scr, int lane) {
    LAS float* wp = scr + (lane >> 4) * 65 + 4 * (lane & 15);
#pragma unroll
    for (int i = 0; i < 16; ++i) { LAS float* q = wp + (4 * i) * 65; q[0] = w[i].x; q[1] = w[i].y; q[2] = w[i].z; q[3] = w[i].w; }
    LDS_WAIT(); asm volatile("" ::: "memory");
    const int c = lane & 7;
#pragma unroll
    for (int j = 0; j < 8; ++j) { const int n = (lane >> 3) + 8 * j; const LAS float* s = scr + (8 * c) * 65 + n;
        v4u o; o.x = pk2(s[0 * 65], s[1 * 65]); o.y = pk2(s[2 * 65], s[3 * 65]); o.z = pk2(s[4 * 65], s[5 * 65]); o.w = pk2(s[6 * 65], s[7 * 65]);
        *(GAS v4u*)(it.WT + (size_t)rowmap(it.mode, it.n0 + n) * it.K + it.k0 + 8 * c) = o; }
    LDS_WAIT(); asm volatile("" ::: "memory");
}
constexpr int I_IN = (D / 64) * (NQKV / 64), I_O = (D / 64) * (D / 64), I_GU = (D / 64) * (FF / 64), I_DN = (FF / 64) * (D / 64);
constexpr int N_IN = 2 * I_IN, N_O = 2 * I_O, N_GU = 2 * NE * 2 * I_GU, N_DN = 2 * NE * I_DN, N_ALL = N_IN + N_O + N_GU + N_DN;
#define P0_DECODE(it_, X) do { int r = (it_); \
        if (r < N_IN) { const int l = r / I_IN, q = r % I_IN; X.W = F_w_in + (size_t)l * D * NQKV; X.WT = F_Wqkv_t + (size_t)l * NQKV * D; X.N = NQKV; X.K = D; X.mode = (l == 0) ? 1 : 0; X.k0 = 64 * (q / (NQKV / 64)); X.n0 = 64 * (q % (NQKV / 64)); break; } r -= N_IN; \
        if (r < N_O) { const int l = r / I_O, q = r % I_O; X.W = F_w_out + (size_t)l * D * D; X.WT = F_Wo_t + (size_t)l * D * D; X.N = D; X.K = D; X.mode = 0; X.k0 = 64 * (q / (D / 64)); X.n0 = 64 * (q % (D / 64)); break; } r -= N_O; \
        if (r < N_GU) { const int mat = r / I_GU, q = r % I_GU, le = mat >> 1, gu = mat & 1; X.W = (gu ? F_w_up : F_w_gate) + (size_t)le * D * FF; X.WT = F_W1_t + (size_t)le * 2 * FF * D; X.N = FF; X.K = D; X.mode = 2 + gu; X.k0 = 64 * (q / (FF / 64)); X.n0 = 64 * (q % (FF / 64)); break; } r -= N_GU; \
        { const int le = r / I_DN, q = r % I_DN; X.W = F_w_down + (size_t)le * FF * D; X.WT = F_W2_t + (size_t)le * D * FF; X.N = D; X.K = FF; X.mode = 0; X.k0 = 64 * (q / (D / 64)); X.n0 = 64 * (q % (D / 64)); } } while (0)
constexpr int N_P0 = N_IN + N_O + N_GU / 2 + N_DN / 2, N_DEFER = N_GU / 2 + N_DN / 2;
#define P0_ORIG(it_) ((it_) < N_IN + N_O + N_GU / 2 ? (it_) : (it_) + N_GU / 2)
#define DEFER_ORIG(j_) ((j_) < N_GU / 2 ? N_IN + N_O + N_GU / 2 + (j_) : N_IN + N_O + N_GU + N_DN / 2 + ((j_) - N_GU / 2))
__device__ __forceinline__ void p0_prologue(Frame& F) {
    {
        LAS float* sc = (LAS float*)(F.lds);
        LAS float* red = (LAS float*)(F.lds + 16384);
        for (int i = F.tid; i < BATCH * D; i += NWAVES * 64) { const float cv = F_c[i]; sc[i] = cv / (1.f + __expf(-cv)); }
        __syncthreads();
        const int kg = F.tid >> 5, cc = F.tid & 31;
        for (int task = blockIdx.x; task < 2 * 192; task += F.G) {
            const int l = task / 192, col0 = (task % 192) * 32;
            const float* W = F_w_ada + (size_t)l * D * 6144 + col0 + cc;
            float a0 = 0.f, a1 = 0.f, a2 = 0.f, a3 = 0.f;
#pragma unroll 8
            for (int k = kg * 64; k < kg * 64 + 64; ++k) { const float w = W[(size_t)k * 6144]; a0 += sc[k] * w; a1 += sc[1024 + k] * w; a2 += sc[2048 + k] * w; a3 += sc[3072 + k] * w; }
            red[(kg * 4 + 0) * 32 + cc] = a0; red[(kg * 4 + 1) * 32 + cc] = a1; red[(kg * 4 + 2) * 32 + cc] = a2; red[(kg * 4 + 3) * 32 + cc] = a3;
            __syncthreads();
            if (F.tid < 128) { const int b = F.tid >> 5; float s = F_b_ada[l * 6144 + col0 + cc];
#pragma unroll
                for (int g = 0; g < 16; ++g) s += red[(g * 4 + b) * 32 + cc];
                F_mod[(size_t)(l * 4 + b) * 6144 + col0 + cc] = s; }
            __syncthreads();
        }
    }
    const int gw = F.vcu * NWAVES + F.wave, NGW = F.G * NWAVES;
    f32x4 wa[16], wb[16]; P0Item ia, ib; LAS float* scr = (LAS float*)(F.lds + RING_OFF + F.wave * 16640);
    int it = gw;
    if (it < N_P0) { P0_DECODE(P0_ORIG(it), ia); p0_item_load(wa, ia, F.lane); }
    while (it < N_P0) {
        const int it1 = it + NGW; const bool h1 = it1 < N_P0;
        if (h1) { P0_DECODE(P0_ORIG(it1), ib); p0_item_load(wb, ib, F.lane); }
        p0_item_store(wa, ia, scr, F.lane);
        if (!h1) break;
        const int it2 = it1 + NGW; const bool h2 = it2 < N_P0;
        if (h2) { P0_DECODE(P0_ORIG(it2), ia); p0_item_load(wa, ia, F.lane); }
        p0_item_store(wb, ib, scr, F.lane);
        it = it2;
    }
}

template <bool COMBINE> __device__ __forceinline__ void n1_phase(Frame& F, const int l, const float* xin, float* xout) {
    const int gw = F.vcu * NWAVES + F.wave, NGW = F.G * NWAVES, RPW = (M + NGW - 1) / NGW;
    const int m0 = gw * RPW, m1 = (m0 + RPW < M) ? m0 + RPW : M;
    int bcur = -1; f32x4 gs[4], sh[4], gm[4];
#pragma unroll
    for (int j = 0; j < 4; ++j) { gs[j] = (f32x4){0.f, 0.f, 0.f, 0.f}; sh[j] = gs[j]; gm[j] = gs[j]; }
    const float* ng = F_norm_g + (size_t)(l * 2 + 0) * D;
    for (int m = m0; m < m1; ++m) {
        const int b = m / T;
        if (b != bcur) { bcur = b; const float* mp = F_mod + (size_t)(l * 4 + b) * 6144;
#pragma unroll
            for (int j = 0; j < 4; ++j) { const int col = 4 * F.lane + 256 * j; const f32x4 g = *(const f32x4*)(ng + col), sc = *(const f32x4*)(mp + 1024 + col);
                gs[j] = g * (sc + 1.0f); sh[j] = *(const f32x4*)(mp + col);
                if (COMBINE) gm[j] = *(const f32x4*)(F_mod + (size_t)((l - 1) * 4 + b) * 6144 + 5120 + col); } }
        const GAS f32x4* xr = (const GAS f32x4*)(xin + (size_t)m * D) + F.lane;
        f32x4 v[4];
#pragma unroll
        for (int j = 0; j < 4; ++j) v[j] = xr[64 * j];
        if (COMBINE) { const GAS u64* ya = (const GAS u64*)(F_Y2 + (size_t)(2 * m) * D) + F.lane; const GAS u64* yb = ya + D / 4;
            GAS f32x4* xo = (GAS f32x4*)(xout + (size_t)m * D) + F.lane;
            const float w0 = F_gatew[2 * m], w1 = F_gatew[2 * m + 1];
#pragma unroll
            for (int j = 0; j < 4; ++j) { const f32x4 fa = bf4_to_f32(ya[64 * j]), fb = bf4_to_f32(yb[64 * j]); v[j] = v[j] + gm[j] * (fa * w0 + fb * w1); xo[64 * j] = v[j]; } }
        float s2 = 0.f;
#pragma unroll
        for (int j = 0; j < 4; ++j) s2 += (v[j].x * v[j].x + v[j].y * v[j].y) + (v[j].z * v[j].z + v[j].w * v[j].w);
        const float rstd = __builtin_amdgcn_rsqf(wave_sum(s2) * (1.f / D) + NORM_EPS);
        GAS u64* o8 = (GAS u64*)(F_HB + (size_t)m * D) + F.lane;
#pragma unroll
        for (int j = 0; j < 4; ++j) o8[64 * j] = f32_to_bf4(v[j] * rstd * gs[j] + sh[j]);
    }
}
__device__ __forceinline__ void final_phase(Frame& F, const float* xin, float* xout) {
    const int gw = F.vcu * NWAVES + F.wave, NGW = F.G * NWAVES, RPW = (M + NGW - 1) / NGW;
    const int m0 = gw * RPW, m1 = (m0 + RPW < M) ? m0 + RPW : M;
    int bcur = -1; f32x4 fg[4], gm[4];
#pragma unroll
    for (int j = 0; j < 4; ++j) { fg[j] = *(const f32x4*)(F_final_g + 4 * F.lane + 256 * j); gm[j] = (f32x4){0.f, 0.f, 0.f, 0.f}; }
    for (int m = m0; m < m1; ++m) {
        const int b = m / T;
        if (b != bcur) { bcur = b;
#pragma unroll
            for (int j = 0; j < 4; ++j) gm[j] = *(const f32x4*)(F_mod + (size_t)(1 * 4 + b) * 6144 + 5120 + 4 * F.lane + 256 * j); }
        const GAS f32x4* xr = (const GAS f32x4*)(xin + (size_t)m * D) + F.lane;
        const GAS u64* ya = (const GAS u64*)(F_Y2 + (size_t)(2 * m) * D) + F.lane; const GAS u64* yb = ya + D / 4;
        f32x4 v[4]; float s2 = 0.f; const float w0 = F_gatew[2 * m], w1 = F_gatew[2 * m + 1];
#pragma unroll
        for (int j = 0; j < 4; ++j) { v[j] = xr[64 * j] + gm[j] * (bf4_to_f32(ya[64 * j]) * w0 + bf4_to_f32(yb[64 * j]) * w1); s2 += (v[j].x * v[j].x + v[j].y * v[j].y) + (v[j].z * v[j].z + v[j].w * v[j].w); }
        const float rstd = __builtin_amdgcn_rsqf(wave_sum(s2) * (1.f / D) + NORM_EPS);
        GAS f32x4* xo = (GAS f32x4*)(xout + (size_t)m * D) + F.lane;
#pragma unroll
        for (int j = 0; j < 4; ++j) xo[64 * j] = v[j] * rstd * fg[j];
    }
}
__device__ __forceinline__ int crow_(int r, int hi) { return (r & 3) + 8 * (r >> 2) + 4 * hi; }
__device__ __forceinline__ void n2_phase(Frame& F, const int l, const float* xin, const int cset) {
    typedef float f32x16 __attribute__((ext_vector_type(16)));
    LAS float* tileA = (LAS float*)F.lds;
    LAS float* part = (LAS float*)F.lds;
    LAS float* logit = (LAS float*)(F.lds + 65536);
    LAS int* lcnt = (LAS int*)(F.lds + TAB_LCNT); LAS int* lbase = (LAS int*)(F.lds + TAB_LBASE);
    LAS int* asg_e = (LAS int*)(F.lds + TAB_ASG_E); LAS int* asg_s = (LAS int*)(F.lds + TAB_ASG_S); LAS int* asg_d = (LAS int*)(F.lds + TAB_ASG_D);
    LAS float* br = (LAS float*)(F.lds + TAB_BR);
    if (F.tid < 32) { lcnt[F.tid] = 0; br[F.tid] = F_b_router[F.tid]; }
    __syncthreads();
    gu32* gcnt = F.ctl + CW_CNT + 64 * cset;
    const float* ng = F_norm_g + (size_t)(l * 2 + 1) * D;
    const int ei = F.lane & 31, kk = F.lane >> 5;
    typedef short bf16x8_t __attribute__((ext_vector_type(8)));
    bf16x8_t whi[8], wlo[8];
#pragma unroll
    for (int sx = 0; sx < 8; ++sx) { v4u h4, l4;
#pragma unroll
        for (int jp = 0; jp < 4; ++jp) { const int k0 = 128 * F.wave + 16 * sx + 8 * kk + 2 * jp; const float w0 = F_w_router[k0 * 32 + ei], w1 = F_w_router[(k0 + 1) * 32 + ei];
            const unsigned hp = pg8::cvt_pk_bf16(w0, w1); h4[jp] = hp; l4[jp] = pg8::cvt_pk_bf16(w0 - bf_lo(hp), w1 - bf_hi(hp)); }
        whi[sx] = __builtin_bit_cast(bf16x8_t, h4); wlo[sx] = __builtin_bit_cast(bf16x8_t, l4); }
    constexpr int NT32 = M / 32;
#define N2_TILE(n) (F.vcu * 4 + ((n) >> 2) * F.G * 4 + ((n) & 3))
#define N2_LOAD(tile_) do { _Pragma("unroll") for (int rr = 0; rr < 4; ++rr) { const size_t m_ = (size_t)((tile_) * 32 + 4 * F.wave + rr); const GAS f32x4* xr = (const GAS f32x4*)(xin + m_ * D) + F.lane; \
        _Pragma("unroll") for (int j = 0; j < 4; ++j) v[rr][j] = xr[64 * j]; } } while (0)
    f32x4 v[4][4];
    int n = 0, tile = N2_TILE(0); bool have = tile < NT32;
    if (have) N2_LOAD(tile);
    while (have) {
        const int ti = n & 3, row0 = tile * 32, b = row0 / T; u64 mx[4][4];
#pragma unroll
        for (int rr = 0; rr < 4; ++rr) { const GAS u64* mr = (const GAS u64*)(F_QB + (size_t)(row0 + 4 * F.wave + rr) * D) + F.lane;
#pragma unroll
            for (int j = 0; j < 4; ++j) mx[rr][j] = mr[64 * j]; }
        const float* mp = F_mod + (size_t)(l * 4 + b) * 6144 + 3072;
        float s2[4] = {0.f, 0.f, 0.f, 0.f};
#pragma unroll
        for (int j = 0; j < 4; ++j) { const int col = 4 * F.lane + 256 * j; const f32x4 gaj = *(const f32x4*)(mp - 1024 + col);
#pragma unroll
            for (int rr = 0; rr < 4; ++rr) { const f32x4 x1 = v[rr][j] + gaj * bf4_to_f32(mx[rr][j]); v[rr][j] = x1;
                *((GAS f32x4*)(F_out + (size_t)(row0 + 4 * F.wave + rr) * D + col)) = x1; s2[rr] += (x1.x * x1.x + x1.y * x1.y) + (x1.z * x1.z + x1.w * x1.w); } }
#pragma unroll
        for (int rr = 0; rr < 4; ++rr) s2[rr] = wave_sum(s2[rr]);
        float rstd[4];
#pragma unroll
        for (int rr = 0; rr < 4; ++rr) rstd[rr] = __builtin_amdgcn_rsqf(s2[rr] * (1.f / D) + NORM_EPS);
#pragma unroll
        for (int j = 0; j < 4; ++j) { const int col = 4 * F.lane + 256 * j; const f32x4 g = *(const f32x4*)(ng + col), sc = *(const f32x4*)(mp + 1024 + col), shj = *(const f32x4*)(mp + col); const f32x4 gsj = g * (sc + 1.0f);
#pragma unroll
            for (int rr = 0; rr < 4; ++rr) { const int r = 4 * F.wave + rr; const f32x4 h = v[rr][j] * rstd[rr] * gsj + shj;
                *((GAS u64*)(F_HB + (size_t)(row0 + r) * D + col)) = f32_to_bf4(h); *(LAS f32x4*)(tileA + r * 1028 + col) = h; } }
        const int n1 = n + 1, tile1 = N2_TILE(n1); const bool have1 = tile1 < NT32;
        if (have1) N2_LOAD(tile1);
        __syncthreads();
        f32x16 acc = {};
#pragma unroll
        for (int sx = 0; sx < 8; ++sx) { const LAS float* ap = tileA + ei * 1028 + 128 * F.wave + 16 * sx + 8 * kk; const f32x4 a0 = *(const LAS f32x4*)ap, a1 = *(const LAS f32x4*)(ap + 4);
            v4u h4, l4;
            h4[0] = pg8::cvt_pk_bf16(a0.x, a0.y); h4[1] = pg8::cvt_pk_bf16(a0.z, a0.w); h4[2] = pg8::cvt_pk_bf16(a1.x, a1.y); h4[3] = pg8::cvt_pk_bf16(a1.z, a1.w);
            l4[0] = pg8::cvt_pk_bf16(a0.x - bf_lo(h4[0]), a0.y - bf_hi(h4[0])); l4[1] = pg8::cvt_pk_bf16(a0.z - bf_lo(h4[1]), a0.w - bf_hi(h4[1]));
            l4[2] = pg8::cvt_pk_bf16(a1.x - bf_lo(h4[2]), a1.y - bf_hi(h4[2])); l4[3] = pg8::cvt_pk_bf16(a1.z - bf_lo(h4[3]), a1.w - bf_hi(h4[3]));
            const bf16x8_t ahi = __builtin_bit_cast(bf16x8_t, h4), alo = __builtin_bit_cast(bf16x8_t, l4);
            acc = __builtin_amdgcn_mfma_f32_32x32x16_bf16(ahi, whi[sx], acc, 0, 0, 0); acc = __builtin_amdgcn_mfma_f32_32x32x16_bf16(ahi, wlo[sx], acc, 0, 0, 0);
            acc = __builtin_amdgcn_mfma_f32_32x32x16_bf16(alo, whi[sx], acc, 0, 0, 0); }
        __syncthreads();
#pragma unroll
        for (int r = 0; r < 16; ++r) part[(F.wave * 32 + crow_(r, kk)) * 33 + ei] = acc[r];
        __syncthreads();
        { const int row = F.tid >> 4;
#pragma unroll
            for (int e2 = 0; e2 < 32; e2 += 16) { const int e = (F.tid & 15) + e2; float s = 0.f;
#pragma unroll
                for (int w = 0; w < 8; ++w) s += part[(w * 32 + row) * 33 + e];
                logit[row * 33 + e] = s; } }
        __syncthreads();
        if (F.tid < 32) { const int row = F.tid, m = row0 + row; const LAS float* lg = logit + row * 33;
            float mx = lg[0];
#pragma unroll
            for (int e = 1; e < 32; ++e) mx = fmaxf(mx, lg[e]);
            float sum = 0.f;
#pragma unroll
            for (int e = 0; e < 32; ++e) sum += __expf(lg[e] - mx);
            const float inv = 1.0f / sum;
            float bestg = -INFINITY; int gb = 0;
#pragma unroll
            for (int g = 0; g < 4; ++g) { float t1 = -INFINITY, t2 = -INFINITY;
#pragma unroll
                for (int jj = 0; jj < 8; ++jj) { const int e = 8 * g + jj; const float sv = __expf(lg[e] - mx) * inv + br[e]; if (sv > t1) { t2 = t1; t1 = sv; } else if (sv > t2) t2 = sv; }
                const float gsv = t1 + t2; if (gsv > bestg) { bestg = gsv; gb = g; } }
            float t1 = -INFINITY, t2 = -INFINITY; int i1 = 0, i2 = 0;
#pragma unroll
            for (int jj = 0; jj < 8; ++jj) { const int e = 8 * gb + jj; const float sv = __expf(lg[e] - mx) * inv + br[e]; if (sv > t1) { t2 = t1; i2 = i1; t1 = sv; i1 = jj; } else if (sv > t2) { t2 = sv; i2 = jj; } }
            const int e1 = 8 * gb + i1, e2 = 8 * gb + i2;
            const float sc1 = __expf(lg[e1] - mx) * inv, sc2 = __expf(lg[e2] - mx) * inv, ig = 1.0f / (sc1 + sc2);
            const int a = (ti * 32 + row) * 2;
            asg_e[a] = e1; asg_s[a] = atomicAdd((int*)(lcnt + e1), 1); asg_d[a] = 2 * m; F_gatew[2 * m] = sc1 * ig;
            asg_e[a + 1] = e2; asg_s[a + 1] = atomicAdd((int*)(lcnt + e2), 1); asg_d[a + 1] = 2 * m + 1; F_gatew[2 * m + 1] = sc2 * ig; }
        __syncthreads();
        if (ti == 3 || !have1) {
            if (F.tid < 32) { int te = F.tid; asm volatile("" : "+v"(te));
                const int cnum = lcnt[te]; lbase[te] = cnum ? (int)__hip_atomic_fetch_add(gcnt + te, (unsigned)cnum, RLX_AGENT) : 0; lcnt[te] = 0; }
            __syncthreads();
            if (F.tid < 64 * (ti + 1)) { const int e = asg_e[F.tid]; F_list[(size_t)e * M + lbase[e] + asg_s[F.tid]] = asg_d[F.tid]; }
            __syncthreads();
        }
        n = n1; tile = tile1; have = have1;
    }
#undef N2_TILE
#undef N2_LOAD
}
__device__ __forceinline__ void load_counts(Frame& F, const int l) {
    LAS int* cnt = (LAS int*)(F.lds + TAB_CNT); LAS int* pre = (LAS int*)(F.lds + TAB_PRE);
    if (F.tid < 32) cnt[F.tid] = (int)__hip_atomic_load(F.ctl + CW_CNT + 64 * l + F.tid, RLX_AGENT);
    __syncthreads();
    if (F.tid == 0) { int s = 0; for (int e = 0; e < 32; ++e) { pre[e] = s; s += (cnt[e] + 255) >> 8; } pre[32] = s; }
    __syncthreads();
}

__device__ __forceinline__ void conv_item_swz(const P0Item& it, LAS float* scr, int lane_) {
    int lane = lane_; asm volatile("" : "+v"(lane));
    f32x4 w[16]; p0_item_load(w, it, lane);
    const int kk = lane >> 4, nn = 4 * (lane & 15);
#pragma unroll
    for (int i = 0; i < 16; ++i) { const int k = 4 * i + kk, x = k & 31; LAS float* q = scr + k * 64;
        q[(nn + 0) ^ x] = w[i].x; q[(nn + 1) ^ x] = w[i].y; q[(nn + 2) ^ x] = w[i].z; q[(nn + 3) ^ x] = w[i].w; }
    LDS_WAIT(); asm volatile("" ::: "memory");
    const int c = lane & 7;
#pragma unroll
    for (int j = 0; j < 8; ++j) { const int n = (lane >> 3) + 8 * j; float v[8];
#pragma unroll
        for (int q = 0; q < 8; ++q) { const int k = 8 * c + q; v[q] = scr[k * 64 + (n ^ (k & 31))]; }
        v4u o; o.x = pk2(v[0], v[1]); o.y = pk2(v[2], v[3]); o.z = pk2(v[4], v[5]); o.w = pk2(v[6], v[7]);
        *(GAS v4u*)(it.WT + (size_t)rowmap(it.mode, it.n0 + n) * it.K + it.k0 + 8 * c) = o; }
    LDS_WAIT(); asm volatile("" ::: "memory");
}
__device__ __forceinline__ void sb_phase(Frame& F, char* ldsg) {
    const int gw = F.vcu * NWAVES + F.wave, NGW = F.G * NWAVES; int cj = gw;
    LAS float* scr = (LAS float*)(F.lds + RING_OFF + F.wave * 16384);
    for (int i = 0;; ++i) { const int grp = (F.vcu >> 3) + (F.G >> 3) * (i >> 2); if (grp >= BATCH * 16) break; const int rb = (((i & 3) * 8 + (F.vcu & 7)) * 8 + F.wave);
        attn_body::sb_item(grp >> 4, grp & 15, rb, (const attn_body::bf16*)F_QB, (const attn_body::bf16*)F_KB, (const attn_body::bf16*)F_VB, (attn_body::bf16*)F_OA, ldsg, F.wave);
        __builtin_amdgcn_sched_barrier(0);
        if (cj < N_DEFER) { int cjo = cj; asm volatile("" : "+s"(cjo));
            P0Item ci; P0_DECODE(DEFER_ORIG(cjo), ci); conv_item_swz(ci, scr, F.lane); cj += NGW; }
        __builtin_amdgcn_sched_barrier(0); }
    while (cj < N_DEFER) { P0Item ci; P0_DECODE(DEFER_ORIG(cj), ci); conv_item_swz(ci, scr, F.lane); cj += NGW; }
}
__global__ void __launch_bounds__(NWAVES * 64, 2) fwd_kernel(Args args) {
    extern __shared__ __attribute__((aligned(16))) unsigned char lds[];
    Frame F;
    F.lds = (LAS unsigned char*)lds;
    F.MISC = (volatile LAS unsigned*)(F.lds + MISC_OFF);
    F.tid = threadIdx.x; F.lane = F.tid & 63; F.wave = __builtin_amdgcn_readfirstlane(F.tid >> 6);
    F.G = gridDim.x; { const int bx = blockIdx.x; F.vcu = (F.G % 8 == 0) ? (bx % 8) * (F.G / 8) + bx / 8 : bx; }
    F.a = (const __attribute__((address_space(4))) Args*)__builtin_amdgcn_kernarg_segment_ptr(); (void)args; F.ctl = (gu32*)(F.a->ws + WS_CTL);
    for (int u = F.tid; u < (LDS_BYTES - LDSCTL_OFF) / 4; u += NWAVES * 64) ((LAS unsigned*)(F.lds + LDSCTL_OFF))[u] = 0u;
    __syncthreads();
    XcdBarrier bar = xcd_barrier_post((unsigned*)(F.ctl + CW_BAR), F.MISC + 8, F.wave);
#define GRID_BAR() xcd_barrier(bar)
#ifndef PH_MASK
#define PH_MASK 0xFFFFFFu
#endif
#ifndef DUP_MASK
#define DUP_MASK 0u
#endif
#ifndef STAMP_PH
#define STAMP_PH (-1)
#endif
#ifndef STAMP_BLK
#define STAMP_BLK 0
#endif
#ifndef STAMP_AMP
#define STAMP_AMP 4
#endif
    unsigned long long tsa_ = 0ull, tsb_ = 0ull; if (STAMP_PH == 100) tsa_ = rt();
#define PH(k) if constexpr (((PH_MASK) >> (k)) & 1u) _Pragma("unroll") for (int rep_ = 0, phk_ = (k); rep_ < 1 + (int)(((DUP_MASK) >> (k)) & 1u); ++rep_)
#define PHASE_END() do { if (STAMP_PH >= 200 && phk_ == STAMP_PH - 200) tsb_ = rt(); } while (0)
#define PHASE_BEGIN() do { if (STAMP_PH >= 0 && (phk_ == STAMP_PH || phk_ == STAMP_PH - 200)) tsa_ = rt(); if (STAMP_PH >= 0 && STAMP_PH < 100 && phk_ > STAMP_PH && tsb_ == 0ull) tsb_ = rt(); int t_ = F.wave * 64 + lane_id_(); asm volatile("" : "+v"(t_)); F.tid = t_; F.lane = t_ & 63; unsigned long long ka_ = (unsigned long long)F.a; asm volatile("" : "+s"(ka_)); F.a = (const __attribute__((address_space(4))) Args*)ka_; } while (0)
    const LAS int* tcnt = (const LAS int*)(F.lds + TAB_CNT); const LAS int* tpre = (const LAS int*)(F.lds + TAB_PRE);

    PH(0) { if (rep_) GRID_BAR(); PHASE_BEGIN();
    p0_prologue(F);
    PHASE_END(); }
    GRID_BAR();
    PH(1) { if (rep_) GRID_BAR(); PHASE_BEGIN();

    n1_phase<false>(F, 0, F_x, nullptr);
    PHASE_END(); }
    GRID_BAR();
    PH(2) { if (rep_) GRID_BAR(); PHASE_BEGIN();
    {
        pg8::StaticOrder S; S.init(F_HB, F_Wqkv_t, M, NQKV, D, F.G, (int)blockIdx.x);
        pg8::EpiQKV E{F_QB, (size_t)(WS_K - WS_Q) / 2, C2, F_pos, 1};
        pg8::gemm_phase<pg8::EpiQKV, pg8::StaticOrder, true, false>(F.lds + RING_OFF, D, S, E, F.wave);
    }
    PHASE_END(); }
    GRID_BAR();
    PH(3) { if (rep_) GRID_BAR(); PHASE_BEGIN();
    {
        const float s1 = wave_sum(F_diff_lambda[F.lane] * F_diff_lambda[64 + F.lane]), s2l = wave_sum(F_diff_lambda[128 + F.lane] * F_diff_lambda[192 + F.lane]);
        const float lam = __expf(s1) - __expf(s2l) + LAM_INIT0;
        attn_body::diff_attn_phase<8>((char*)lds + RING_OFF, (const attn_body::bf16*)F_QB, (const attn_body::bf16*)F_KB, (const attn_body::bf16*)F_VB, (attn_body::bf16*)F_out, (attn_body::bf16*)F_HB,
                                      lam, F_subln_g, 1.0f - LAM_INIT0, F.G, F.vcu, F.wave);
    }
    PHASE_END(); }
    GRID_BAR();
    PH(5) { if (rep_) GRID_BAR(); PHASE_BEGIN();
    {
        pg8::StaticOrder S; S.init(F_HB, F_Wo_t, M, D, D, F.G, (int)blockIdx.x);
        pg8::EpiPlain E{F_QB, D};
        pg8::gemm_phase<pg8::EpiPlain, pg8::StaticOrder, true, false>(F.lds + RING_OFF, D, S, E, F.wave);
    }
    PHASE_END(); }
    GRID_BAR();
    PH(6) { if (rep_) GRID_BAR(); PHASE_BEGIN();
    n2_phase(F, 0, F_x, rep_ ? 2 : 0);
    PHASE_END(); }
    GRID_BAR();
    PH(7) { if (rep_) GRID_BAR(); PHASE_BEGIN();
    load_counts(F, 0);
    {
        pg8::GroupedOrder<4, true> S{tcnt, tpre, F.G, F.vcu, D, M, (const char*)F_HB, (const char*)F_W1_t, (size_t)2 * FF * D * 2, F_list};
        pg8::EpiSwiGLU E{F_HID};
        pg8::gemm_phase<pg8::EpiSwiGLU, pg8::GroupedOrder<4, true>, true, true>(F.lds + RING_OFF, D, S, E, F.wave);
    }
    PHASE_END(); }
    GRID_BAR();
    PH(8) { if (rep_) GRID_BAR(); PHASE_BEGIN();
    {
        pg8::GroupedOrder<4, false> S{tcnt, tpre, F.G, F.vcu, FF, M, (const char*)F_HID, (const char*)F_W2_t, (size_t)D * FF * 2, F_list};
        pg8::EpiDown E{F_Y2, F_list, tcnt, M};
        pg8::gemm_phase<pg8::EpiDown, pg8::GroupedOrder<4, false>, true, false>(F.lds + RING_OFF, FF, S, E, F.wave);
    }
    PHASE_END(); }
    GRID_BAR();
    PH(9) { if (rep_) GRID_BAR(); PHASE_BEGIN();

    n1_phase<true>(F, 1, F_out, F_out);
    PHASE_END(); }
    GRID_BAR();
    PH(10) { if (rep_) GRID_BAR(); PHASE_BEGIN();
    {
        pg8::StaticOrder S; S.init(F_HB, F_Wqkv_t + (size_t)NQKV * D, M, NQKV, D, F.G, (int)blockIdx.x);
        pg8::EpiQKV E{F_QB, (size_t)(WS_K - WS_Q) / 2, C2, F_pos, 0};
        pg8::gemm_phase<pg8::EpiQKV, pg8::StaticOrder, true, false>(F.lds + RING_OFF, D, S, E, F.wave);
    }
    PHASE_END(); }
    GRID_BAR();
    PH(11) { if (rep_) GRID_BAR(); PHASE_BEGIN();
    sb_phase(F, (char*)lds + RING_OFF);
    PHASE_END(); }
    GRID_BAR();
    PH(12) { if (rep_) GRID_BAR(); PHASE_BEGIN();
    {
        pg8::StaticOrder S; S.init(F_OA, F_Wo_t + (size_t)D * D, M, D, D, F.G, (int)blockIdx.x);
        pg8::EpiPlain E{F_QB, D};
        pg8::gemm_phase<pg8::EpiPlain, pg8::StaticOrder, true, false>(F.lds + RING_OFF, D, S, E, F.wave);
    }
    PHASE_END(); }
    GRID_BAR();
    PH(13) { if (rep_) GRID_BAR(); PHASE_BEGIN();
    n2_phase(F, 1, F_out, rep_ ? 3 : 1);
    PHASE_END(); }
    GRID_BAR();
    PH(14) { if (rep_) GRID_BAR(); PHASE_BEGIN();
    load_counts(F, 1);
    {
        pg8::GroupedOrder<4, true> S{tcnt, tpre, F.G, F.vcu, D, M, (const char*)F_HB, (const char*)(F_W1_t + (size_t)NE * 2 * FF * D), (size_t)2 * FF * D * 2, F_list};
        pg8::EpiSwiGLU E{F_HID};
        pg8::gemm_phase<pg8::EpiSwiGLU, pg8::GroupedOrder<4, true>, true, true>(F.lds + RING_OFF, D, S, E, F.wave);
    }
    PHASE_END(); }
    GRID_BAR();
    PH(15) { if (rep_) GRID_BAR(); PHASE_BEGIN();
    {
        pg8::GroupedOrder<4, false> S{tcnt, tpre, F.G, F.vcu, FF, M, (const char*)F_HID, (const char*)(F_W2_t + (size_t)NE * D * FF), (size_t)D * FF * 2, F_list};
        pg8::EpiDown E{F_Y2, F_list, tcnt, M};
        pg8::gemm_phase<pg8::EpiDown, pg8::GroupedOrder<4, false>, true, false>(F.lds + RING_OFF, FF, S, E, F.wave);
    }
    PHASE_END(); }
    GRID_BAR();
    PH(16) { if (rep_) GRID_BAR(); PHASE_BEGIN();
    final_phase(F, F_out, F_out);

    }
    if (STAMP_PH >= 0 && blockIdx.x == STAMP_BLK && F.wave == 0 && lane_id_() == 0) { const unsigned long long tend = rt(); if (STAMP_PH == 16 || STAMP_PH == 100) tsb_ = tend;
        const unsigned long long need = (unsigned long long)STAMP_AMP * (tsb_ - tsa_); while (rt() - tend < need) __builtin_amdgcn_s_sleep(8); }
#undef GRID_BAR
}

extern "C" void kernel_launch(void* const* d_in, const int* in_sizes, int n_in, void* d_out, int out_size, void* d_ws, size_t ws_size, hipStream_t stream) {
    static int grid = 0;
    if (grid == 0) {
        if (n_in != 16 || in_sizes[0] != M * D || out_size != M * D || ws_size < WS_END) { fprintf(stderr, "kernel_launch: built for 16 inputs, x and out of %d floats, >= %zu bytes of workspace; got n_in %d, in0 %d, out %d, ws %zu; nothing launched\n", M * D, (size_t)WS_END, n_in, n_in > 0 ? in_sizes[0] : -1, out_size, ws_size); grid = -1; return; }
        int dev = 0, cus = 0, per_cu = 0;
        if (hipGetDevice(&dev) != hipSuccess || hipDeviceGetAttribute(&cus, hipDeviceAttributeMultiprocessorCount, dev) != hipSuccess) { fprintf(stderr, "kernel_launch: hipGetDevice / hipDeviceGetAttribute failed\n"); grid = -1; return; }
        if (hipFuncSetAttribute((const void*)fwd_kernel, hipFuncAttributeMaxDynamicSharedMemorySize, LDS_BYTES) != hipSuccess) { fprintf(stderr, "kernel_launch: hipFuncSetAttribute failed\n"); grid = -1; return; }
        if (hipOccupancyMaxActiveBlocksPerMultiprocessor(&per_cu, (const void*)fwd_kernel, NWAVES * 64, LDS_BYTES) != hipSuccess || per_cu < 1) { fprintf(stderr, "kernel_launch: occupancy query reports %d workgroups per CU\n", per_cu); }
        (void)hipGetLastError();
        grid = cus;
        if (grid > 256) grid = 256;
        grid -= grid % 8;
    }
    if (grid <= 0) return;
    if (hipMemsetAsync((char*)d_ws + WS_CTL, 0, CTL_ZERO_BYTES, stream) != hipSuccess) { fprintf(stderr, "kernel_launch: hipMemsetAsync failed\n"); return; }
    Args a{};
    for (int i = 0; i < 16; ++i) a.in[i] = d_in[i];
    a.out = (float*)d_out; a.ws = (unsigned char*)d_ws;
    hipLaunchKernelGGL(fwd_kernel, dim3(grid), dim3(NWAVES * 64), LDS_BYTES, stream, a);
    const hipError_t le = hipPeekAtLastError();
    if (le != hipSuccess) fprintf(stderr, "kernel_launch: launch failed: %s\n", hipGetErrorName(le));
}
```

```cpp
#include <hip/hip_runtime.h>
#include <hip/hip_bf16.h>
#include <cstdio>
#include <cstdint>
#include <cmath>
__device__ __forceinline__ int lane_id_() { return (int)__builtin_amdgcn_mbcnt_hi(~0u, __builtin_amdgcn_mbcnt_lo(~0u, 0u)); }
namespace pg8 {
#define PG8_LAS __attribute__((address_space(3)))
typedef unsigned short bf16_t;
typedef short bf16x8 __attribute__((ext_vector_type(8)));
typedef float f32x4 __attribute__((ext_vector_type(4)));
typedef unsigned u32x4 __attribute__((ext_vector_type(4)));
constexpr int BM = 256, BK = 64, HALF = 128, HTB = HALF * BK * 2  , STAGE_BYTES = 8 * HTB, NXCD = 8, WGM = 8;

__host__ __device__ __forceinline__ int lds_byte(int r, int c) { const int st = (r >> 4) * 2 + (c >> 5), rr = r & 15, cc = c & 31, ob = rr * 64 + cc * 2; return st * 1024 + (ob ^ (((ob >> 9) & 1) << 5)); }
__host__ __device__ __forceinline__ void stage_rc(int b, int& R, int& C) { const int st = b / 1024, sb = b % 1024, swz = sb ^ (((sb >> 9) & 1) << 5); R = (st >> 1) * 16 + swz / 64; C = (st & 1) * 32 + (swz % 64) / 2; }
__host__ __device__ __forceinline__ int perm32(int rho) { const int n = rho >> 4, i = rho & 15; return 8 * (i >> 2) + 4 * n + (i & 3); }


struct Unit { int pm, pn, e, rb; };

struct StaticOrder {
    int nM, nN, nwg, G, c; const char* A; const char* Bt; int K;
    __device__ void init(const void* A_, const void* Bt_, int M, int N, int K_, int G_, int c_) { A = (const char*)A_; Bt = (const char*)Bt_; K = K_; nM = M / BM; nN = N / BM; nwg = nM * nN; G = G_; c = c_; }
    __device__ bool next(int i, Unit& u) const {
        const long L = (long)i * G + c; if (L >= nwg) return false;
        int wgid = (int)L; { const int q = nwg / NXCD, r = nwg % NXCD, xcd = wgid % NXCD, off = wgid / NXCD; wgid = (xcd < r ? xcd * (q + 1) : r * (q + 1) + (xcd - r) * q) + off; }
        const int nig = WGM * nN, gid = wgid / nig, fm = gid * WGM, gsz = (nM - fm) < WGM ? (nM - fm) : WGM;
        u.pm = fm + ((wgid % nig) % gsz); u.pn = (wgid % nig) / gsz; u.e = 0; u.rb = 0; return true;
    }
    __device__ __forceinline__ const char* a_ptr(const Unit& u) const { return A + (size_t)u.pm * ((size_t)BM * K * 2); }
    __device__ __forceinline__ const char* b_ptr(const Unit& u) const { return Bt + (size_t)u.pn * ((size_t)BM * K * 2); }
    __device__ __forceinline__ unsigned a_rowoff(const Unit&, int R) const { return (unsigned)R * (unsigned)K * 2u; }
};
template <int NPN, bool GATHER_> struct GroupedOrder {
    const PG8_LAS int* cnt; const PG8_LAS int* pre; int G, vc, K, Mtok;
    const char* A; const char* W; size_t wstride; const int* list;
    __device__ bool next(int i, Unit& u) const {
        const int total = pre[32] * NPN; const int L = i * G + vc; if (L >= total) return false;
        const int rbg = L / NPN; int e = 0;
#pragma unroll 1
        for (int j = 1; j < 32; ++j) e += (pre[j] <= rbg) ? 1 : 0;
        e = __builtin_amdgcn_readfirstlane(e); const int rb = __builtin_amdgcn_readfirstlane(rbg - pre[e]);
        u.e = e; u.rb = rb; u.pm = __builtin_amdgcn_readfirstlane(rbg); u.pn = __builtin_amdgcn_readfirstlane(L % NPN); return true;
    }
    __device__ __forceinline__ const char* a_ptr(const Unit& u) const { return GATHER_ ? A : A + (size_t)u.pm * ((size_t)BM * K * 2); }
    __device__ __forceinline__ const char* b_ptr(const Unit& u) const { return W + (size_t)u.e * wstride + (size_t)u.pn * ((size_t)BM * K * 2); }
    __device__ __forceinline__ unsigned a_rowoff(const Unit& u, int R) const {
        if (!GATHER_) return (unsigned)R * (unsigned)K * 2u;
        const int idx = u.rb * BM + R; int tok = 0; if (idx < cnt[u.e]) tok = list[(size_t)u.e * Mtok + idx] >> 1;
        return (unsigned)tok * (unsigned)K * 2u;
    }
};

__device__ __forceinline__ unsigned cvt_pk_bf16(float lo, float hi) { unsigned r; asm volatile("v_cvt_pk_bf16_f32 %0, %1, %2" : "=v"(r) : "v"(lo), "v"(hi)); return r; }
typedef float f32x2 __attribute__((ext_vector_type(2)));
__device__ __forceinline__ void sincos_rad(float ang, float& s, float& c) {
    double r = (double)ang * 0.15915494309189535; r = r - __builtin_floor(r);
    const float rf = (float)r; s = __builtin_amdgcn_sinf(rf); c = __builtin_amdgcn_cosf(rf);
}
struct EpiQKV {
    static constexpr bool PERM = true, AFTER_DRAIN = false, HAS_META = false;
    bf16_t* O; size_t split_stride; float scale0; const int* pos; int rope;
    __device__ __forceinline__ void operator()(const f32x4 (&acc)[2][2][4][2], const Unit& u, int wr, int wc, int fr, int fq) const {
        const int t = u.pn >> 2; bf16_t* base = O + (size_t)t * split_stride;
        const float sc = (t == 0) ? scale0 : 1.f;
        const int row0 = u.pm * BM + wr * 64 + fr, col0 = (u.pn & 3) * BM + wc * 32 + 8 * fq;
        const bool dorope = rope && t < 2 && (wc & 1) == 0 && fq < 2;
        const float f0 = fq ? 0.0014142135623842478f : 1.0f, f1 = fq ? 0.00027424818836152554f : 0.1939227432012558f,
                    f2 = fq ? 5.318296098266728e-05f : 0.03760603070259094f, f3 = fq ? 1.0313386155758053e-05f : 0.007292664609849453f;
#pragma unroll
        for (int ai = 0; ai < 2; ++ai)
#pragma unroll
            for (int m = 0; m < 4; ++m) { const int row = row0 + ai * HALF + m * 16; bf16_t* rowp = base + (size_t)row * 1024 + col0;
                float s0 = 0.f, s1 = 0.f, s2 = 0.f, s3 = 0.f, c0 = 1.f, c1 = 1.f, c2 = 1.f, c3 = 1.f;
                if (dorope) { const float p = (float)pos[row]; sincos_rad(p * f0, s0, c0); sincos_rad(p * f1, s1, c1); sincos_rad(p * f2, s2, c2); sincos_rad(p * f3, s3, c3); }
#pragma unroll
                for (int bj = 0; bj < 2; ++bj) { f32x4 v0 = acc[ai][bj][m][0], v1 = acc[ai][bj][m][1];
                    { const float a0 = v0[0], b0 = v0[1], a1 = v0[2], b1 = v0[3], a2 = v1[0], b2 = v1[1], a3 = v1[2], b3 = v1[3];
                      v0[0] = a0 * c0 - b0 * s0; v0[1] = b0 * c0 + a0 * s0; v0[2] = a1 * c1 - b1 * s1; v0[3] = b1 * c1 + a1 * s1;
                      v1[0] = a2 * c2 - b2 * s2; v1[1] = b2 * c2 + a2 * s2; v1[2] = a3 * c3 - b3 * s3; v1[3] = b3 * c3 + a3 * s3; }
                    v0 = v0 * sc; v1 = v1 * sc; u32x4 w; w.x = cvt_pk_bf16(v0[0], v0[1]); w.y = cvt_pk_bf16(v0[2], v0[3]); w.z = cvt_pk_bf16(v1[0], v1[1]); w.w = cvt_pk_bf16(v1[2], v1[3]);
                    *(u32x4*)(rowp + bj * HALF) = w; } }
    }
};
struct EpiPlain {
    static constexpr bool PERM = true, AFTER_DRAIN = false, HAS_META = false;
    bf16_t* O; int ldc;
    __device__ __forceinline__ void operator()(const f32x4 (&acc)[2][2][4][2], const Unit& u, int wr, int wc, int fr, int fq) const {
        const int row0 = u.pm * BM + wr * 64 + fr, col0 = u.pn * BM + wc * 32 + 8 * fq;
#pragma unroll
        for (int ai = 0; ai < 2; ++ai)
#pragma unroll
            for (int m = 0; m < 4; ++m) { bf16_t* rowp = O + (size_t)(row0 + ai * HALF + m * 16) * ldc + col0;
#pragma unroll
                for (int bj = 0; bj < 2; ++bj) { const f32x4 v0 = acc[ai][bj][m][0], v1 = acc[ai][bj][m][1];
                    u32x4 w; w.x = cvt_pk_bf16(v0[0], v0[1]); w.y = cvt_pk_bf16(v0[2], v0[3]); w.z = cvt_pk_bf16(v1[0], v1[1]); w.w = cvt_pk_bf16(v1[2], v1[3]);
                    *(u32x4*)(rowp + bj * HALF) = w; } }
    }
};
__device__ __forceinline__ float silu_mul(float g, float u) { return g * u * __builtin_amdgcn_rcpf(1.0f + __builtin_amdgcn_exp2f(-1.4426950408889634f * g)); }
struct EpiSwiGLU {
    static constexpr bool PERM = true, AFTER_DRAIN = false, HAS_META = false;
    bf16_t* hid;
    __device__ __forceinline__ void operator()(const f32x4 (&acc)[2][2][4][2], const Unit& u, int wr, int wc, int fr, int fq) const {
        const int row0 = u.pm * BM + wr * 64 + fr, col0 = u.pn * HALF + wc * 32 + 8 * fq;
#pragma unroll
        for (int ai = 0; ai < 2; ++ai)
#pragma unroll
            for (int m = 0; m < 4; ++m) { const f32x4 g0 = acc[ai][0][m][0], g1 = acc[ai][0][m][1], u0 = acc[ai][1][m][0], u1 = acc[ai][1][m][1];
                u32x4 w; w.x = cvt_pk_bf16(silu_mul(g0[0], u0[0]), silu_mul(g0[1], u0[1])); w.y = cvt_pk_bf16(silu_mul(g0[2], u0[2]), silu_mul(g0[3], u0[3]));
                w.z = cvt_pk_bf16(silu_mul(g1[0], u1[0]), silu_mul(g1[1], u1[1])); w.w = cvt_pk_bf16(silu_mul(g1[2], u1[2]), silu_mul(g1[3], u1[3]));
                *(u32x4*)(hid + (size_t)(row0 + ai * HALF + m * 16) * 512 + col0) = w; }
    }
};
struct EpiDown {
    static constexpr bool PERM = true, AFTER_DRAIN = false, HAS_META = true;
    bf16_t* y2; const int* list; const PG8_LAS int* cnt; int Mtok;
    __device__ __forceinline__ void prefetch(int (&dd)[8], const Unit& u, int wr, int fr) const {
        const int nvalid = cnt[u.e] - u.rb * BM; const int* lp = list + (size_t)u.e * Mtok + u.rb * BM;
#pragma unroll
        for (int ai = 0; ai < 2; ++ai)
#pragma unroll
            for (int m = 0; m < 4; ++m) { const int r = ai * HALF + wr * 64 + m * 16 + fr; dd[ai * 4 + m] = (r < nvalid) ? lp[r] : -1; }
    }
    __device__ __forceinline__ void operator()(const f32x4 (&acc)[2][2][4][2], const Unit& u, int wr, int wc, int fr, int fq, const int (&dd)[8]) const {
        const int col0 = u.pn * BM + wc * 32 + 8 * fq;
#pragma unroll
        for (int ai = 0; ai < 2; ++ai)
#pragma unroll
            for (int m = 0; m < 4; ++m) if (dd[ai * 4 + m] >= 0) { bf16_t* rowp = y2 + (size_t)dd[ai * 4 + m] * 1024 + col0;
#pragma unroll
                for (int bj = 0; bj < 2; ++bj) { const f32x4 v0 = acc[ai][bj][m][0], v1 = acc[ai][bj][m][1];
                    u32x4 w; w.x = cvt_pk_bf16(v0[0], v0[1]); w.y = cvt_pk_bf16(v0[2], v0[3]); w.z = cvt_pk_bf16(v1[0], v1[1]); w.w = cvt_pk_bf16(v1[2], v1[3]);
                    *(u32x4*)(rowp + bj * HALF) = w; } }
    }
};

template <class Epi, class Sched, bool ALIGN_EPI, bool GATHER>
__device__ __forceinline__ void gemm_phase(PG8_LAS unsigned char* lds, const int K, const Sched& S, const Epi& E, const int wv) {
    int tid_ = wv * 64 + lane_id_(); asm volatile("" : "+v"(tid_));
    const int tid = tid_, wid = __builtin_amdgcn_readfirstlane(tid >> 6), lane = tid & 63, wr = wid >> 2, wc = wid & 3, fr = lane & 15, fq = lane >> 4;
    const int nt = K / BK;
    unsigned vA0[2], vA1[2], nA0[2], nA1[2], voffB[2]; int RA[2], CA2[2];
#pragma unroll
    for (int i = 0; i < 2; ++i) { int R, C; stage_rc(tid * 16 + i * 8192, R, C); const int Rb = Epi::PERM ? ((R & ~31) + perm32(R & 31)) : R;
        RA[i] = R; CA2[i] = C * 2; voffB[i] = (unsigned)(Rb * K + C) * 2u; }
    const size_t kstep = (size_t)(BK * 2);
    const size_t hstep = (size_t)HALF * K * 2;
    const unsigned ldsw = (unsigned)wid * 1024u;
    const int aoff = lds_byte(wr * 64 + fr, fq * 8), boff = lds_byte(wc * 32 + fr, fq * 8);
#define PG8_SA(b, h) (((b) * 2 + (h)) * HTB)
#define PG8_SB(b, h) ((4 + (b) * 2 + (h)) * HTB)
#define PG8_STAGE(bufoff, gbase, voff) do { _Pragma("unroll") for (int _i = 0; _i < 2; ++_i) \
        __builtin_amdgcn_global_load_lds((const unsigned*)((const char*)(gbase) + (voff)[_i]), (PG8_LAS unsigned*)(lds + (bufoff) + ldsw + _i * 8192), 16, 0, 0); } while (0)
#define PG8_LDA(dst, b, h) do { _Pragma("unroll") for (int m = 0; m < 4; ++m) _Pragma("unroll") for (int k = 0; k < 2; ++k) dst[m][k] = *(const PG8_LAS bf16x8*)(lds + PG8_SA(b, h) + aoff + m * 2048 + k * 1024); } while (0)
#define PG8_LDB(dst, b, h) do { _Pragma("unroll") for (int n = 0; n < 2; ++n) _Pragma("unroll") for (int k = 0; k < 2; ++k) dst[n][k] = *(const PG8_LAS bf16x8*)(lds + PG8_SB(b, h) + boff + n * 2048 + k * 1024); } while (0)
#define PG8_MMA(ai, bj, At, Bt) do { __builtin_amdgcn_s_setprio(1); _Pragma("unroll") for (int m = 0; m < 4; ++m) _Pragma("unroll") for (int n = 0; n < 2; ++n) _Pragma("unroll") for (int k = 0; k < 2; ++k) \
        acc[ai][bj][m][n] = __builtin_amdgcn_mfma_f32_16x16x32_bf16(Bt[n][k], At[m][k], acc[ai][bj][m][n], 0, 0, 0); __builtin_amdgcn_s_setprio(0); } while (0)
#define PG8_WAIT_V(n) asm volatile("s_waitcnt vmcnt(" #n ")" ::: "memory")
#define PG8_WAIT_L(n) asm volatile("s_waitcnt lgkmcnt(" #n ")" ::: "memory")
#define PG8_BAR __builtin_amdgcn_s_barrier()
#define PG8_SCHED __builtin_amdgcn_sched_barrier(0)
#define PG8_AOFFS(u, d0, d1) do { _Pragma("unroll") for (int _i = 0; _i < 2; ++_i) { d0[_i] = S.a_rowoff(u, RA[_i]) + (unsigned)CA2[_i]; d1[_i] = S.a_rowoff(u, HALF + RA[_i]) + (unsigned)CA2[_i]; } } while (0)
    Unit cur, nxt; int ui = 0;
    if (!S.next(0, cur)) return;
    f32x4 acc[2][2][4][2];
#pragma unroll
    for (int a = 0; a < 2; ++a)
#pragma unroll
        for (int b = 0; b < 2; ++b)
#pragma unroll
            for (int m = 0; m < 4; ++m)
#pragma unroll
                for (int n = 0; n < 2; ++n) acc[a][b][m][n] = (f32x4){0.f, 0.f, 0.f, 0.f};
    bf16x8 At[4][2], B0[2][2], B1[2][2]; int meta[8];
    const char* cA = S.a_ptr(cur); const char* cB = S.b_ptr(cur);
    PG8_AOFFS(cur, vA0, vA1);
    {
        PG8_STAGE(PG8_SB(0, 0), cB, voffB); PG8_STAGE(PG8_SB(0, 1), cB + hstep, voffB); PG8_STAGE(PG8_SA(0, 0), cA, vA0); PG8_STAGE(PG8_SA(0, 1), cA, vA1);
        if (wr == 1) PG8_BAR;
        PG8_WAIT_V(2); PG8_BAR;
        PG8_STAGE(PG8_SB(1, 0), cB + kstep, voffB); PG8_STAGE(PG8_SA(1, 0), cA + kstep, vA0); PG8_STAGE(PG8_SB(1, 1), cB + hstep + kstep, voffB);
        PG8_WAIT_V(6); PG8_BAR;
    }
    for (;;) {
        const bool has_next = S.next(ui + 1, nxt);
        if constexpr (Epi::HAS_META) E.prefetch(meta, cur, wr, fr);
        const char* nA = has_next ? S.a_ptr(nxt) : cA; const char* nB = has_next ? S.b_ptr(nxt) : cB;
        if constexpr (GATHER) { if (has_next) { PG8_AOFFS(nxt, nA0, nA1); } else {
#pragma unroll
            for (int _i = 0; _i < 2; ++_i) { nA0[_i] = vA0[_i]; nA1[_i] = vA1[_i]; } } }
        for (int t = 0; t < nt; t += 2) {
            const bool last = (t == nt - 2);
            const char* a1 = cA + (size_t)(t + 1) * kstep;
            const char* a2 = last ? nA : cA + (size_t)(t + 2) * kstep; const char* b2 = last ? nB : cB + (size_t)(t + 2) * kstep;
            const char* a3 = a2 + kstep; const char* b3 = b2 + kstep;
            PG8_LDB(B0, 0, 0); PG8_LDB(B1, 0, 1); PG8_SCHED; PG8_LDA(At, 0, 0); PG8_STAGE(PG8_SA(1, 1), a1, vA1);
            if constexpr (GATHER) { if (last) {
#pragma unroll
                for (int _i = 0; _i < 2; ++_i) { vA0[_i] = nA0[_i]; vA1[_i] = nA1[_i]; } } }
            PG8_WAIT_V(8); PG8_WAIT_L(0); PG8_BAR; PG8_MMA(0, 0, At, B0); PG8_MMA(0, 1, At, B1); PG8_BAR; PG8_SCHED;
            PG8_LDA(At, 0, 1); PG8_STAGE(PG8_SB(0, 0), b2, voffB); PG8_STAGE(PG8_SB(0, 1), b2 + hstep, voffB); PG8_STAGE(PG8_SA(0, 0), a2, vA0);
            PG8_WAIT_V(8); PG8_WAIT_L(0); PG8_BAR; PG8_MMA(1, 0, At, B0); PG8_MMA(1, 1, At, B1); PG8_BAR; PG8_SCHED;
            PG8_LDB(B0, 1, 0); PG8_LDB(B1, 1, 1); PG8_SCHED; PG8_LDA(At, 1, 0); PG8_STAGE(PG8_SA(0, 1), a2, vA1);
            PG8_WAIT_V(8); PG8_WAIT_L(0); PG8_BAR; PG8_MMA(0, 0, At, B0); PG8_MMA(0, 1, At, B1); PG8_BAR; PG8_SCHED;
            PG8_LDA(At, 1, 1); PG8_STAGE(PG8_SB(1, 0), b3, voffB); PG8_STAGE(PG8_SB(1, 1), b3 + hstep, voffB); PG8_STAGE(PG8_SA(1, 0), a3, vA0);
            PG8_WAIT_V(8); PG8_WAIT_L(0); PG8_BAR; PG8_MMA(1, 0, At, B0); PG8_MMA(1, 1, At, B1); PG8_BAR; PG8_SCHED;
        }
        if constexpr (ALIGN_EPI) { if (wr == 0) PG8_BAR; }
        if constexpr (Epi::HAS_META) E(acc, cur, wr, wc, fr, fq, meta); else E(acc, cur, wr, wc, fr, fq);
        if (!has_next) break;
#pragma unroll
        for (int a = 0; a < 2; ++a)
#pragma unroll
            for (int b = 0; b < 2; ++b)
#pragma unroll
                for (int m = 0; m < 4; ++m)
#pragma unroll
                    for (int n = 0; n < 2; ++n) acc[a][b][m][n] = (f32x4){0.f, 0.f, 0.f, 0.f};
        cur = nxt; cA = nA; cB = nB; ++ui;
        if constexpr (ALIGN_EPI) { if (wr == 1) PG8_BAR; }
    }
    PG8_WAIT_V(0);
    if constexpr (!ALIGN_EPI) { if (wr == 0) PG8_BAR; }
    PG8_BAR;
#undef PG8_SA
#undef PG8_SB
#undef PG8_STAGE
#undef PG8_LDA
#undef PG8_LDB
#undef PG8_MMA
#undef PG8_WAIT_V
#undef PG8_WAIT_L
#undef PG8_BAR
#undef PG8_SCHED
#undef PG8_AOFFS
}
}
#include <hip/hip_bf16.h>
#include <cmath>
namespace attn_body {
using bf16=__hip_bfloat16;
using bf16x8=__attribute__((ext_vector_type(8)))short;
using s16x4=__attribute__((ext_vector_type(4)))short;
using f32x16=__attribute__((ext_vector_type(16)))float;
using u32x4=__attribute__((ext_vector_type(4)))unsigned;
constexpr int BATCH=4,NHEAD=16,SEQ=8192,D=64,DM=NHEAD*D;
constexpr int NW=8,QBLK=32,QB=QBLK*NW,KVBLK=64,NQB=SEQ/QB;
constexpr int ATTN_PITCH=DM, ATTN_UNIT_ROWS=QB;
__device__ __forceinline__ int crow(int r,int hi){return (r&3)+8*(r>>2)+4*hi;}
#define SBAR() __builtin_amdgcn_sched_barrier(0)
__device__ __forceinline__ void cmask(f32x16&p0,f32x16&p1,int jb,int qrel,int hi){
  const float NEG=-INFINITY; const int thr=qrel-64*jb-4*hi;
  #pragma unroll
  for(int r=0;r<16;++r){const int kc=(r&3)+8*(r>>2); if(kc>thr)p0[r]=NEG; if(kc+32>thr)p1[r]=NEG;}
}

constexpr int NSLOT=3, SLOTB=8192;
constexpr int LDS_K=0, LDS_V=NSLOT*SLOTB, LDS_WS=2*NSLOT*SLOTB, LDS_OST=LDS_WS+NW*64*4, LDS_BYTES=LDS_OST+NW*4096;
constexpr float C2=0.125f*1.4426950408889634f;
__device__ __forceinline__ void glds16(const void*gsrc,unsigned lds_dst){unsigned keep;
  asm volatile("s_mov_b32 %0, m0\n\ts_mov_b32 m0, %2\n\ts_nop 0\n\tglobal_load_lds_dwordx4 %1, off\n\ts_mov_b32 m0, %0":"=&s"(keep):"v"(gsrc),"s"(lds_dst):"memory");}
__device__ __forceinline__ void glds16s(const void*sbase,unsigned voff,unsigned lds_dst){unsigned keep;
  asm volatile("s_mov_b32 %0, m0\n\ts_mov_b32 m0, %3\n\ts_nop 0\n\tglobal_load_lds_dwordx4 %1, %2\n\ts_mov_b32 m0, %0":"=&s"(keep):"v"(voff),"s"(sbase),"s"(lds_dst):"memory");}
__device__ __forceinline__ float max3f(float a,float b,float c){float r;asm("v_max3_f32 %0, %1, %2, %3":"=v"(r):"v"(a),"v"(b),"v"(c));return r;}
__device__ __forceinline__ float max2f(float a,float b){float r;asm("v_max_f32_e32 %0, %1, %2":"=v"(r):"v"(a),"v"(b));return r;}
__device__ __forceinline__ float fadd_s(float a,float b){float r;asm("v_add_f32_e32 %0, %1, %2":"=v"(r):"v"(a),"v"(b));return r;}
__device__ __forceinline__ float fsub_s(float a,float b){float r;asm("v_sub_f32_e32 %0, %1, %2":"=v"(r):"v"(a),"v"(b));return r;}
typedef float f32x2_t __attribute__((ext_vector_type(2))); typedef __bf16 bf16x2_t __attribute__((ext_vector_type(2)));
__device__ __forceinline__ unsigned cvtpk_s(float lo,float hi){f32x2_t v={lo,hi};bf16x2_t b=__builtin_convertvector(v,bf16x2_t);return __builtin_bit_cast(unsigned,b);}
#define WAIT_BAR(N) asm volatile("s_waitcnt vmcnt(" #N ") lgkmcnt(0)\n\ts_barrier":::"memory")

__device__ __forceinline__ void qkt(f32x16&p0,f32x16&p1,const char*Kslot,const bf16x8*qr,const f32x16&negm,int r32,int hi){
  const char*kb=Kslot+hi*1024+r32*16;
  #pragma unroll
  for(int d0=0;d0<4;++d0){
    const bf16x8 b0=*reinterpret_cast<const bf16x8*>(kb+d0*2048);
    const bf16x8 b1=*reinterpret_cast<const bf16x8*>(kb+d0*2048+512);
    if(d0==0){p0=__builtin_amdgcn_mfma_f32_32x32x16_bf16(b0,qr[0],negm,0,0,0);p1=__builtin_amdgcn_mfma_f32_32x32x16_bf16(b1,qr[0],negm,0,0,0);}
    else{p0=__builtin_amdgcn_mfma_f32_32x32x16_bf16(b0,qr[d0],p0,0,0,0);p1=__builtin_amdgcn_mfma_f32_32x32x16_bf16(b1,qr[d0],p1,0,0,0);}}
}
typedef __attribute__((address_space(3))) const char* lds_cptr;
typedef short v4i16_t __attribute__((ext_vector_type(4)));
__device__ __forceinline__ void kload8(bf16x8*kf,lds_cptr kp){
  kf[0]=*(const __attribute__((address_space(3))) bf16x8*)(kp);      kf[1]=*(const __attribute__((address_space(3))) bf16x8*)(kp+512);
  kf[2]=*(const __attribute__((address_space(3))) bf16x8*)(kp+2048); kf[3]=*(const __attribute__((address_space(3))) bf16x8*)(kp+2560);
  kf[4]=*(const __attribute__((address_space(3))) bf16x8*)(kp+4096); kf[5]=*(const __attribute__((address_space(3))) bf16x8*)(kp+4608);
  kf[6]=*(const __attribute__((address_space(3))) bf16x8*)(kp+6144); kf[7]=*(const __attribute__((address_space(3))) bf16x8*)(kp+6656);
}
__device__ __forceinline__ void kload2(bf16x8*kf,lds_cptr kp,int j){ kf[2*j]=*(const __attribute__((address_space(3))) bf16x8*)(kp+j*2048); kf[2*j+1]=*(const __attribute__((address_space(3))) bf16x8*)(kp+j*2048+512); }
__device__ __forceinline__ s16x4 vtr(lds_cptr p){ return __builtin_bit_cast(s16x4,__builtin_amdgcn_ds_read_tr16_b64_v4i16((__attribute__((address_space(3))) v4i16_t*)p)); }
__device__ __forceinline__ float rowmax(const f32x16&p0,const f32x16&p1){
  float a=max3f(p0[0],p0[1],p1[0]),b=max3f(p0[2],p0[3],p1[1]);a=max3f(a,p1[2],p1[3]);
  #pragma unroll
  for(int r=4;r<16;r+=4){a=max3f(a,p0[r],p0[r+1]);b=max3f(b,p0[r+2],p0[r+3]);a=max3f(a,p1[r],p1[r+1]);b=max3f(b,p1[r+2],p1[r+3]);}
  const float m=max2f(a,b);
  auto rr=__builtin_amdgcn_permlane32_swap(__float_as_uint(m),__float_as_uint(m),false,false);
  return max2f(__uint_as_float(rr[0]),__uint_as_float(rr[1]));
}
__device__ __forceinline__ void pv(f32x16*o,int vb,bf16x8 pa0,bf16x8 pa1,bf16x8 pa2,bf16x8 pa3){
  #pragma unroll
  for(int d0=0;d0<2;++d0){s16x4 lo[4],hi[4];
    #pragma unroll
    for(int ks=0;ks<4;++ks){
      asm volatile("ds_read_b64_tr_b16 %0,%1 offset:%c2":"=&v"(lo[ks]):"v"(vb),"i"(d0*4096+ks*1024):"memory");
      asm volatile("ds_read_b64_tr_b16 %0,%1 offset:%c2":"=&v"(hi[ks]):"v"(vb),"i"(d0*4096+ks*1024+512):"memory");}
    asm volatile("s_waitcnt lgkmcnt(0)":::"memory");SBAR();
    #define PK(k) (bf16x8){lo[k][0],lo[k][1],lo[k][2],lo[k][3],hi[k][0],hi[k][1],hi[k][2],hi[k][3]}
    o[d0]=__builtin_amdgcn_mfma_f32_32x32x16_bf16(pa0,PK(0),o[d0],0,0,0);
    o[d0]=__builtin_amdgcn_mfma_f32_32x32x16_bf16(pa1,PK(1),o[d0],0,0,0);
    o[d0]=__builtin_amdgcn_mfma_f32_32x32x16_bf16(pa2,PK(2),o[d0],0,0,0);
    o[d0]=__builtin_amdgcn_mfma_f32_32x32x16_bf16(pa3,PK(3),o[d0],0,0,0);
    #undef PK
  }
}

#ifndef ATTN_STORE16
#define ATTN_STORE16(p,v) (*(u32x4*)(p)=(v))
#endif
constexpr int LDS2_WS=LDS_V+NSLOT*2*SLOTB, LDS2_OST=LDS2_WS+NW*64*4, LDS2_BYTES=LDS2_OST+NW*4096;
__device__ __forceinline__ void pv4(f32x16*o,int vb,bf16x8 pa0,bf16x8 pa1,bf16x8 pa2,bf16x8 pa3){
  #pragma unroll
  for(int d0=0;d0<4;++d0){s16x4 lo[4],hi[4];
    #pragma unroll
    for(int ks=0;ks<4;++ks){
      asm volatile("ds_read_b64_tr_b16 %0,%1 offset:%c2":"=&v"(lo[ks]):"v"(vb),"i"(d0*4096+ks*1024):"memory");
      asm volatile("ds_read_b64_tr_b16 %0,%1 offset:%c2":"=&v"(hi[ks]):"v"(vb),"i"(d0*4096+ks*1024+512):"memory");}
    asm volatile("s_waitcnt lgkmcnt(0)":::"memory");SBAR();
    #define PK(k) (bf16x8){lo[k][0],lo[k][1],lo[k][2],lo[k][3],hi[k][0],hi[k][1],hi[k][2],hi[k][3]}
    o[d0]=__builtin_amdgcn_mfma_f32_32x32x16_bf16(pa0,PK(0),o[d0],0,0,0);
    o[d0]=__builtin_amdgcn_mfma_f32_32x32x16_bf16(pa1,PK(1),o[d0],0,0,0);
    o[d0]=__builtin_amdgcn_mfma_f32_32x32x16_bf16(pa2,PK(2),o[d0],0,0,0);
    o[d0]=__builtin_amdgcn_mfma_f32_32x32x16_bf16(pa3,PK(3),o[d0],0,0,0);
    #undef PK
  }
}
template<int THRL,bool COMBINE> __device__ __forceinline__ void attn_unit128(int b,int qcol,int kcol,int vcol,int ocol,int qb,const bf16*Q,const bf16*__restrict__ K,const bf16*__restrict__ V,bf16*O,char*shm,const int wv,
    bf16*HBo,const float lam,const float*subg,const float osc){
  int tid_=wv*64+lane_id_(); asm volatile("":"+v"(tid_)); const int tid=tid_,lane=tid&63,r32=lane&31,hi=lane>>5; const int wid=__builtin_amdgcn_readfirstlane(tid>>6);
  const long rowbase=(long)b*SEQ; const int q0=qb*QB;
  const bf16*Qw=Q+(rowbase+q0+wid*QBLK)*DM+qcol;
  const bf16*Kh=K+rowbase*DM+kcol,*Vh=V+rowbase*DM+vcol;
  const unsigned lds0=(unsigned)(uintptr_t)shm;
  float*wsf=(float*)(shm+LDS2_WS)+wid*64;
  const unsigned koff=(unsigned)(lane*DM+wid*8)*2u, voff=(unsigned)((16*(wid&3)+(lane>>2))*DM+(wid>>2)*32+(lane&3)*8)*2u;
  const unsigned kdst=lds0+LDS_K+wid*1024, vdst=lds0+LDS_V+wid*1024;
  #define DMA_K(t,slot) glds16s(Kh+(long)(t)*KVBLK*DM,koff,(unsigned)__builtin_amdgcn_readfirstlane(kdst+(slot)))
  #define DMA_V(t,slot) do{ glds16s(Vh+(long)(t)*KVBLK*DM,voff,(unsigned)__builtin_amdgcn_readfirstlane(vdst+2*(slot))); glds16s(Vh+(long)(t)*KVBLK*DM+64,voff,(unsigned)__builtin_amdgcn_readfirstlane(vdst+2*(slot)+8192)); }while(0)
  const int vb0=(int)(lds0+LDS_V)+((lane>>4)&1)*32+(lane&3)*8+(4*hi+((lane&15)>>2))*64;
  const char*Kbase=shm+LDS_K; bf16x8 kf[8];
  const lds_cptr shm3=(lds_cptr)shm; const lds_cptr kp0=shm3+LDS_K+hi*1024+r32*16; const lds_cptr vp0=shm3+LDS_V+((lane>>4)&1)*32+(lane&3)*8+(4*hi+((lane&15)>>2))*64;
  const int NT=(q0+QB)/KVBLK;
  DMA_K(0,0);DMA_V(0,0);DMA_K(1,SLOTB);
  bf16x8 qr[4];
  #pragma unroll
  for(int d0=0;d0<4;++d0)qr[d0]=*reinterpret_cast<const bf16x8*>(&Qw[(long)r32*DM+d0*16+hi*8]);
  float mhat=0.f,l_reg=0.f;float z_=0.f; asm volatile("":"+v"(z_));
  f32x16 o[4]; f32x16 negm;
  _Pragma("unroll") for(int r=0;r<16;++r){o[0][r]=z_;o[1][r]=z_;o[2][r]=z_;o[3][r]=z_;negm[r]=z_;} asm volatile("":"+v"(negm));
  const int qrel=wid*QBLK+r32;
  #define CMASK(P0,P1,t) do{int jb_=(t)-(NT-4); if(jb_>=0)cmask(P0,P1,jb_,qrel,hi);}while(0)
  bool resc=false;
  #define START(P0,P1) do{ const float rm=rowmax(P0,P1); resc=false; \
    { const float dl=rm; mhat=fadd_s(mhat,dl); \
      _Pragma("unroll") for(int r=0;r<16;++r){P0[r]=fsub_s(P0[r],dl);P1[r]=fsub_s(P1[r],dl);} \
      _Pragma("unroll") for(int r=0;r<16;++r)negm[r]=-mhat; asm volatile("":"+v"(negm)); } \
    _Pragma("unroll") for(int r=0;r<16;++r)P0[r]=__builtin_amdgcn_exp2f(P0[r]); }while(0)
  #define RESC() do{ if(resc){ asm volatile("s_waitcnt lgkmcnt(0)":::"memory"); \
      _Pragma("unroll") for(int d_=0;d_<4;++d_) _Pragma("unroll") for(int r=0;r<16;++r)o[d_][r]*=wsf[crow(r,hi)]; } }while(0)
  f32x16 pA0,pA1,pB0,pB1;
  int sl_prev=0,sl_cur=0,sl_next=SLOTB;
  #define ROT() do{sl_prev=sl_cur;sl_cur=sl_next;sl_next=(sl_next==(NSLOT-1)*SLOTB)?0:sl_next+SLOTB;}while(0)
  DMA_K(2,2*SLOTB);
  WAIT_BAR(3);
  qkt(pA0,pA1,Kbase,qr,negm,r32,hi);asm volatile("s_nop 15\n\ts_nop 7":"+v"(pA0),"+v"(pA1));CMASK(pA0,pA1,0);
  START(pA0,pA1);
  _Pragma("unroll") for(int r=0;r<16;++r)pA1[r]=__builtin_amdgcn_exp2f(pA1[r]);
  WAIT_BAR(0);
  DMA_K(3,0);DMA_V(1,SLOTB);
  ROT();
  kload8(kf,kp0+sl_cur);
  WAIT_BAR(3);
  s16x4 vlo[8],vhi[8]; u32x4 pw0,pw1,pw2,pw3;
  #define PKW(P,B) cvtpk_s(P[B],P[B+1])
  #define PAF(k) __builtin_bit_cast(bf16x8,pw##k)
  #define VFR(i) (bf16x8){vlo[i][0],vlo[i][1],vlo[i][2],vlo[i][3],vhi[i][0],vhi[i][1],vhi[i][2],vhi[i][3]}
  #define PIN(x) asm volatile("":"+v"(x))
  #define MX3(a,b,c) __builtin_fmaxf(__builtin_fmaxf((a),(b)),(c))
  #define GAPA(MF,A0,A1,A2,A3,W0,W1,PW) do{ MF; sacc+=A0; sacc+=A1; sacc+=A2; sacc+=A3; PIN(sacc); W0; W1; PIN(PW); SBAR(); }while(0)
  #define EX(v) __builtin_amdgcn_exp2f(v)
  #define GAPB(MF,X,B) do{ MF; X[B]=EX(X[B]); X[B+1]=EX(X[B+1]); PIN(X); SBAR(); }while(0)
  #define VRD(f) do{ vlo[(f)&7]=vtr(vp_+(((f)&3)*4096+((f)>>2)*1024)); vhi[(f)&7]=vtr(vp_+(((f)&3)*4096+((f)>>2)*1024+512)); }while(0)
  #define KRD(G,j) do{ if(G){ kload2(kf,kp0+sl_next,j); SBAR(); } }while(0)
  #define PVM(f) o[(f)&3]=__builtin_amdgcn_mfma_f32_32x32x16_bf16(PAFN((f)>>2),VFR((f)&7),o[(f)&3],0,0,0)
  #define PAFN(k) ((k)==0?PAF(0):(k)==1?PAF(1):(k)==2?PAF(2):PAF(3))
  #define STEP(C0,C1,P0,P1,t,GK,GV,GL) do{ SBAR(); \
    const lds_cptr vp_=vp0+2*sl_prev; \
    float sacc=(P0[0]+P0[1]); \
    GAPA(C0=__builtin_amdgcn_mfma_f32_32x32x16_bf16(kf[0],qr[0],negm,0,0,0), P0[2],P0[3],P0[4],P0[5],     pw0[0]=PKW(P0,0), pw0[1]=PKW(P0,2), pw0); \
    GAPA(C1=__builtin_amdgcn_mfma_f32_32x32x16_bf16(kf[1],qr[0],negm,0,0,0), P0[6],P0[7],P0[8],P0[9],     pw0[2]=PKW(P0,4), pw0[3]=PKW(P0,6), pw0); \
    VRD(0); SBAR(); GAPA(C0=__builtin_amdgcn_mfma_f32_32x32x16_bf16(kf[2],qr[1],C0,0,0,0),   P0[10],P0[11],P0[12],P0[13], pw1[0]=PKW(P0,8), pw1[1]=PKW(P0,10), pw1); \
    VRD(1); SBAR(); GAPA(C1=__builtin_amdgcn_mfma_f32_32x32x16_bf16(kf[3],qr[1],C1,0,0,0),   P0[14],P0[15],P1[0],P1[1],   pw1[2]=PKW(P0,12),pw1[3]=PKW(P0,14), pw1); \
    VRD(2); SBAR(); GAPA(C0=__builtin_amdgcn_mfma_f32_32x32x16_bf16(kf[4],qr[2],C0,0,0,0),   P1[2],P1[3],P1[4],P1[5],     pw2[0]=PKW(P1,0), pw2[1]=PKW(P1,2), pw2); \
    VRD(3); SBAR(); GAPA(C1=__builtin_amdgcn_mfma_f32_32x32x16_bf16(kf[5],qr[2],C1,0,0,0),   P1[6],P1[7],P1[8],P1[9],     pw2[2]=PKW(P1,4), pw2[3]=PKW(P1,6), pw2); \
    VRD(4); SBAR(); GAPA(C0=__builtin_amdgcn_mfma_f32_32x32x16_bf16(kf[6],qr[3],C0,0,0,0),   P1[10],P1[11],P1[12],P1[13], pw3[0]=PKW(P1,8), pw3[1]=PKW(P1,10), pw3); \
    VRD(5); SBAR(); GAPA(C1=__builtin_amdgcn_mfma_f32_32x32x16_bf16(kf[7],qr[3],C1,0,0,0),   P1[14],P1[15],0.f,0.f,       pw3[2]=PKW(P1,12),pw3[3]=PKW(P1,14), pw3); \
    l_reg+=sacc; \
    if(GK){DMA_K((t)+3,sl_cur);} if(GV){DMA_V((t)+1,sl_next);} \
    CMASK(C0,C1,t); \
    { float a=MX3(C0[0],C0[1],C1[0]),b=MX3(C0[2],C0[3],C1[1]); a=MX3(a,C1[2],C1[3]); \
      _Pragma("unroll") for(int r=4;r<16;r+=4){a=MX3(a,C0[r],C0[r+1]);b=MX3(b,C0[r+2],C0[r+3]);a=MX3(a,C1[r],C1[r+1]);b=MX3(b,C1[r+2],C1[r+3]);} \
      float rm=__builtin_fmaxf(a,b); { auto rr=__builtin_amdgcn_permlane32_swap(__float_as_uint(rm),__float_as_uint(rm),false,false); rm=__builtin_fmaxf(__uint_as_float(rr[0]),__uint_as_float(rr[1])); } \
      resc=false; \
      if(__builtin_expect(__any(rm>(float)THRL),0)){ const float dl=__builtin_fmaxf(rm,0.f); mhat+=dl; \
        _Pragma("unroll") for(int r=0;r<16;++r){C0[r]-=dl;C1[r]-=dl;} \
        _Pragma("unroll") for(int r=0;r<16;++r)negm[r]=-mhat; asm volatile("":"+v"(negm)); \
        const float f=__builtin_amdgcn_exp2f(-dl); l_reg*=f; if(hi==0)wsf[r32]=f; resc=true; } } \
    SBAR(); \
    VRD(6);  SBAR(); GAPB(PVM(0),  C0,0); \
    VRD(7);  SBAR(); GAPB(PVM(1),  C0,2); \
    VRD(8);  SBAR(); GAPB(PVM(2),  C0,4); \
    VRD(9);  SBAR(); GAPB(PVM(3),  C0,6); \
    VRD(10); SBAR(); GAPB(PVM(4),  C0,8); \
    VRD(11); SBAR(); GAPB(PVM(5),  C0,10); \
    VRD(12); SBAR(); GAPB(PVM(6),  C0,12); \
    VRD(13); SBAR(); GAPB(PVM(7),  C0,14); \
    VRD(14); SBAR(); GAPB(PVM(8),  C1,0); \
    VRD(15); SBAR(); GAPB(PVM(9),  C1,2); \
    GAPB(PVM(10), C1,4); \
    GAPB(PVM(11), C1,6); \
    KRD(GL,0); GAPB(PVM(12), C1,8); \
    KRD(GL,1); GAPB(PVM(13), C1,10); \
    KRD(GL,2); GAPB(PVM(14), C1,12); \
    KRD(GL,3); GAPB(PVM(15), C1,14); \
    }while(0)
  int t=1;
  #undef CMASK
  #define CMASK(P0,P1,t) do{}while(0)
  for(;t+5<NT;t+=2){
    STEP(pB0,pB1,pA0,pA1,t,true,true,true);     WAIT_BAR(3); RESC(); ROT();
    STEP(pA0,pA1,pB0,pB1,t+1,true,true,true);   WAIT_BAR(3); RESC(); ROT();
  }
  #undef CMASK
  #define CMASK(P0,P1,t) do{int jb_=(t)-(NT-4); if(jb_>=0)cmask(P0,P1,jb_,qrel,hi);}while(0)
  #define ENDW(tt) do{ if((tt)+3<NT){WAIT_BAR(3);} else if((tt)+2<NT){WAIT_BAR(2);} else {WAIT_BAR(0);} }while(0)
  for(;t+1<NT;t+=2){
    STEP(pB0,pB1,pA0,pA1,t,(t+3<NT),(t+1<NT),(t+1<NT));       ENDW(t);   RESC(); ROT();
    STEP(pA0,pA1,pB0,pB1,t+1,(t+4<NT),(t+2<NT),(t+2<NT));     ENDW(t+1); RESC(); ROT();
  }
  STEP(pB0,pB1,pA0,pA1,NT-1,false,false,false); RESC();
  { float sacc=pB0[0]+pB0[1]; _Pragma("unroll") for(int r=2;r<16;++r)sacc+=pB0[r]; _Pragma("unroll") for(int r=0;r<16;++r)sacc+=pB1[r]; l_reg+=sacc;
    pw0=(u32x4){PKW(pB0,0),PKW(pB0,2),PKW(pB0,4),PKW(pB0,6)};pw1=(u32x4){PKW(pB0,8),PKW(pB0,10),PKW(pB0,12),PKW(pB0,14)};pw2=(u32x4){PKW(pB1,0),PKW(pB1,2),PKW(pB1,4),PKW(pB1,6)};pw3=(u32x4){PKW(pB1,8),PKW(pB1,10),PKW(pB1,12),PKW(pB1,14)};
    SBAR(); pv4(o,vb0+2*sl_cur,PAF(0),PAF(1),PAF(2),PAF(3)); }
  #undef PKW
  #undef PAF
  #undef VFR
  #undef PIN
  #undef MX3
  #undef GAPA
  #undef GAPB
  #undef EX
  #undef VRD
  #undef KRD
  #undef STEP
  #undef PVM
  #undef PAFN
  #undef ENDW
  {auto rr=__builtin_amdgcn_permlane32_swap(__float_as_uint(l_reg),__float_as_uint(l_reg),false,false);l_reg=__uint_as_float(rr[0])+__uint_as_float(rr[1]);}
  if(hi==0)wsf[32+r32]=l_reg;asm volatile("s_waitcnt lgkmcnt(0)":::"memory");
  float rli[16];
  #pragma unroll
  for(int r=0;r<16;++r)rli[r]=__builtin_amdgcn_rcpf(wsf[32+crow(r,hi)]);
  bf16*Ow=O+(rowbase+q0+wid*QBLK)*DM+ocol;
  bf16*stg=(bf16*)(shm+LDS2_OST)+wid*2048;
  if constexpr(!COMBINE){
    #pragma unroll
    for(int hf=0;hf<2;++hf){
      #pragma unroll
      for(int r=0;r<16;++r){const int orow=crow(r,hi);
        #pragma unroll
        for(int d0=0;d0<2;++d0)stg[orow*64+d0*32+r32]=__float2bfloat16(o[2*hf+d0][r]*rli[r]);}
      asm volatile("s_waitcnt lgkmcnt(0)":::"memory");
      #pragma unroll
      for(int i=0;i<4;++i){const int row=i*8+(lane>>3),ch=lane&7; const u32x4 v=*(const u32x4*)(stg+row*64+ch*8); ATTN_STORE16(Ow+(long)row*DM+hf*64+ch*8,v);}
      asm volatile("s_waitcnt lgkmcnt(0)":::"memory"); }
  } else {
    const int ch=lane&7,rw=lane>>3;
    u32x4 v1[2][4];
    #pragma unroll
    for(int hf=0;hf<2;++hf)
      #pragma unroll
      for(int i=0;i<4;++i)v1[hf][i]=*(const u32x4*)(Ow+(long)(i*8+rw)*DM+hf*64+ch*8);
    float cv[2][4][8]; float ss[4]={0.f,0.f,0.f,0.f};
    #pragma unroll
    for(int hf=0;hf<2;++hf){
      #pragma unroll
      for(int r=0;r<16;++r){const int orow=crow(r,hi);
        #pragma unroll
        for(int d0=0;d0<2;++d0)stg[orow*64+d0*32+r32]=__float2bfloat16(o[2*hf+d0][r]*rli[r]);}
      asm volatile("s_waitcnt lgkmcnt(0)":::"memory");
      #pragma unroll
      for(int i=0;i<4;++i){ const u32x4 v2=*(const u32x4*)(stg+(i*8+rw)*64+ch*8);
        #pragma unroll
        for(int e=0;e<4;++e){ const unsigned a=v1[hf][i][e],c2=v2[e];
          const float c0=__uint_as_float(a<<16)-lam*__uint_as_float(c2<<16), c1=__uint_as_float(a&0xffff0000u)-lam*__uint_as_float(c2&0xffff0000u);
          cv[hf][i][2*e]=c0; cv[hf][i][2*e+1]=c1; ss[i]+=c0*c0+c1*c1; } }
      asm volatile("s_waitcnt lgkmcnt(0)":::"memory"); }
    float rs[4];
    #pragma unroll
    for(int i=0;i<4;++i){ float t=ss[i];
      t+=__int_as_float(__builtin_amdgcn_ds_swizzle(__float_as_int(t),(1<<10)|0x1f)); t+=__int_as_float(__builtin_amdgcn_ds_swizzle(__float_as_int(t),(2<<10)|0x1f)); t+=__int_as_float(__builtin_amdgcn_ds_swizzle(__float_as_int(t),(4<<10)|0x1f));
      rs[i]=__builtin_amdgcn_rsqf(t*(1.f/128.f)+1e-6f)*osc; }
    bf16*Hw=HBo+(rowbase+q0+wid*QBLK)*DM+ocol;
    #pragma unroll
    for(int hf=0;hf<2;++hf){ float g8[8];
      #pragma unroll
      for(int e=0;e<8;++e)g8[e]=subg[hf*64+ch*8+e];
      #pragma unroll
      for(int i=0;i<4;++i){ u32x4 w;
        #pragma unroll
        for(int e=0;e<4;++e)w[e]=cvtpk_s(cv[hf][i][2*e]*rs[i]*g8[2*e],cv[hf][i][2*e+1]*rs[i]*g8[2*e+1]);
        ATTN_STORE16(Hw+(long)(i*8+rw)*DM+hf*64+ch*8,w); } }
  }
  asm volatile("s_waitcnt lgkmcnt(0)\n\ts_barrier":::"memory");
  #undef DMA_K
  #undef DMA_V
  #undef CMASK
  #undef START
  #undef RESC
  #undef ROT
}

typedef __attribute__((address_space(3))) volatile unsigned* lds_vu32;
__device__ __forceinline__ void smask(f32x16&p0,f32x16&p1,int jb,int qrel,int hi){
  const float NEG=-INFINITY; const int thr=qrel-64*jb-4*hi;
  #pragma unroll
  for(int r=0;r<16;++r){const int kc=(r&3)+8*(r>>2); if(kc>=thr)p0[r]=NEG; if(kc+32>=thr)p1[r]=NEG;}
}
typedef __attribute__((address_space(3))) u32x4* lds_v4p;
__device__ __forceinline__ void sb_item(int b,int h,int rb,const bf16*Q,const bf16*__restrict__ K,const bf16*__restrict__ V,bf16*O,char*shm,const int wv){
  int tid_=wv*64+lane_id_(); asm volatile("":"+v"(tid_)); const int tid=tid_,lane=tid&63,r32=lane&31,hi=lane>>5; const int wid=__builtin_amdgcn_readfirstlane(tid>>6);
  const long rowbase=(long)b*SEQ; const int r0=rb*QBLK;
  const bf16*Qw=Q+(rowbase+r0)*DM+h*D;
  const bf16*Kh=K+rowbase*DM+h*D,*Vh=V+rowbase*DM+h*D;
  char*wl=shm+wid*16384;
  const lds_cptr wl3=(lds_cptr)wl;
  const unsigned lds0=(unsigned)(uintptr_t)wl;
  const int vb=(int)lds0+8192+((lane>>4)&1)*32+(lane&3)*8+(4*hi+((lane&15)>>2))*64;
  const int lrow=lane>>3,lch=lane&7;
  const lds_v4p kw0=(lds_v4p)(wl3+lch*1024+((lrow^(2*lch))<<4)), kw1=(lds_v4p)(wl3+lch*1024+(((lrow|8)^(2*lch))<<4));
  const lds_v4p vw=(lds_v4p)(wl3+8192+(lch>>2)*4096+lrow*64+(lch&3)*16);
  const bf16*kbase=Kh+(long)lrow*DM+lch*8;
  const bf16*vbase=Vh+(long)lrow*DM+lch*8;
  int koff4[4];
  #pragma unroll
  for(int d0=0;d0<4;++d0)koff4[d0]=(2*d0+hi)*1024+((r32^(2*(2*d0+hi)))<<4);
  bf16x8 qr[4];
  #pragma unroll
  for(int d0=0;d0<4;++d0)qr[d0]=*reinterpret_cast<const bf16x8*>(&Qw[(long)r32*DM+d0*16+hi*8]);
  int t=(r0+QBLK-2)>>6;
  u32x4 ks[8],vs[8]; bf16x8 kf[8];
  #define SB_LD(tt) do{ _Pragma("unroll") for(int i=0;i<8;++i){ ks[i]=*reinterpret_cast<const u32x4*>(kbase+(long)(64*(tt)+8*i)*DM); vs[i]=*reinterpret_cast<const u32x4*>(vbase+(long)(64*(tt)+8*i)*DM); } }while(0)
  #define SB_ST() do{ _Pragma("unroll") for(int i=0;i<8;++i){ if(i&1) kw1[(i>>1)*16]=ks[i]; else kw0[(i>>1)*16]=ks[i]; vw[32*i]=vs[i]; } }while(0)
  #define SB_KF() do{ _Pragma("unroll") for(int d0=0;d0<4;++d0){ kf[2*d0]=*(const __attribute__((address_space(3))) bf16x8*)(wl3+koff4[d0]); kf[2*d0+1]=*(const __attribute__((address_space(3))) bf16x8*)(wl3+koff4[d0]+512); } }while(0)
  SB_LD(t); SB_ST();
  f32x16 o[2];o[0]=f32x16{};o[1]=f32x16{};
  float Cc=1.f; bool first=true;
  for(;;){
    const bool more=t>0; const int tn=more?t-1:0;
    SB_LD(tn);
    SB_KF();
    f32x16 p0,p1;
    #pragma unroll
    for(int d0=0;d0<4;++d0){
      if(d0==0){const f32x16 z=f32x16{};p0=__builtin_amdgcn_mfma_f32_32x32x16_bf16(kf[0],qr[0],z,0,0,0);p1=__builtin_amdgcn_mfma_f32_32x32x16_bf16(kf[1],qr[0],z,0,0,0);}
      else{p0=__builtin_amdgcn_mfma_f32_32x32x16_bf16(kf[2*d0],qr[d0],p0,0,0,0);p1=__builtin_amdgcn_mfma_f32_32x32x16_bf16(kf[2*d0+1],qr[d0],p1,0,0,0);}}
    if(first){ const float NEG=-INFINITY; const int thr=r0+r32-64*t-4*hi;
      #pragma unroll
      for(int r=0;r<16;++r){const int kc=(r&3)+8*(r>>2); if(kc>=thr)p0[r]=NEG; if(kc+32>=thr)p1[r]=NEG;} }
    f32x16 W0,W1;
    #pragma unroll
    for(int r=0;r<16;++r){
      const float e0=__builtin_amdgcn_exp2f(p0[r]),e1=__builtin_amdgcn_exp2f(p1[r]);
      const float w0=__builtin_amdgcn_rcpf(1.0f+e0),w1=__builtin_amdgcn_rcpf(1.0f+e1);
      W0[r]=w0;W1[r]=w1;p0[r]=1.0f-w0;p1[r]=1.0f-w1; }
    float own[8],oth[8],base[8];
    #pragma unroll
    for(int m=0;m<4;++m){ own[m]=(W0[4*m]*W0[4*m+1])*(W0[4*m+2]*W0[4*m+3]); own[4+m]=(W1[4*m]*W1[4*m+1])*(W1[4*m+2]*W1[4*m+3]); }
    #pragma unroll
    for(int m=0;m<8;++m){ auto rr=__builtin_amdgcn_permlane32_swap(__float_as_uint(own[m]),__float_as_uint(own[m]),false,false); oth[m]=__uint_as_float(hi?rr[0]:rr[1]); }
    float tot=Cc;
    #pragma unroll
    for(int m=7;m>=0;--m){ base[m]=hi?tot:tot*oth[m]; tot*=own[m]*oth[m]; }
    Cc=tot;
    #pragma unroll
    for(int m=0;m<4;++m){
      { const float a3=base[m],a2=a3*W0[4*m+3],a1=a2*W0[4*m+2],a0=a1*W0[4*m+1];
        p0[4*m+0]*=a0; p0[4*m+1]*=a1; p0[4*m+2]*=a2; p0[4*m+3]*=a3; }
      { const float a3=base[4+m],a2=a3*W1[4*m+3],a1=a2*W1[4*m+2],a0=a1*W1[4*m+1];
        p1[4*m+0]*=a0; p1[4*m+1]*=a1; p1[4*m+2]*=a2; p1[4*m+3]*=a3; } }
    #define PKW(P,B) cvtpk_s(P[B],P[B+1])
    u32x4 pw0=(u32x4){PKW(p0,0),PKW(p0,2),PKW(p0,4),PKW(p0,6)},pw1=(u32x4){PKW(p0,8),PKW(p0,10),PKW(p0,12),PKW(p0,14)},pw2=(u32x4){PKW(p1,0),PKW(p1,2),PKW(p1,4),PKW(p1,6)},pw3=(u32x4){PKW(p1,8),PKW(p1,10),PKW(p1,12),PKW(p1,14)};
    #undef PKW
    pv(o,vb,__builtin_bit_cast(bf16x8,pw0),__builtin_bit_cast(bf16x8,pw1),__builtin_bit_cast(bf16x8,pw2),__builtin_bit_cast(bf16x8,pw3));
    if(!more||__all(Cc==0.f))break;
    SB_ST();
    --t; first=false;
  }
  #undef SB_LD
  #undef SB_ST
  #undef SB_KF
  bf16*Ow=O+(rowbase+r0)*DM+h*D;
  { bf16*stg=(bf16*)wl;
    #pragma unroll
    for(int r=0;r<16;++r){const int orow=crow(r,hi);
      #pragma unroll
      for(int d0=0;d0<2;++d0)stg[orow*64+d0*32+r32]=__float2bfloat16(o[d0][r]);}
    asm volatile("s_waitcnt lgkmcnt(0)":::"memory");
    #pragma unroll
    for(int i=0;i<4;++i){const int row=i*8+(lane>>3),ch=lane&7; const u32x4 v=*(const u32x4*)(stg+row*64+ch*8); ATTN_STORE16(Ow+(long)row*DM+ch*8,v);} }
  asm volatile("s_waitcnt lgkmcnt(0)":::"memory");
}
constexpr int ATTN_LDS_BYTES=LDS2_BYTES;
template<int THRL> __device__ __forceinline__ void diff_attn_phase(char*lds,const bf16*Q,const bf16*K,const bf16*V,bf16*OA,bf16*HBo,const float lam,const float*subg,const float osc,int G,int vcu,const int wv){
  for(int i=0;;++i){ const int grp=(vcu>>3)+(G>>3)*(i>>2); if(grp>=BATCH*(NHEAD/2))break; const int s=vcu&7,ii=i&3; const int qb=(ii==0)?s:(ii==1)?15-s:(ii==2)?16+s:31-s;
    const int b=grp>>3,h=grp&7; const int vcol=h*128;
    attn_unit128<THRL,false>(b,(2*h)*64,(2*h)*64,vcol,vcol,qb,Q,K,V,OA,lds,wv,HBo,lam,subg,osc);
    attn_unit128<THRL,true>(b,(2*h+1)*64,(2*h+1)*64,vcol,vcol,qb,Q,K,V,OA,lds,wv,HBo,lam,subg,osc); }
}
__device__ __forceinline__ void sb_attn_phase(char*lds,const bf16*Q,const bf16*K,const bf16*V,bf16*O,int G,int vcu,const int wv){
  const int wid=wv;
  for(int i=0;;++i){ const int grp=(vcu>>3)+(G>>3)*(i>>2); if(grp>=BATCH*NHEAD)break; const int rb=(((i&3)*8+(vcu&7))*8+wid);
    sb_item(grp>>4,grp&15,rb,Q,K,V,O,lds,wv); }
}
#undef SBAR
#undef WAIT_BAR
}

constexpr int NWAVES = 8;
constexpr int BATCH = 4, T = 8192, D = 1024, M = BATCH * T, NQKV = 3 * D, NE = 32, FF = 512;
constexpr float NORM_EPS = 1e-6f;
constexpr float C2 = 0.125f * 1.4426950408889634f;
constexpr float LAM_INIT0 = 0.2f;

constexpr size_t MiB = 1u << 20;
constexpr size_t WS_CTL = 0, CTL_ZERO_BYTES = 64 * 1024;
constexpr size_t WS_MOD = 1 * MiB;
constexpr size_t WS_GATEW = 1 * MiB + 256 * 1024;
constexpr size_t WS_WQKV = 2 * MiB, WS_WO = 14 * MiB, WS_W1 = 18 * MiB, WS_W2 = 146 * MiB;
constexpr size_t WS_HB = 210 * MiB;
constexpr size_t WS_Q = 274 * MiB, WS_K = 338 * MiB, WS_V = 402 * MiB, WS_OA = 466 * MiB;
constexpr size_t WS_Y2 = 274 * MiB;
constexpr size_t WS_HID = 402 * MiB;
constexpr size_t WS_LIST = 474 * MiB;
constexpr size_t WS_END = 530 * MiB;
constexpr int CW_TMO = 0, CW_CODE = 1, CW_BAR = 4096, CW_CNT = 8192;

constexpr int RING_OFF = 0, RING_BYTES = 135168;
constexpr int LDSCTL_OFF = RING_BYTES, MISC_OFF = LDSCTL_OFF + 320;
constexpr int TAB_CNT = LDSCTL_OFF + 512, TAB_PRE = LDSCTL_OFF + 640, TAB_BR = LDSCTL_OFF + 896, TAB_LCNT = LDSCTL_OFF + 1024, TAB_LBASE = LDSCTL_OFF + 1152;
constexpr int TAB_ASG_E = LDSCTL_OFF + 1280, TAB_ASG_S = LDSCTL_OFF + 2304, TAB_ASG_D = LDSCTL_OFF + 3328;
constexpr int LDS_BYTES = 147456;
static_assert(TAB_ASG_D + 1024 <= LDS_BYTES, "LDS map");
#define GAS __attribute__((address_space(1)))
#define LAS __attribute__((address_space(3)))
typedef unsigned short bf16;
typedef unsigned v4u __attribute__((ext_vector_type(4)));
typedef float f32x4 __attribute__((ext_vector_type(4)));
typedef short bf16x8 __attribute__((ext_vector_type(8)));
typedef GAS unsigned gu32;
typedef GAS unsigned long long gu64;
#define RLX_AGENT __ATOMIC_RELAXED, __HIP_MEMORY_SCOPE_AGENT
#define LDS_WAIT() asm volatile("s_waitcnt lgkmcnt(0)" ::: "memory")
#define VM_WAIT() asm volatile("s_waitcnt vmcnt(0)" ::: "memory")
__device__ __forceinline__ unsigned long long rt() { return __builtin_amdgcn_s_memrealtime(); }
__device__ __forceinline__ unsigned f2bf(float f) { unsigned u = __builtin_bit_cast(unsigned, f); return (u + 0x7fffu + ((u >> 16) & 1u)) >> 16; }
__device__ __forceinline__ unsigned pk2(float lo, float hi) { return f2bf(lo) | (f2bf(hi) << 16); }

#define XB_TMO      128
#define XB_XCNT(j)  (256  + 64 * (j))
#define XB_XSUB(j)  (1280 + 64 * (j))
#define XB_XGEN(j)  (2304 + 64 * (j))
#define XB_TOP      3328
#define XB_TOPGEN   3392
#define XCD_BAR_WORDS 3456
#define XB_SPIN_CAP (1u << 18)

__device__ __forceinline__ unsigned xb_ld(unsigned* p)              { return __hip_atomic_load(p, __ATOMIC_RELAXED, __HIP_MEMORY_SCOPE_AGENT); }
__device__ __forceinline__ unsigned xb_add(unsigned* p, unsigned v) { return __hip_atomic_fetch_add(p, v, __ATOMIC_RELAXED, __HIP_MEMORY_SCOPE_AGENT); }
__device__ __forceinline__ unsigned xb_xcc_id() { return (unsigned)__builtin_amdgcn_s_getreg((3 << 11) | 20) & 0xFu; }
#define XB_SPIN(cond, bar) do { unsigned _sp = 0; while (cond) { __builtin_amdgcn_s_sleep(1); \
    if ((++_sp & 255u) == 0u) { if (xb_ld(&(bar)[XB_TMO])) break; if (_sp > XB_SPIN_CAP) { atomicAdd(&(bar)[XB_TMO], 1u); break; } } } } while (0)

struct XcdBarrier {
    unsigned* bar; unsigned x; int wv;
    volatile LAS unsigned* st;
};

__device__ __forceinline__ XcdBarrier xcd_barrier_post(unsigned* bar, volatile LAS unsigned* st, int wv) {
    XcdBarrier b; b.bar = bar; b.x = xb_xcc_id(); b.st = st; b.wv = wv;
    if (threadIdx.x == 0) (void)xb_add(&bar[XB_XCNT(b.x)], 1u);
    return b;
}
__device__ __forceinline__ void xcd_barrier_complete(unsigned* bar, unsigned x, unsigned& nloc, unsigned& nx) {
    const unsigned G = gridDim.x * gridDim.y * gridDim.z;
    unsigned sum, cnt, mine, sp = 0u;
    for (;;) {
        sum = 0u; cnt = 0u; mine = 0u;
#pragma unroll
        for (unsigned j = 0; j < 16; ++j) { const unsigned c = xb_ld(&bar[XB_XCNT(j)]); sum += c; cnt += (c > 0u) ? 1u : 0u; mine = (j == x) ? c : mine; }
        if (sum == G) break;
        __builtin_amdgcn_s_sleep(1);
        if ((++sp & 255u) == 0u) { if (xb_ld(&bar[XB_TMO])) break; if (sp > XB_SPIN_CAP) { atomicAdd(&bar[XB_TMO], 1u); break; } }
    }
    nloc = mine > 0u ? mine : 1u; nx = cnt > 0u ? cnt : 1u;
}

__device__ __forceinline__ void xcd_barrier(const XcdBarrier& b) {
    asm volatile("s_waitcnt vmcnt(0)" ::: "memory");
    __syncthreads();
    if (b.wv == 0 && lane_id_() == 0) {
        unsigned* bar = b.bar; unsigned bx_ = b.x; asm volatile("" : "+s"(bx_));
        __builtin_amdgcn_s_waitcnt(0);
        unsigned nloc = b.st[0], nx = b.st[1];
        if (nloc == 0u) { xcd_barrier_complete(bar, bx_, nloc, nx); b.st[0] = nloc; b.st[1] = nx; }
        const unsigned old = xb_add(&bar[XB_XSUB(bx_)], 1u);
        const unsigned gen = old / nloc;
        if (old + 1u == (gen + 1u) * nloc) {
            __builtin_amdgcn_fence(__ATOMIC_RELEASE, "agent");
            asm volatile("s_waitcnt vmcnt(0)" ::: "memory");
            const unsigned og = xb_add(&bar[XB_TOP], 1u);
            const unsigned tg = og / nx;
            if (og + 1u == (tg + 1u) * nx) xb_add(&bar[XB_TOPGEN], 1u);
            else XB_SPIN(xb_ld(&bar[XB_TOPGEN]) == tg, bar);
            __builtin_amdgcn_fence(__ATOMIC_ACQUIRE, "agent");
            xb_add(&bar[XB_XGEN(bx_)], 1u);
            asm volatile("s_waitcnt vmcnt(0)" ::: "memory");
        } else {
            XB_SPIN(xb_ld(&bar[XB_XGEN(bx_)]) == gen, bar);
            __builtin_amdgcn_fence(__ATOMIC_ACQUIRE, "agent");
            asm volatile("s_waitcnt vmcnt(0)" ::: "memory");
        }
    }
    __syncthreads();
}

struct Args { const void* in[16]; float* out; unsigned char* ws; };
struct Frame {
    LAS unsigned char* lds;
    volatile LAS unsigned* MISC;
    gu32* ctl;
    int tid, lane, wave;
    int vcu, G;
    const __attribute__((address_space(4))) Args* a;
};
#define FIN(i)   ((const float*)F.a->in[i])
#define F_x FIN(0)
#define F_c FIN(1)
#define F_pos ((const int*)F.a->in[2])
#define F_w_ada FIN(3)
#define F_b_ada FIN(4)
#define F_norm_g FIN(5)
#define F_w_in FIN(6)
#define F_w_out FIN(7)
#define F_diff_lambda FIN(8)
#define F_subln_g FIN(9)
#define F_w_router FIN(10)
#define F_b_router FIN(11)
#define F_w_gate FIN(12)
#define F_w_up FIN(13)
#define F_w_down FIN(14)
#define F_final_g FIN(15)
#define F_out (F.a->out)
#define F_mod ((float*)(F.a->ws + WS_MOD))
#define F_gatew ((float*)(F.a->ws + WS_GATEW))
#define F_Wqkv_t ((bf16*)(F.a->ws + WS_WQKV))
#define F_Wo_t ((bf16*)(F.a->ws + WS_WO))
#define F_W1_t ((bf16*)(F.a->ws + WS_W1))
#define F_W2_t ((bf16*)(F.a->ws + WS_W2))
#define F_HB ((bf16*)(F.a->ws + WS_HB))
#define F_QB ((bf16*)(F.a->ws + WS_Q))
#define F_KB ((bf16*)(F.a->ws + WS_K))
#define F_VB ((bf16*)(F.a->ws + WS_V))
#define F_OA ((bf16*)(F.a->ws + WS_OA))
#define F_Y2 ((bf16*)(F.a->ws + WS_Y2))
#define F_HID ((bf16*)(F.a->ws + WS_HID))
#define F_list ((int*)(F.a->ws + WS_LIST))
typedef unsigned long long u64;
template <int X> __device__ __forceinline__ float swz_xor(float v) { return __int_as_float(__builtin_amdgcn_ds_swizzle(__float_as_int(v), (X << 10) | 0x1f)); }
__device__ __forceinline__ float half_sum(float v) {
    v += swz_xor<1>(v); v += swz_xor<2>(v); v += swz_xor<4>(v); v += swz_xor<8>(v); v += swz_xor<16>(v); return v;
}
__device__ __forceinline__ float wave_sum(float v) {
    v = half_sum(v);
    const auto rr = __builtin_amdgcn_permlane32_swap(__float_as_uint(v), __float_as_uint(v), false, false);
    return __uint_as_float(rr[0]) + __uint_as_float(rr[1]);
}
__device__ __forceinline__ float bf_lo(unsigned w) { return __uint_as_float(w << 16); }
__device__ __forceinline__ float bf_hi(unsigned w) { return __uint_as_float(w & 0xffff0000u); }
__device__ __forceinline__ f32x4 bf4_to_f32(u64 w) { const unsigned lo = (unsigned)w, hi = (unsigned)(w >> 32); return (f32x4){bf_lo(lo), bf_hi(lo), bf_lo(hi), bf_hi(hi)}; }
__device__ __forceinline__ u64 f32_to_bf4(f32x4 v) { return (u64)pg8::cvt_pk_bf16(v.x, v.y) | ((u64)pg8::cvt_pk_bf16(v.z, v.w) << 32); }

__device__ __forceinline__ int rowmap(int mode, int n) {
    if (mode == 1) { if (n >= 2048) return n; const int d = n & 63; const int p = d < 8 ? 2 * d : (d < 16 ? 2 * (d - 8) + 1 : d); return (n & ~63) + p; }
    if (mode == 2) return 256 * (n >> 7) + (n & 127);
    if (mode == 3) return 256 * (n >> 7) + 128 + (n & 127);
    return n;
}
struct P0Item { const float* W; bf16* WT; int N, K, mode, k0, n0; };
__device__ __forceinline__ void p0_item_load(f32x4 (&w)[16], const P0Item& it, int lane) {
    const float* p = it.W + (size_t)(it.k0 + (lane >> 4)) * it.N + it.n0 + 4 * (lane & 15);
#pragma unroll
    for (int i = 0; i < 16; ++i) w[i] = *(const f32x4*)(p + (size_t)(4 * i) * it.N);
}
__device__ __forceinline__ void p0_item_store(const f32x4 (&w)[16], const P0Item& it, LAS float* scr, int lane) {
    LAS float* wp = scr + (lane >> 4) * 65 + 4 * (lane & 15);
#pragma unroll
    for (int i = 0; i < 16; ++i) { LAS float* q = wp + (4 * i) * 65; q[0] = w[i].x; q[1] = w[i].y; q[2] = w[i].z; q[3] = w[i].w; }
    LDS_WAIT(); asm volatile("" ::: "memory");
    const int c = lane & 7;
#pragma unroll
    for (int j = 0; j < 8; ++j) { const int n = (lane >> 3) + 8 * j; const LAS float* s = scr + (8 * c) * 65 + n;
        v4u o; o.x = pg8::cvt_pk_bf16(s[0 * 65], s[1 * 65]); o.y = pg8::cvt_pk_bf16(s[2 * 65], s[3 * 65]); o.z = pg8::cvt_pk_bf16(s[4 * 65], s[5 * 65]); o.w = pg8::cvt_pk_bf16(s[6 * 65], s[7 * 65]);
        *(GAS v4u*)(it.WT + (size_t)rowmap(it.mode, it.n0 + n) * it.K + it.k0 + 8 * c) = o; }
    LDS_WAIT(); asm volatile("" ::: "memory");
}
__device__ __forceinline__ void p0_prologue(Frame& F) {
    {
        LAS float* sc = (LAS float*)(F.lds);
        LAS float* red = (LAS float*)(F.lds + 16384);
        for (int i = F.tid; i < BATCH * D; i += NWAVES * 64) { const float cv = F_c[i]; sc[i] = cv / (1.f + __expf(-cv)); }
        __syncthreads();
        const int kg = F.tid >> 5, cc = F.tid & 31;
        for (int task = blockIdx.x; task < 2 * 192; task += F.G) {
            const int l = task / 192, col0 = (task % 192) * 32;
            const float* W = F_w_ada + (size_t)l * D * 6144 + col0 + cc;
            float a0 = 0.f, a1 = 0.f, a2 = 0.f, a3 = 0.f;
#pragma unroll 8
            for (int k = kg * 64; k < kg * 64 + 64; ++k) { const float w = W[(size_t)k * 6144]; a0 += sc[k] * w; a1 += sc[1024 + k] * w; a2 += sc[2048 + k] * w; a3 += sc[3072 + k] * w; }
            red[(kg * 4 + 0) * 32 + cc] = a0; red[(kg * 4 + 1) * 32 + cc] = a1; red[(kg * 4 + 2) * 32 + cc] = a2; red[(kg * 4 + 3) * 32 + cc] = a3;
            __syncthreads();
            if (F.tid < 128) { const int b = F.tid >> 5; float s = F_b_ada[l * 6144 + col0 + cc];
#pragma unroll
                for (int g = 0; g < 16; ++g) s += red[(g * 4 + b) * 32 + cc];
                F_mod[(size_t)(l * 4 + b) * 6144 + col0 + cc] = s; }
            __syncthreads();
        }
    }
    const int gw = F.vcu * NWAVES + F.wave, NGW = F.G * NWAVES;
    constexpr int I_IN = (D / 64) * (NQKV / 64), I_O = (D / 64) * (D / 64), I_GU = (D / 64) * (FF / 64), I_DN = (FF / 64) * (D / 64);
    constexpr int N_IN = 2 * I_IN, N_O = 2 * I_O, N_GU = 2 * NE * 2 * I_GU, N_DN = 2 * NE * I_DN, N_ALL = N_IN + N_O + N_GU + N_DN;
#define P0_DECODE(it_, X) do { int r = (it_); \
        if (r < N_IN) { const int l = r / I_IN, q = r % I_IN; X.W = F_w_in + (size_t)l * D * NQKV; X.WT = F_Wqkv_t + (size_t)l * NQKV * D; X.N = NQKV; X.K = D; X.mode = (l == 0) ? 1 : 0; X.k0 = 64 * (q / (NQKV / 64)); X.n0 = 64 * (q % (NQKV / 64)); break; } r -= N_IN; \
        if (r < N_O) { const int l = r / I_O, q = r % I_O; X.W = F_w_out + (size_t)l * D * D; X.WT = F_Wo_t + (size_t)l * D * D; X.N = D; X.K = D; X.mode = 0; X.k0 = 64 * (q / (D / 64)); X.n0 = 64 * (q % (D / 64)); break; } r -= N_O; \
        if (r < N_GU) { const int mat = r / I_GU, q = r % I_GU, le = mat >> 1, gu = mat & 1; X.W = (gu ? F_w_up : F_w_gate) + (size_t)le * D * FF; X.WT = F_W1_t + (size_t)le * 2 * FF * D; X.N = FF; X.K = D; X.mode = 2 + gu; X.k0 = 64 * (q / (FF / 64)); X.n0 = 64 * (q % (FF / 64)); break; } r -= N_GU; \
        { const int le = r / I_DN, q = r % I_DN; X.W = F_w_down + (size_t)le * FF * D; X.WT = F_W2_t + (size_t)le * D * FF; X.N = D; X.K = FF; X.mode = 0; X.k0 = 64 * (q / (D / 64)); X.n0 = 64 * (q % (D / 64)); } } while (0)
    f32x4 wa[16], wb[16]; P0Item ia, ib; LAS float* scr = (LAS float*)(F.lds + RING_OFF + F.wave * 16640);
    int it = gw;
    { const int c0 = it < N_ALL ? it : N_ALL - 1; P0_DECODE(c0, ia); p0_item_load(wa, ia, F.lane); }
    while (it < N_ALL) {
        const int it1 = it + NGW, c1 = it1 < N_ALL ? it1 : N_ALL - 1;
        P0_DECODE(c1, ib); p0_item_load(wb, ib, F.lane);
        p0_item_store(wa, ia, scr, F.lane);
        const int it2 = it1 + NGW, c2 = it2 < N_ALL ? it2 : N_ALL - 1;
        P0_DECODE(c2, ia); p0_item_load(wa, ia, F.lane);
        if (it1 < N_ALL) p0_item_store(wb, ib, scr, F.lane);
        it = it2;
    }
#undef P0_DECODE
}

template <bool COMBINE> __device__ __forceinline__ void n1_phase(Frame& F, const int l, const float* xin, float* xout) {
    const int gw = F.vcu * NWAVES + F.wave, NGW = F.G * NWAVES, RPW = (M + NGW - 1) / NGW;
    const int m0 = gw * RPW, m1 = (m0 + RPW < M) ? m0 + RPW : M;
    int bcur = -1; f32x4 gs[4], sh[4], gm[4];
#pragma unroll
    for (int j = 0; j < 4; ++j) { gs[j] = (f32x4){0.f, 0.f, 0.f, 0.f}; sh[j] = gs[j]; gm[j] = gs[j]; }
    const float* ng = F_norm_g + (size_t)(l * 2 + 0) * D;
    for (int m = m0; m < m1; ++m) {
        const int b = m / T;
        if (b != bcur) { bcur = b; const float* mp = F_mod + (size_t)(l * 4 + b) * 6144;
#pragma unroll
            for (int j = 0; j < 4; ++j) { const int col = 4 * F.lane + 256 * j; const f32x4 g = *(const f32x4*)(ng + col), sc = *(const f32x4*)(mp + 1024 + col);
                gs[j] = g * (sc + 1.0f); sh[j] = *(const f32x4*)(mp + col);
                if (COMBINE) gm[j] = *(const f32x4*)(F_mod + (size_t)((l - 1) * 4 + b) * 6144 + 5120 + col); } }
        const GAS f32x4* xr = (const GAS f32x4*)(xin + (size_t)m * D) + F.lane;
        f32x4 v[4];
#pragma unroll
        for (int j = 0; j < 4; ++j) v[j] = xr[64 * j];
        if (COMBINE) { const GAS u64* ya = (const GAS u64*)(F_Y2 + (size_t)(2 * m) * D) + F.lane; const GAS u64* yb = ya + D / 4;
            GAS f32x4* xo = (GAS f32x4*)(xout + (size_t)m * D) + F.lane;
            const float w0 = F_gatew[2 * m], w1 = F_gatew[2 * m + 1];
#pragma unroll
            for (int j = 0; j < 4; ++j) { const f32x4 fa = bf4_to_f32(ya[64 * j]), fb = bf4_to_f32(yb[64 * j]); v[j] = v[j] + gm[j] * (fa * w0 + fb * w1); xo[64 * j] = v[j]; } }
        float s2 = 0.f;
#pragma unroll
        for (int j = 0; j < 4; ++j) s2 += (v[j].x * v[j].x + v[j].y * v[j].y) + (v[j].z * v[j].z + v[j].w * v[j].w);
        const float rstd = __builtin_amdgcn_rsqf(wave_sum(s2) * (1.f / D) + NORM_EPS);
        GAS u64* o8 = (GAS u64*)(F_HB + (size_t)m * D) + F.lane;
#pragma unroll
        for (int j = 0; j < 4; ++j) o8[64 * j] = f32_to_bf4(v[j] * rstd * gs[j] + sh[j]);
    }
}
__device__ __forceinline__ void final_phase(Frame& F, const float* xin, float* xout) {
    const int gw = F.vcu * NWAVES + F.wave, NGW = F.G * NWAVES, RPW = (M + NGW - 1) / NGW;
    const int m0 = gw * RPW, m1 = (m0 + RPW < M) ? m0 + RPW : M;
    int bcur = -1; f32x4 fg[4], gm[4];
#pragma unroll
    for (int j = 0; j < 4; ++j) { fg[j] = *(const f32x4*)(F_final_g + 4 * F.lane + 256 * j); gm[j] = (f32x4){0.f, 0.f, 0.f, 0.f}; }
    for (int m = m0; m < m1; ++m) {
        const int b = m / T;
        if (b != bcur) { bcur = b;
#pragma unroll
            for (int j = 0; j < 4; ++j) gm[j] = *(const f32x4*)(F_mod + (size_t)(1 * 4 + b) * 6144 + 5120 + 4 * F.lane + 256 * j); }
        const GAS f32x4* xr = (const GAS f32x4*)(xin + (size_t)m * D) + F.lane;
        const GAS u64* ya = (const GAS u64*)(F_Y2 + (size_t)(2 * m) * D) + F.lane; const GAS u64* yb = ya + D / 4;
        f32x4 v[4]; float s2 = 0.f; const float w0 = F_gatew[2 * m], w1 = F_gatew[2 * m + 1];
#pragma unroll
        for (int j = 0; j < 4; ++j) { v[j] = xr[64 * j] + gm[j] * (bf4_to_f32(ya[64 * j]) * w0 + bf4_to_f32(yb[64 * j]) * w1); s2 += (v[j].x * v[j].x + v[j].y * v[j].y) + (v[j].z * v[j].z + v[j].w * v[j].w); }
        const float rstd = __builtin_amdgcn_rsqf(wave_sum(s2) * (1.f / D) + NORM_EPS);
        GAS f32x4* xo = (GAS f32x4*)(xout + (size_t)m * D) + F.lane;
#pragma unroll
        for (int j = 0; j < 4; ++j) xo[64 * j] = v[j] * rstd * fg[j];
    }
}
__device__ __forceinline__ int crow_(int r, int hi) { return (r & 3) + 8 * (r >> 2) + 4 * hi; }
__device__ __forceinline__ void n2_phase(Frame& F, const int l, const float* xin, const int cset) {
    typedef float f32x16 __attribute__((ext_vector_type(16)));
    LAS float* tileA = (LAS float*)F.lds;
    LAS float* part = (LAS float*)F.lds;
    LAS float* logit = (LAS float*)(F.lds + 65536);
    LAS int* lcnt = (LAS int*)(F.lds + TAB_LCNT); LAS int* lbase = (LAS int*)(F.lds + TAB_LBASE);
    LAS int* asg_e = (LAS int*)(F.lds + TAB_ASG_E); LAS int* asg_s = (LAS int*)(F.lds + TAB_ASG_S); LAS int* asg_d = (LAS int*)(F.lds + TAB_ASG_D);
    LAS float* br = (LAS float*)(F.lds + TAB_BR);
    if (F.tid < 32) { lcnt[F.tid] = 0; br[F.tid] = F_b_router[F.tid]; }
    __syncthreads();
    gu32* gcnt = F.ctl + CW_CNT + 64 * cset;
    const float* ng = F_norm_g + (size_t)(l * 2 + 1) * D;
    const int ei = F.lane & 31, kk = F.lane >> 5;
    typedef short bf16x8_t __attribute__((ext_vector_type(8)));
    bf16x8_t whi[8], wlo[8];
#pragma unroll
    for (int sx = 0; sx < 8; ++sx) { v4u h4, l4;
#pragma unroll
        for (int jp = 0; jp < 4; ++jp) { const int k0 = 128 * F.wave + 16 * sx + 8 * kk + 2 * jp; const float w0 = F_w_router[k0 * 32 + ei], w1 = F_w_router[(k0 + 1) * 32 + ei];
            const unsigned hp = pg8::cvt_pk_bf16(w0, w1); h4[jp] = hp; l4[jp] = pg8::cvt_pk_bf16(w0 - bf_lo(hp), w1 - bf_hi(hp)); }
        whi[sx] = __builtin_bit_cast(bf16x8_t, h4); wlo[sx] = __builtin_bit_cast(bf16x8_t, l4); }
    constexpr int NT32 = M / 32;
#define N2_TILE(n) (F.vcu * 4 + ((n) >> 2) * F.G * 4 + ((n) & 3))
#define N2_LOAD(tile_) do { _Pragma("unroll") for (int rr = 0; rr < 4; ++rr) { const size_t m_ = (size_t)((tile_) * 32 + 4 * F.wave + rr); const GAS f32x4* xr = (const GAS f32x4*)(xin + m_ * D) + F.lane; \
        _Pragma("unroll") for (int j = 0; j < 4; ++j) v[rr][j] = xr[64 * j]; } } while (0)
    f32x4 v[4][4];
    int n = 0, tile = N2_TILE(0); bool have = tile < NT32;
    if (have) N2_LOAD(tile);
    while (have) {
        const int ti = n & 3, row0 = tile * 32, b = row0 / T; u64 mx[4][4];
#pragma unroll
        for (int rr = 0; rr < 4; ++rr) { const GAS u64* mr = (const GAS u64*)(F_QB + (size_t)(row0 + 4 * F.wave + rr) * D) + F.lane;
#pragma unroll
            for (int j = 0; j < 4; ++j) mx[rr][j] = mr[64 * j]; }
        const float* mp = F_mod + (size_t)(l * 4 + b) * 6144 + 3072;
        float s2[4] = {0.f, 0.f, 0.f, 0.f};
#pragma unroll
        for (int j = 0; j < 4; ++j) { const int col = 4 * F.lane + 256 * j; const f32x4 gaj = *(const f32x4*)(mp - 1024 + col);
#pragma unroll
            for (int rr = 0; rr < 4; ++rr) { const f32x4 x1 = v[rr][j] + gaj * bf4_to_f32(mx[rr][j]); v[rr][j] = x1;
                *((GAS f32x4*)(F_out + (size_t)(row0 + 4 * F.wave + rr) * D + col)) = x1; s2[rr] += (x1.x * x1.x + x1.y * x1.y) + (x1.z * x1.z + x1.w * x1.w); } }
#pragma unroll
        for (int rr = 0; rr < 4; ++rr) s2[rr] = wave_sum(s2[rr]);
        float rstd[4];
#pragma unroll
        for (int rr = 0; rr < 4; ++rr) rstd[rr] = __builtin_amdgcn_rsqf(s2[rr] * (1.f / D) + NORM_EPS);
#pragma unroll
        for (int j = 0; j < 4; ++j) { const int col = 4 * F.lane + 256 * j; const f32x4 g = *(const f32x4*)(ng + col), sc = *(const f32x4*)(mp + 1024 + col), shj = *(const f32x4*)(mp + col); const f32x4 gsj = g * (sc + 1.0f);
#pragma unroll
            for (int rr = 0; rr < 4; ++rr) { const int r = 4 * F.wave + rr; const f32x4 h = v[rr][j] * rstd[rr] * gsj + shj;
                *((GAS u64*)(F_HB + (size_t)(row0 + r) * D + col)) = f32_to_bf4(h); *(LAS f32x4*)(tileA + r * 1028 + col) = h; } }
        const int n1 = n + 1, tile1 = N2_TILE(n1); const bool have1 = tile1 < NT32;
        if (have1) N2_LOAD(tile1);
        __syncthreads();
        f32x16 acc = {};
#pragma unroll
        for (int sx = 0; sx < 8; ++sx) { const LAS float* ap = tileA + ei * 1028 + 128 * F.wave + 16 * sx + 8 * kk; const f32x4 a0 = *(const LAS f32x4*)ap, a1 = *(const LAS f32x4*)(ap + 4);
            v4u h4, l4;
            h4[0] = pg8::cvt_pk_bf16(a0.x, a0.y); h4[1] = pg8::cvt_pk_bf16(a0.z, a0.w); h4[2] = pg8::cvt_pk_bf16(a1.x, a1.y); h4[3] = pg8::cvt_pk_bf16(a1.z, a1.w);
            l4[0] = pg8::cvt_pk_bf16(a0.x - bf_lo(h4[0]), a0.y - bf_hi(h4[0])); l4[1] = pg8::cvt_pk_bf16(a0.z - bf_lo(h4[1]), a0.w - bf_hi(h4[1]));
            l4[2] = pg8::cvt_pk_bf16(a1.x - bf_lo(h4[2]), a1.y - bf_hi(h4[2])); l4[3] = pg8::cvt_pk_bf16(a1.z - bf_lo(h4[3]), a1.w - bf_hi(h4[3]));
            const bf16x8_t ahi = __builtin_bit_cast(bf16x8_t, h4), alo = __builtin_bit_cast(bf16x8_t, l4);
            acc = __builtin_amdgcn_mfma_f32_32x32x16_bf16(ahi, whi[sx], acc, 0, 0, 0); acc = __builtin_amdgcn_mfma_f32_32x32x16_bf16(ahi, wlo[sx], acc, 0, 0, 0);
            acc = __builtin_amdgcn_mfma_f32_32x32x16_bf16(alo, whi[sx], acc, 0, 0, 0); }
        __syncthreads();
#pragma unroll
        for (int r = 0; r < 16; ++r) part[(F.wave * 32 + crow_(r, kk)) * 33 + ei] = acc[r];
        __syncthreads();
        { const int row = F.tid >> 4;
#pragma unroll
            for (int e2 = 0; e2 < 32; e2 += 16) { const int e = (F.tid & 15) + e2; float s = 0.f;
#pragma unroll
                for (int w = 0; w < 8; ++w) s += part[(w * 32 + row) * 33 + e];
                logit[row * 33 + e] = s; } }
        __syncthreads();
        if (F.tid < 32) { const int row = F.tid, m = row0 + row; const LAS float* lg = logit + row * 33;
            float mx = lg[0];
#pragma unroll
            for (int e = 1; e < 32; ++e) mx = fmaxf(mx, lg[e]);
            float sum = 0.f;
#pragma unroll
            for (int e = 0; e < 32; ++e) sum += __expf(lg[e] - mx);
            const float inv = 1.0f / sum;
            float bestg = -INFINITY; int gb = 0;
#pragma unroll
            for (int g = 0; g < 4; ++g) { float t1 = -INFINITY, t2 = -INFINITY;
#pragma unroll
                for (int jj = 0; jj < 8; ++jj) { const int e = 8 * g + jj; const float sv = __expf(lg[e] - mx) * inv + br[e]; if (sv > t1) { t2 = t1; t1 = sv; } else if (sv > t2) t2 = sv; }
                const float gsv = t1 + t2; if (gsv > bestg) { bestg = gsv; gb = g; } }
            float t1 = -INFINITY, t2 = -INFINITY; int i1 = 0, i2 = 0;
#pragma unroll
            for (int jj = 0; jj < 8; ++jj) { const int e = 8 * gb + jj; const float sv = __expf(lg[e] - mx) * inv + br[e]; if (sv > t1) { t2 = t1; i2 = i1; t1 = sv; i1 = jj; } else if (sv > t2) { t2 = sv; i2 = jj; } }
            const int e1 = 8 * gb + i1, e2 = 8 * gb + i2;
            const float sc1 = __expf(lg[e1] - mx) * inv, sc2 = __expf(lg[e2] - mx) * inv, ig = 1.0f / (sc1 + sc2);
            const int a = (ti * 32 + row) * 2;
            asg_e[a] = e1; asg_s[a] = atomicAdd((int*)(lcnt + e1), 1); asg_d[a] = 2 * m; F_gatew[2 * m] = sc1 * ig;
            asg_e[a + 1] = e2; asg_s[a + 1] = atomicAdd((int*)(lcnt + e2), 1); asg_d[a + 1] = 2 * m + 1; F_gatew[2 * m + 1] = sc2 * ig; }
        __syncthreads();
        if (ti == 3 || !have1) {
            if (F.tid < 32) { int te = F.tid; asm volatile("" : "+v"(te));
                const int cnum = lcnt[te]; lbase[te] = cnum ? (int)__hip_atomic_fetch_add(gcnt + te, (unsigned)cnum, RLX_AGENT) : 0; lcnt[te] = 0; }
            __syncthreads();
            if (F.tid < 64 * (ti + 1)) { const int e = asg_e[F.tid]; F_list[(size_t)e * M + lbase[e] + asg_s[F.tid]] = asg_d[F.tid]; }
            __syncthreads();
        }
        n = n1; tile = tile1; have = have1;
    }
#undef N2_TILE
#undef N2_LOAD
}
__device__ __forceinline__ void load_counts(Frame& F, const int l) {
    LAS int* cnt = (LAS int*)(F.lds + TAB_CNT); LAS int* pre = (LAS int*)(F.lds + TAB_PRE);
    if (F.tid < 32) cnt[F.tid] = (int)__hip_atomic_load(F.ctl + CW_CNT + 64 * l + F.tid, RLX_AGENT);
    __syncthreads();
    if (F.tid == 0) { int s = 0; for (int e = 0; e < 32; ++e) { pre[e] = s; s += (cnt[e] + 255) >> 8; } pre[32] = s; }
    __syncthreads();
}

__global__ void __launch_bounds__(NWAVES * 64, 2) fwd_kernel(Args args) {
    extern __shared__ __attribute__((aligned(16))) unsigned char lds[];
    Frame F;
    F.lds = (LAS unsigned char*)lds;
    F.MISC = (volatile LAS unsigned*)(F.lds + MISC_OFF);
    F.tid = threadIdx.x; F.lane = F.tid & 63; F.wave = __builtin_amdgcn_readfirstlane(F.tid >> 6);
    F.G = gridDim.x; { const int bx = blockIdx.x; F.vcu = (F.G % 8 == 0) ? (bx % 8) * (F.G / 8) + bx / 8 : bx; }
    F.a = (const __attribute__((address_space(4))) Args*)__builtin_amdgcn_kernarg_segment_ptr(); (void)args; F.ctl = (gu32*)(F.a->ws + WS_CTL);
    for (int u = F.tid; u < (LDS_BYTES - LDSCTL_OFF) / 4; u += NWAVES * 64) ((LAS unsigned*)(F.lds + LDSCTL_OFF))[u] = 0u;
    __syncthreads();
    XcdBarrier bar = xcd_barrier_post((unsigned*)(F.ctl + CW_BAR), F.MISC + 8, F.wave);
#define GRID_BAR() xcd_barrier(bar)
#ifndef PH_MASK
#define PH_MASK 0xFFFFFFu
#endif
#ifndef DUP_MASK
#define DUP_MASK 0u
#endif
#ifndef STAMP_PH
#define STAMP_PH (-1)
#endif
#ifndef STAMP_BLK
#define STAMP_BLK 0
#endif
#ifndef STAMP_AMP
#define STAMP_AMP 4
#endif
    unsigned long long tsa_ = 0ull, tsb_ = 0ull; if (STAMP_PH == 100) tsa_ = rt();
#define PH(k) if constexpr (((PH_MASK) >> (k)) & 1u) _Pragma("unroll") for (int rep_ = 0, phk_ = (k); rep_ < 1 + (int)(((DUP_MASK) >> (k)) & 1u); ++rep_)
#define PHASE_END() do { if (STAMP_PH >= 200 && phk_ == STAMP_PH - 200) tsb_ = rt(); } while (0)
#define PHASE_BEGIN() do { if (STAMP_PH >= 0 && (phk_ == STAMP_PH || phk_ == STAMP_PH - 200)) tsa_ = rt(); if (STAMP_PH >= 0 && STAMP_PH < 100 && phk_ > STAMP_PH && tsb_ == 0ull) tsb_ = rt(); int t_ = F.wave * 64 + lane_id_(); asm volatile("" : "+v"(t_)); F.tid = t_; F.lane = t_ & 63; unsigned long long ka_ = (unsigned long long)F.a; asm volatile("" : "+s"(ka_)); F.a = (const __attribute__((address_space(4))) Args*)ka_; } while (0)
    const LAS int* tcnt = (const LAS int*)(F.lds + TAB_CNT); const LAS int* tpre = (const LAS int*)(F.lds + TAB_PRE);

    PH(0) { if (rep_) GRID_BAR(); PHASE_BEGIN();
    p0_prologue(F);
    PHASE_END(); }
    GRID_BAR();
    PH(1) { if (rep_) GRID_BAR(); PHASE_BEGIN();

    n1_phase<false>(F, 0, F_x, nullptr);
    PHASE_END(); }
    GRID_BAR();
    PH(2) { if (rep_) GRID_BAR(); PHASE_BEGIN();
    {
        pg8::StaticOrder S; S.init(F_HB, F_Wqkv_t, M, NQKV, D, F.G, (int)blockIdx.x);
        pg8::EpiQKV E{F_QB, (size_t)(WS_K - WS_Q) / 2, C2, F_pos, 1};
        pg8::gemm_phase<pg8::EpiQKV, pg8::StaticOrder, true, false>(F.lds + RING_OFF, D, S, E, F.wave);
    }
    PHASE_END(); }
    GRID_BAR();
    PH(3) { if (rep_) GRID_BAR(); PHASE_BEGIN();
    {
        const float s1 = wave_sum(F_diff_lambda[F.lane] * F_diff_lambda[64 + F.lane]), s2l = wave_sum(F_diff_lambda[128 + F.lane] * F_diff_lambda[192 + F.lane]);
        const float lam = __expf(s1) - __expf(s2l) + LAM_INIT0;
        attn_body::diff_attn_phase<8>((char*)lds + RING_OFF, (const attn_body::bf16*)F_QB, (const attn_body::bf16*)F_KB, (const attn_body::bf16*)F_VB, (attn_body::bf16*)F_out, (attn_body::bf16*)F_HB,
                                      lam, F_subln_g, 1.0f - LAM_INIT0, F.G, F.vcu, F.wave);
    }
    PHASE_END(); }
    GRID_BAR();
    PH(5) { if (rep_) GRID_BAR(); PHASE_BEGIN();
    {
        pg8::StaticOrder S; S.init(F_HB, F_Wo_t, M, D, D, F.G, (int)blockIdx.x);
        pg8::EpiPlain E{F_QB, D};
        pg8::gemm_phase<pg8::EpiPlain, pg8::StaticOrder, true, false>(F.lds + RING_OFF, D, S, E, F.wave);
    }
    PHASE_END(); }
    GRID_BAR();
    PH(6) { if (rep_) GRID_BAR(); PHASE_BEGIN();
    n2_phase(F, 0, F_x, rep_ ? 2 : 0);
    PHASE_END(); }
    GRID_BAR();
    PH(7) { if (rep_) GRID_BAR(); PHASE_BEGIN();
    load_counts(F, 0);
    {
        pg8::GroupedOrder<4, true> S{tcnt, tpre, F.G, F.vcu, D, M, (const char*)F_HB, (const char*)F_W1_t, (size_t)2 * FF * D * 2, F_list};
        pg8::EpiSwiGLU E{F_HID};
        pg8::gemm_phase<pg8::EpiSwiGLU, pg8::GroupedOrder<4, true>, true, true>(F.lds + RING_OFF, D, S, E, F.wave);
    }
    PHASE_END(); }
    GRID_BAR();
    PH(8) { if (rep_) GRID_BAR(); PHASE_BEGIN();
    {
        pg8::GroupedOrder<4, false> S{tcnt, tpre, F.G, F.vcu, FF, M, (const char*)F_HID, (const char*)F_W2_t, (size_t)D * FF * 2, F_list};
        pg8::EpiDown E{F_Y2, F_list, tcnt, M};
        pg8::gemm_phase<pg8::EpiDown, pg8::GroupedOrder<4, false>, true, false>(F.lds + RING_OFF, FF, S, E, F.wave);
    }
    PHASE_END(); }
    GRID_BAR();
    PH(9) { if (rep_) GRID_BAR(); PHASE_BEGIN();

    n1_phase<true>(F, 1, F_out, F_out);
    PHASE_END(); }
    GRID_BAR();
    PH(10) { if (rep_) GRID_BAR(); PHASE_BEGIN();
    {
        pg8::StaticOrder S; S.init(F_HB, F_Wqkv_t + (size_t)NQKV * D, M, NQKV, D, F.G, (int)blockIdx.x);
        pg8::EpiQKV E{F_QB, (size_t)(WS_K - WS_Q) / 2, C2, F_pos, 0};
        pg8::gemm_phase<pg8::EpiQKV, pg8::StaticOrder, true, false>(F.lds + RING_OFF, D, S, E, F.wave);
    }
    PHASE_END(); }
    GRID_BAR();
    PH(11) { if (rep_) GRID_BAR(); PHASE_BEGIN();
    attn_body::sb_attn_phase((char*)lds + RING_OFF, (const attn_body::bf16*)F_QB, (const attn_body::bf16*)F_KB, (const attn_body::bf16*)F_VB, (attn_body::bf16*)F_OA, F.G, F.vcu, F.wave);
    PHASE_END(); }
    GRID_BAR();
    PH(12) { if (rep_) GRID_BAR(); PHASE_BEGIN();
    {
        pg8::StaticOrder S; S.init(F_OA, F_Wo_t + (size_t)D * D, M, D, D, F.G, (int)blockIdx.x);
        pg8::EpiPlain E{F_QB, D};
        pg8::gemm_phase<pg8::EpiPlain, pg8::StaticOrder, true, false>(F.lds + RING_OFF, D, S, E, F.wave);
    }
    PHASE_END(); }
    GRID_BAR();
    PH(13) { if (rep_) GRID_BAR(); PHASE_BEGIN();
    n2_phase(F, 1, F_out, rep_ ? 3 : 1);
    PHASE_END(); }
    GRID_BAR();
    PH(14) { if (rep_) GRID_BAR(); PHASE_BEGIN();
    load_counts(F, 1);
    {
        pg8::GroupedOrder<4, true> S{tcnt, tpre, F.G, F.vcu, D, M, (const char*)F_HB, (const char*)(F_W1_t + (size_t)NE * 2 * FF * D), (size_t)2 * FF * D * 2, F_list};
        pg8::EpiSwiGLU E{F_HID};
        pg8::gemm_phase<pg8::EpiSwiGLU, pg8::GroupedOrder<4, true>, true, true>(F.lds + RING_OFF, D, S, E, F.wave);
    }
    PHASE_END(); }
    GRID_BAR();
    PH(15) { if (rep_) GRID_BAR(); PHASE_BEGIN();
    {
        pg8::GroupedOrder<4, false> S{tcnt, tpre, F.G, F.vcu, FF, M, (const char*)F_HID, (const char*)(F_W2_t + (size_t)NE * D * FF), (size_t)D * FF * 2, F_list};
        pg8::EpiDown E{F_Y2, F_list, tcnt, M};
        pg8::gemm_phase<pg8::EpiDown, pg8::GroupedOrder<4, false>, true, false>(F.lds + RING_OFF, FF, S, E, F.wave);
    }
    PHASE_END(); }
    GRID_BAR();
    PH(16) { if (rep_) GRID_BAR(); PHASE_BEGIN();
    final_phase(F, F_out, F_out);

    }
    if (STAMP_PH >= 0 && blockIdx.x == STAMP_BLK && F.wave == 0 && lane_id_() == 0) { const unsigned long long tend = rt(); if (STAMP_PH == 16 || STAMP_PH == 100) tsb_ = tend;
        const unsigned long long need = (unsigned long long)STAMP_AMP * (tsb_ - tsa_); while (rt() - tend < need) __builtin_amdgcn_s_sleep(8); }
#undef GRID_BAR
}

extern "C" void kernel_launch(void* const* d_in, const int* in_sizes, int n_in, void* d_out, int out_size, void* d_ws, size_t ws_size, hipStream_t stream) {
    static int grid = 0;
    if (grid == 0) {
        if (n_in != 16 || in_sizes[0] != M * D || out_size != M * D || ws_size < WS_END) { fprintf(stderr, "kernel_launch: built for 16 inputs, x and out of %d floats, >= %zu bytes of workspace; got n_in %d, in0 %d, out %d, ws %zu; nothing launched\n", M * D, (size_t)WS_END, n_in, n_in > 0 ? in_sizes[0] : -1, out_size, ws_size); grid = -1; return; }
        int dev = 0, cus = 0, per_cu = 0;
        if (hipGetDevice(&dev) != hipSuccess || hipDeviceGetAttribute(&cus, hipDeviceAttributeMultiprocessorCount, dev) != hipSuccess) { fprintf(stderr, "kernel_launch: hipGetDevice / hipDeviceGetAttribute failed\n"); grid = -1; return; }
        if (hipFuncSetAttribute((const void*)fwd_kernel, hipFuncAttributeMaxDynamicSharedMemorySize, LDS_BYTES) != hipSuccess) { fprintf(stderr, "kernel_launch: hipFuncSetAttribute failed\n"); grid = -1; return; }
        if (hipOccupancyMaxActiveBlocksPerMultiprocessor(&per_cu, (const void*)fwd_kernel, NWAVES * 64, LDS_BYTES) != hipSuccess || per_cu < 1) { fprintf(stderr, "kernel_launch: occupancy query reports %d workgroups per CU\n", per_cu); }
        (void)hipGetLastError();
        grid = cus;
        if (grid > 256) grid = 256;
        grid -= grid % 8;
    }
    if (grid <= 0) return;
    if (hipMemsetAsync((char*)d_ws + WS_CTL, 0, CTL_ZERO_BYTES, stream) != hipSuccess) { fprintf(stderr, "kernel_launch: hipMemsetAsync failed\n"); return; }
    Args a{};
    for (int i = 0; i < 16; ++i) a.in[i] = d_in[i];
    a.out = (float*)d_out; a.ws = (unsigned char*)d_ws;
    hipLaunchKernelGGL(fwd_kernel, dim3(grid), dim3(NWAVES * 64), LDS_BYTES, stream, a);
    const hipError_t le = hipPeekAtLastError();
    if (le != hipSuccess) fprintf(stderr, "kernel_launch: launch failed: %s\n", hipGetErrorName(le));
}
```

```cpp
#include <hip/hip_runtime.h>
#include <hip/hip_bf16.h>
#include <cstdio>
#include <cstdint>
#include <cmath>
__device__ __forceinline__ int lane_id_() { return (int)__builtin_amdgcn_mbcnt_hi(~0u, __builtin_amdgcn_mbcnt_lo(~0u, 0u)); }
namespace pg8 {
#define PG8_LAS __attribute__((address_space(3)))
typedef unsigned short bf16_t;
typedef short bf16x8 __attribute__((ext_vector_type(8)));
typedef float f32x4 __attribute__((ext_vector_type(4)));
typedef unsigned u32x4 __attribute__((ext_vector_type(4)));
constexpr int BM = 256, BK = 64, HALF = 128, HTB = HALF * BK * 2  , STAGE_BYTES = 8 * HTB, NXCD = 8, WGM = 8;

__host__ __device__ __forceinline__ int lds_byte(int r, int c) { const int st = (r >> 4) * 2 + (c >> 5), rr = r & 15, cc = c & 31, ob = rr * 64 + cc * 2; return st * 1024 + (ob ^ (((ob >> 9) & 1) << 5)); }
__host__ __device__ __forceinline__ void stage_rc(int b, int& R, int& C) { const int st = b / 1024, sb = b % 1024, swz = sb ^ (((sb >> 9) & 1) << 5); R = (st >> 1) * 16 + swz / 64; C = (st & 1) * 32 + (swz % 64) / 2; }
__host__ __device__ __forceinline__ int perm32(int rho) { const int n = rho >> 4, i = rho & 15; return 8 * (i >> 2) + 4 * n + (i & 3); }


struct Unit { int pm, pn, e, rb; };

struct StaticOrder {
    int nM, nN, nwg, G, c; const char* A; const char* Bt; int K;
    __device__ void init(const void* A_, const void* Bt_, int M, int N, int K_, int G_, int c_) { A = (const char*)A_; Bt = (const char*)Bt_; K = K_; nM = M / BM; nN = N / BM; nwg = nM * nN; G = G_; c = c_; }
    __device__ bool next(int i, Unit& u) const {
        const long L = (long)i * G + c; if (L >= nwg) return false;
        int wgid = (int)L; { const int q = nwg / NXCD, r = nwg % NXCD, xcd = wgid % NXCD, off = wgid / NXCD; wgid = (xcd < r ? xcd * (q + 1) : r * (q + 1) + (xcd - r) * q) + off; }
        const int nig = WGM * nN, gid = wgid / nig, fm = gid * WGM, gsz = (nM - fm) < WGM ? (nM - fm) : WGM;
        u.pm = fm + ((wgid % nig) % gsz); u.pn = (wgid % nig) / gsz; u.e = 0; u.rb = 0; return true;
    }
    __device__ __forceinline__ const char* a_ptr(const Unit& u) const { return A + (size_t)u.pm * ((size_t)BM * K * 2); }
    __device__ __forceinline__ const char* b_ptr(const Unit& u) const { return Bt + (size_t)u.pn * ((size_t)BM * K * 2); }
    __device__ __forceinline__ unsigned a_rowoff(const Unit&, int R) const { return (unsigned)R * (unsigned)K * 2u; }
};
template <int NPN, bool GATHER_> struct GroupedOrder {
    const PG8_LAS int* cnt; const PG8_LAS int* pre; int G, vc, K, Mtok;
    const char* A; const char* W; size_t wstride; const int* list;
    __device__ bool next(int i, Unit& u) const {
        const int total = pre[32] * NPN; const int L = i * G + vc; if (L >= total) return false;
        const int rbg = L / NPN; int e = 0;
#pragma unroll 1
        for (int j = 1; j < 32; ++j) e += (pre[j] <= rbg) ? 1 : 0;
        e = __builtin_amdgcn_readfirstlane(e); const int rb = __builtin_amdgcn_readfirstlane(rbg - pre[e]);
        u.e = e; u.rb = rb; u.pm = __builtin_amdgcn_readfirstlane(rbg); u.pn = __builtin_amdgcn_readfirstlane(L % NPN); return true;
    }
    __device__ __forceinline__ const char* a_ptr(const Unit& u) const { return GATHER_ ? A : A + (size_t)u.pm * ((size_t)BM * K * 2); }
    __device__ __forceinline__ const char* b_ptr(const Unit& u) const { return W + (size_t)u.e * wstride + (size_t)u.pn * ((size_t)BM * K * 2); }
    __device__ __forceinline__ unsigned a_rowoff(const Unit& u, int R) const {
        if (!GATHER_) return (unsigned)R * (unsigned)K * 2u;
        const int idx = u.rb * BM + R; int tok = 0; if (idx < cnt[u.e]) tok = list[(size_t)u.e * Mtok + idx] >> 1;
        return (unsigned)tok * (unsigned)K * 2u;
    }
};

__device__ __forceinline__ unsigned cvt_pk_bf16(float lo, float hi) { unsigned r; asm volatile("v_cvt_pk_bf16_f32 %0, %1, %2" : "=v"(r) : "v"(lo), "v"(hi)); return r; }
typedef float f32x2 __attribute__((ext_vector_type(2)));
__device__ __forceinline__ void sincos_rad(float ang, float& s, float& c) {
    double r = (double)ang * 0.15915494309189535; r = r - __builtin_floor(r);
    const float rf = (float)r; s = __builtin_amdgcn_sinf(rf); c = __builtin_amdgcn_cosf(rf);
}
struct EpiQKV {
    static constexpr bool PERM = true, AFTER_DRAIN = false, HAS_META = false;
    bf16_t* O; size_t split_stride; float scale0; const int* pos; int rope;
    __device__ __forceinline__ void operator()(const f32x4 (&acc)[2][2][4][2], const Unit& u, int wr, int wc, int fr, int fq) const {
        const int t = u.pn >> 2; bf16_t* base = O + (size_t)t * split_stride;
        const float sc = (t == 0) ? scale0 : 1.f;
        const int row0 = u.pm * BM + wr * 64 + fr, col0 = (u.pn & 3) * BM + wc * 32 + 8 * fq;
        const bool dorope = rope && t < 2 && (wc & 1) == 0 && fq < 2;
        const float f0 = fq ? 0.0014142135623842478f : 1.0f, f1 = fq ? 0.00027424818836152554f : 0.1939227432012558f,
                    f2 = fq ? 5.318296098266728e-05f : 0.03760603070259094f, f3 = fq ? 1.0313386155758053e-05f : 0.007292664609849453f;
#pragma unroll
        for (int ai = 0; ai < 2; ++ai)
#pragma unroll
            for (int m = 0; m < 4; ++m) { const int row = row0 + ai * HALF + m * 16; bf16_t* rowp = base + (size_t)row * 1024 + col0;
                float s0 = 0.f, s1 = 0.f, s2 = 0.f, s3 = 0.f, c0 = 1.f, c1 = 1.f, c2 = 1.f, c3 = 1.f;
                if (dorope) { const float p = (float)pos[row]; sincos_rad(p * f0, s0, c0); sincos_rad(p * f1, s1, c1); sincos_rad(p * f2, s2, c2); sincos_rad(p * f3, s3, c3); }
#pragma unroll
                for (int bj = 0; bj < 2; ++bj) { f32x4 v0 = acc[ai][bj][m][0], v1 = acc[ai][bj][m][1];
                    { const float a0 = v0[0], b0 = v0[1], a1 = v0[2], b1 = v0[3], a2 = v1[0], b2 = v1[1], a3 = v1[2], b3 = v1[3];
                      v0[0] = a0 * c0 - b0 * s0; v0[1] = b0 * c0 + a0 * s0; v0[2] = a1 * c1 - b1 * s1; v0[3] = b1 * c1 + a1 * s1;
                      v1[0] = a2 * c2 - b2 * s2; v1[1] = b2 * c2 + a2 * s2; v1[2] = a3 * c3 - b3 * s3; v1[3] = b3 * c3 + a3 * s3; }
                    v0 = v0 * sc; v1 = v1 * sc; u32x4 w; w.x = cvt_pk_bf16(v0[0], v0[1]); w.y = cvt_pk_bf16(v0[2], v0[3]); w.z = cvt_pk_bf16(v1[0], v1[1]); w.w = cvt_pk_bf16(v1[2], v1[3]);
                    *(u32x4*)(rowp + bj * HALF) = w; } }
    }
};
struct EpiPlain {
    static constexpr bool PERM = true, AFTER_DRAIN = false, HAS_META = false;
    bf16_t* O; int ldc;
    __device__ __forceinline__ void operator()(const f32x4 (&acc)[2][2][4][2], const Unit& u, int wr, int wc, int fr, int fq) const {
        const int row0 = u.pm * BM + wr * 64 + fr, col0 = u.pn * BM + wc * 32 + 8 * fq;
#pragma unroll
        for (int ai = 0; ai < 2; ++ai)
#pragma unroll
            for (int m = 0; m < 4; ++m) { bf16_t* rowp = O + (size_t)(row0 + ai * HALF + m * 16) * ldc + col0;
#pragma unroll
                for (int bj = 0; bj < 2; ++bj) { const f32x4 v0 = acc[ai][bj][m][0], v1 = acc[ai][bj][m][1];
                    u32x4 w; w.x = cvt_pk_bf16(v0[0], v0[1]); w.y = cvt_pk_bf16(v0[2], v0[3]); w.z = cvt_pk_bf16(v1[0], v1[1]); w.w = cvt_pk_bf16(v1[2], v1[3]);
                    *(u32x4*)(rowp + bj * HALF) = w; } }
    }
};
__device__ __forceinline__ float silu_mul(float g, float u) { return g * u * __builtin_amdgcn_rcpf(1.0f + __builtin_amdgcn_exp2f(-1.4426950408889634f * g)); }
struct EpiSwiGLU {
    static constexpr bool PERM = true, AFTER_DRAIN = false, HAS_META = false;
    bf16_t* hid;
    __device__ __forceinline__ void operator()(const f32x4 (&acc)[2][2][4][2], const Unit& u, int wr, int wc, int fr, int fq) const {
        const int row0 = u.pm * BM + wr * 64 + fr, col0 = u.pn * HALF + wc * 32 + 8 * fq;
#pragma unroll
        for (int ai = 0; ai < 2; ++ai)
#pragma unroll
            for (int m = 0; m < 4; ++m) { const f32x4 g0 = acc[ai][0][m][0], g1 = acc[ai][0][m][1], u0 = acc[ai][1][m][0], u1 = acc[ai][1][m][1];
                u32x4 w; w.x = cvt_pk_bf16(silu_mul(g0[0], u0[0]), silu_mul(g0[1], u0[1])); w.y = cvt_pk_bf16(silu_mul(g0[2], u0[2]), silu_mul(g0[3], u0[3]));
                w.z = cvt_pk_bf16(silu_mul(g1[0], u1[0]), silu_mul(g1[1], u1[1])); w.w = cvt_pk_bf16(silu_mul(g1[2], u1[2]), silu_mul(g1[3], u1[3]));
                *(u32x4*)(hid + (size_t)(row0 + ai * HALF + m * 16) * 512 + col0) = w; }
    }
};
struct EpiDown {
    static constexpr bool PERM = true, AFTER_DRAIN = false, HAS_META = true;
    bf16_t* y2; const int* list; const PG8_LAS int* cnt; int Mtok;
    __device__ __forceinline__ void prefetch(int (&dd)[8], const Unit& u, int wr, int fr) const {
        const int nvalid = cnt[u.e] - u.rb * BM; const int* lp = list + (size_t)u.e * Mtok + u.rb * BM;
#pragma unroll
        for (int ai = 0; ai < 2; ++ai)
#pragma unroll
            for (int m = 0; m < 4; ++m) { const int r = ai * HALF + wr * 64 + m * 16 + fr; dd[ai * 4 + m] = (r < nvalid) ? lp[r] : -1; }
    }
    __device__ __forceinline__ void operator()(const f32x4 (&acc)[2][2][4][2], const Unit& u, int wr, int wc, int fr, int fq, const int (&dd)[8]) const {
        const int col0 = u.pn * BM + wc * 32 + 8 * fq;
#pragma unroll
        for (int ai = 0; ai < 2; ++ai)
#pragma unroll
            for (int m = 0; m < 4; ++m) if (dd[ai * 4 + m] >= 0) { bf16_t* rowp = y2 + (size_t)dd[ai * 4 + m] * 1024 + col0;
#pragma unroll
                for (int bj = 0; bj < 2; ++bj) { const f32x4 v0 = acc[ai][bj][m][0], v1 = acc[ai][bj][m][1];
                    u32x4 w; w.x = cvt_pk_bf16(v0[0], v0[1]); w.y = cvt_pk_bf16(v0[2], v0[3]); w.z = cvt_pk_bf16(v1[0], v1[1]); w.w = cvt_pk_bf16(v1[2], v1[3]);
                    *(u32x4*)(rowp + bj * HALF) = w; } }
    }
};

template <class Epi, class Sched, bool ALIGN_EPI, bool GATHER>
__device__ __forceinline__ void gemm_phase(PG8_LAS unsigned char* lds, const int K, const Sched& S, const Epi& E, const int wv) {
    int tid_ = wv * 64 + lane_id_(); asm volatile("" : "+v"(tid_));
    const int tid = tid_, wid = __builtin_amdgcn_readfirstlane(tid >> 6), lane = tid & 63, wr = wid >> 2, wc = wid & 3, fr = lane & 15, fq = lane >> 4;
    const int nt = K / BK;
    unsigned vA0[2], vA1[2], nA0[2], nA1[2], voffB[2]; int RA[2], CA2[2];
#pragma unroll
    for (int i = 0; i < 2; ++i) { int R, C; stage_rc(tid * 16 + i * 8192, R, C); const int Rb = Epi::PERM ? ((R & ~31) + perm32(R & 31)) : R;
        RA[i] = R; CA2[i] = C * 2; voffB[i] = (unsigned)(Rb * K + C) * 2u; }
    const size_t kstep = (size_t)(BK * 2);
    const size_t hstep = (size_t)HALF * K * 2;
    const unsigned ldsw = (unsigned)wid * 1024u;
    const int aoff = lds_byte(wr * 64 + fr, fq * 8), boff = lds_byte(wc * 32 + fr, fq * 8);
#define PG8_SA(b, h) (((b) * 2 + (h)) * HTB)
#define PG8_SB(b, h) ((4 + (b) * 2 + (h)) * HTB)
#define PG8_STAGE(bufoff, gbase, voff) do { _Pragma("unroll") for (int _i = 0; _i < 2; ++_i) \
        __builtin_amdgcn_global_load_lds((const unsigned*)((const char*)(gbase) + (voff)[_i]), (PG8_LAS unsigned*)(lds + (bufoff) + ldsw + _i * 8192), 16, 0, 0); } while (0)
#define PG8_LDA(dst, b, h) do { _Pragma("unroll") for (int m = 0; m < 4; ++m) _Pragma("unroll") for (int k = 0; k < 2; ++k) dst[m][k] = *(const PG8_LAS bf16x8*)(lds + PG8_SA(b, h) + aoff + m * 2048 + k * 1024); } while (0)
#define PG8_LDB(dst, b, h) do { _Pragma("unroll") for (int n = 0; n < 2; ++n) _Pragma("unroll") for (int k = 0; k < 2; ++k) dst[n][k] = *(const PG8_LAS bf16x8*)(lds + PG8_SB(b, h) + boff + n * 2048 + k * 1024); } while (0)
#define PG8_MMA(ai, bj, At, Bt) do { __builtin_amdgcn_s_setprio(1); _Pragma("unroll") for (int m = 0; m < 4; ++m) _Pragma("unroll") for (int n = 0; n < 2; ++n) _Pragma("unroll") for (int k = 0; k < 2; ++k) \
        acc[ai][bj][m][n] = __builtin_amdgcn_mfma_f32_16x16x32_bf16(Bt[n][k], At[m][k], acc[ai][bj][m][n], 0, 0, 0); __builtin_amdgcn_s_setprio(0); } while (0)
#define PG8_WAIT_V(n) asm volatile("s_waitcnt vmcnt(" #n ")" ::: "memory")
#define PG8_WAIT_L(n) asm volatile("s_waitcnt lgkmcnt(" #n ")" ::: "memory")
#define PG8_BAR __builtin_amdgcn_s_barrier()
#define PG8_SCHED __builtin_amdgcn_sched_barrier(0)
#define PG8_AOFFS(u, d0, d1) do { _Pragma("unroll") for (int _i = 0; _i < 2; ++_i) { d0[_i] = S.a_rowoff(u, RA[_i]) + (unsigned)CA2[_i]; d1[_i] = S.a_rowoff(u, HALF + RA[_i]) + (unsigned)CA2[_i]; } } while (0)
    Unit cur, nxt; int ui = 0;
    if (!S.next(0, cur)) return;
    f32x4 acc[2][2][4][2];
#pragma unroll
    for (int a = 0; a < 2; ++a)
#pragma unroll
        for (int b = 0; b < 2; ++b)
#pragma unroll
            for (int m = 0; m < 4; ++m)
#pragma unroll
                for (int n = 0; n < 2; ++n) acc[a][b][m][n] = (f32x4){0.f, 0.f, 0.f, 0.f};
    bf16x8 At[4][2], B0[2][2], B1[2][2]; int meta[8];
    const char* cA = S.a_ptr(cur); const char* cB = S.b_ptr(cur);
    PG8_AOFFS(cur, vA0, vA1);
    {
        PG8_STAGE(PG8_SB(0, 0), cB, voffB); PG8_STAGE(PG8_SB(0, 1), cB + hstep, voffB); PG8_STAGE(PG8_SA(0, 0), cA, vA0); PG8_STAGE(PG8_SA(0, 1), cA, vA1);
        if (wr == 1) PG8_BAR;
        PG8_WAIT_V(2); PG8_BAR;
        PG8_STAGE(PG8_SB(1, 0), cB + kstep, voffB); PG8_STAGE(PG8_SA(1, 0), cA + kstep, vA0); PG8_STAGE(PG8_SB(1, 1), cB + hstep + kstep, voffB);
        PG8_WAIT_V(6); PG8_BAR;
    }
    for (;;) {
        const bool has_next = S.next(ui + 1, nxt);
        if constexpr (Epi::HAS_META) E.prefetch(meta, cur, wr, fr);
        const char* nA = has_next ? S.a_ptr(nxt) : cA; const char* nB = has_next ? S.b_ptr(nxt) : cB;
        if constexpr (GATHER) { if (has_next) { PG8_AOFFS(nxt, nA0, nA1); } else {
#pragma unroll
            for (int _i = 0; _i < 2; ++_i) { nA0[_i] = vA0[_i]; nA1[_i] = vA1[_i]; } } }
        for (int t = 0; t < nt; t += 2) {
            const bool last = (t == nt - 2);
            const char* a1 = cA + (size_t)(t + 1) * kstep;
            const char* a2 = last ? nA : cA + (size_t)(t + 2) * kstep; const char* b2 = last ? nB : cB + (size_t)(t + 2) * kstep;
            const char* a3 = a2 + kstep; const char* b3 = b2 + kstep;
            PG8_LDB(B0, 0, 0); PG8_LDB(B1, 0, 1); PG8_SCHED; PG8_LDA(At, 0, 0); PG8_STAGE(PG8_SA(1, 1), a1, vA1);
            if constexpr (GATHER) { if (last) {
#pragma unroll
                for (int _i = 0; _i < 2; ++_i) { vA0[_i] = nA0[_i]; vA1[_i] = nA1[_i]; } } }
            PG8_WAIT_V(8); PG8_WAIT_L(0); PG8_BAR; PG8_MMA(0, 0, At, B0); PG8_MMA(0, 1, At, B1); PG8_BAR; PG8_SCHED;
            PG8_LDA(At, 0, 1); PG8_STAGE(PG8_SB(0, 0), b2, voffB); PG8_STAGE(PG8_SB(0, 1), b2 + hstep, voffB); PG8_STAGE(PG8_SA(0, 0), a2, vA0);
            PG8_WAIT_V(8); PG8_WAIT_L(0); PG8_BAR; PG8_MMA(1, 0, At, B0); PG8_MMA(1, 1, At, B1); PG8_BAR; PG8_SCHED;
            PG8_LDB(B0, 1, 0); PG8_LDB(B1, 1, 1); PG8_SCHED; PG8_LDA(At, 1, 0); PG8_STAGE(PG8_SA(0, 1), a2, vA1);
            PG8_WAIT_V(8); PG8_WAIT_L(0); PG8_BAR; PG8_MMA(0, 0, At, B0); PG8_MMA(0, 1, At, B1); PG8_BAR; PG8_SCHED;
            PG8_LDA(At, 1, 1); PG8_STAGE(PG8_SB(1, 0), b3, voffB); PG8_STAGE(PG8_SB(1, 1), b3 + hstep, voffB); PG8_STAGE(PG8_SA(1, 0), a3, vA0);
            PG8_WAIT_V(8); PG8_WAIT_L(0); PG8_BAR; PG8_MMA(1, 0, At, B0); PG8_MMA(1, 1, At, B1); PG8_BAR; PG8_SCHED;
        }
        if constexpr (ALIGN_EPI) { if (wr == 0) PG8_BAR; }
        if constexpr (Epi::HAS_META) E(acc, cur, wr, wc, fr, fq, meta); else E(acc, cur, wr, wc, fr, fq);
        if (!has_next) break;
#pragma unroll
        for (int a = 0; a < 2; ++a)
#pragma unroll
            for (int b = 0; b < 2; ++b)
#pragma unroll
                for (int m = 0; m < 4; ++m)
#pragma unroll
                    for (int n = 0; n < 2; ++n) acc[a][b][m][n] = (f32x4){0.f, 0.f, 0.f, 0.f};
        cur = nxt; cA = nA; cB = nB; ++ui;
        if constexpr (ALIGN_EPI) { if (wr == 1) PG8_BAR; }
    }
    PG8_WAIT_V(0);
    if constexpr (!ALIGN_EPI) { if (wr == 0) PG8_BAR; }
    PG8_BAR;
#undef PG8_SA
#undef PG8_SB
#undef PG8_STAGE
#undef PG8_LDA
#undef PG8_LDB
#undef PG8_MMA
#undef PG8_WAIT_V
#undef PG8_WAIT_L
#undef PG8_BAR
#undef PG8_SCHED
#undef PG8_AOFFS
}
}
#include <hip/hip_bf16.h>
#include <cmath>
namespace attn_body {
using bf16=__hip_bfloat16;
using bf16x8=__attribute__((ext_vector_type(8)))short;
using s16x4=__attribute__((ext_vector_type(4)))short;
using f32x16=__attribute__((ext_vector_type(16)))float;
using u32x4=__attribute__((ext_vector_type(4)))unsigned;
constexpr int BATCH=4,NHEAD=16,SEQ=8192,D=64,DM=NHEAD*D;
constexpr int NW=8,QBLK=32,QB=QBLK*NW,KVBLK=64,NQB=SEQ/QB;
constexpr int ATTN_PITCH=DM, ATTN_UNIT_ROWS=QB;
__device__ __forceinline__ int crow(int r,int hi){return (r&3)+8*(r>>2)+4*hi;}
#define SBAR() __builtin_amdgcn_sched_barrier(0)
__device__ __forceinline__ void cmask(f32x16&p0,f32x16&p1,int jb,int qrel,int hi){
  const float NEG=-INFINITY; const int thr=qrel-64*jb-4*hi;
  #pragma unroll
  for(int r=0;r<16;++r){const int kc=(r&3)+8*(r>>2); if(kc>thr)p0[r]=NEG; if(kc+32>thr)p1[r]=NEG;}
}

constexpr int NSLOT=3, SLOTB=8192;
constexpr int LDS_K=0, LDS_V=NSLOT*SLOTB, LDS_WS=2*NSLOT*SLOTB, LDS_OST=LDS_WS+NW*64*4, LDS_BYTES=LDS_OST+NW*4096;
constexpr float C2=0.125f*1.4426950408889634f;
__device__ __forceinline__ void glds16(const void*gsrc,unsigned lds_dst){unsigned keep;
  asm volatile("s_mov_b32 %0, m0\n\ts_mov_b32 m0, %2\n\ts_nop 0\n\tglobal_load_lds_dwordx4 %1, off\n\ts_mov_b32 m0, %0":"=&s"(keep):"v"(gsrc),"s"(lds_dst):"memory");}
__device__ __forceinline__ void glds16s(const void*sbase,unsigned voff,unsigned lds_dst){unsigned keep;
  asm volatile("s_mov_b32 %0, m0\n\ts_mov_b32 m0, %3\n\ts_nop 0\n\tglobal_load_lds_dwordx4 %1, %2\n\ts_mov_b32 m0, %0":"=&s"(keep):"v"(voff),"s"(sbase),"s"(lds_dst):"memory");}
__device__ __forceinline__ float max3f(float a,float b,float c){float r;asm("v_max3_f32 %0, %1, %2, %3":"=v"(r):"v"(a),"v"(b),"v"(c));return r;}
__device__ __forceinline__ float max2f(float a,float b){float r;asm("v_max_f32_e32 %0, %1, %2":"=v"(r):"v"(a),"v"(b));return r;}
__device__ __forceinline__ float fadd_s(float a,float b){float r;asm("v_add_f32_e32 %0, %1, %2":"=v"(r):"v"(a),"v"(b));return r;}
__device__ __forceinline__ float fsub_s(float a,float b){float r;asm("v_sub_f32_e32 %0, %1, %2":"=v"(r):"v"(a),"v"(b));return r;}
typedef float f32x2_t __attribute__((ext_vector_type(2))); typedef __bf16 bf16x2_t __attribute__((ext_vector_type(2)));
__device__ __forceinline__ unsigned cvtpk_s(float lo,float hi){f32x2_t v={lo,hi};bf16x2_t b=__builtin_convertvector(v,bf16x2_t);return __builtin_bit_cast(unsigned,b);}
#define WAIT_BAR(N) asm volatile("s_waitcnt vmcnt(" #N ") lgkmcnt(0)\n\ts_barrier":::"memory")

__device__ __forceinline__ void qkt(f32x16&p0,f32x16&p1,const char*Kslot,const bf16x8*qr,const f32x16&negm,int r32,int hi){
  const char*kb=Kslot+hi*1024+r32*16;
  #pragma unroll
  for(int d0=0;d0<4;++d0){
    const bf16x8 b0=*reinterpret_cast<const bf16x8*>(kb+d0*2048);
    const bf16x8 b1=*reinterpret_cast<const bf16x8*>(kb+d0*2048+512);
    if(d0==0){p0=__builtin_amdgcn_mfma_f32_32x32x16_bf16(b0,qr[0],negm,0,0,0);p1=__builtin_amdgcn_mfma_f32_32x32x16_bf16(b1,qr[0],negm,0,0,0);}
    else{p0=__builtin_amdgcn_mfma_f32_32x32x16_bf16(b0,qr[d0],p0,0,0,0);p1=__builtin_amdgcn_mfma_f32_32x32x16_bf16(b1,qr[d0],p1,0,0,0);}}
}
typedef __attribute__((address_space(3))) const char* lds_cptr;
typedef short v4i16_t __attribute__((ext_vector_type(4)));
__device__ __forceinline__ void kload8(bf16x8*kf,lds_cptr kp){
  kf[0]=*(const __attribute__((address_space(3))) bf16x8*)(kp);      kf[1]=*(const __attribute__((address_space(3))) bf16x8*)(kp+512);
  kf[2]=*(const __attribute__((address_space(3))) bf16x8*)(kp+2048); kf[3]=*(const __attribute__((address_space(3))) bf16x8*)(kp+2560);
  kf[4]=*(const __attribute__((address_space(3))) bf16x8*)(kp+4096); kf[5]=*(const __attribute__((address_space(3))) bf16x8*)(kp+4608);
  kf[6]=*(const __attribute__((address_space(3))) bf16x8*)(kp+6144); kf[7]=*(const __attribute__((address_space(3))) bf16x8*)(kp+6656);
}
__device__ __forceinline__ void kload2(bf16x8*kf,lds_cptr kp,int j){ kf[2*j]=*(const __attribute__((address_space(3))) bf16x8*)(kp+j*2048); kf[2*j+1]=*(const __attribute__((address_space(3))) bf16x8*)(kp+j*2048+512); }
__device__ __forceinline__ s16x4 vtr(lds_cptr p){ return __builtin_bit_cast(s16x4,__builtin_amdgcn_ds_read_tr16_b64_v4i16((__attribute__((address_space(3))) v4i16_t*)p)); }
__device__ __forceinline__ float rowmax(const f32x16&p0,const f32x16&p1){
  float a=max3f(p0[0],p0[1],p1[0]),b=max3f(p0[2],p0[3],p1[1]);a=max3f(a,p1[2],p1[3]);
  #pragma unroll
  for(int r=4;r<16;r+=4){a=max3f(a,p0[r],p0[r+1]);b=max3f(b,p0[r+2],p0[r+3]);a=max3f(a,p1[r],p1[r+1]);b=max3f(b,p1[r+2],p1[r+3]);}
  const float m=max2f(a,b);
  auto rr=__builtin_amdgcn_permlane32_swap(__float_as_uint(m),__float_as_uint(m),false,false);
  return max2f(__uint_as_float(rr[0]),__uint_as_float(rr[1]));
}
__device__ __forceinline__ void pv(f32x16*o,int vb,bf16x8 pa0,bf16x8 pa1,bf16x8 pa2,bf16x8 pa3){
  #pragma unroll
  for(int d0=0;d0<2;++d0){s16x4 lo[4],hi[4];
    #pragma unroll
    for(int ks=0;ks<4;++ks){
      asm volatile("ds_read_b64_tr_b16 %0,%1 offset:%c2":"=&v"(lo[ks]):"v"(vb),"i"(d0*4096+ks*1024):"memory");
      asm volatile("ds_read_b64_tr_b16 %0,%1 offset:%c2":"=&v"(hi[ks]):"v"(vb),"i"(d0*4096+ks*1024+512):"memory");}
    asm volatile("s_waitcnt lgkmcnt(0)":::"memory");SBAR();
    #define PK(k) (bf16x8){lo[k][0],lo[k][1],lo[k][2],lo[k][3],hi[k][0],hi[k][1],hi[k][2],hi[k][3]}
    o[d0]=__builtin_amdgcn_mfma_f32_32x32x16_bf16(pa0,PK(0),o[d0],0,0,0);
    o[d0]=__builtin_amdgcn_mfma_f32_32x32x16_bf16(pa1,PK(1),o[d0],0,0,0);
    o[d0]=__builtin_amdgcn_mfma_f32_32x32x16_bf16(pa2,PK(2),o[d0],0,0,0);
    o[d0]=__builtin_amdgcn_mfma_f32_32x32x16_bf16(pa3,PK(3),o[d0],0,0,0);
    #undef PK
  }
}

#ifndef ATTN_STORE16
#define ATTN_STORE16(p,v) (*(u32x4*)(p)=(v))
#endif
constexpr int LDS2_WS=LDS_V+NSLOT*2*SLOTB, LDS2_OST=LDS2_WS+NW*64*4, LDS2_BYTES=LDS2_OST+NW*4096;
__device__ __forceinline__ void pv4(f32x16*o,int vb,bf16x8 pa0,bf16x8 pa1,bf16x8 pa2,bf16x8 pa3){
  #pragma unroll
  for(int d0=0;d0<4;++d0){s16x4 lo[4],hi[4];
    #pragma unroll
    for(int ks=0;ks<4;++ks){
      asm volatile("ds_read_b64_tr_b16 %0,%1 offset:%c2":"=&v"(lo[ks]):"v"(vb),"i"(d0*4096+ks*1024):"memory");
      asm volatile("ds_read_b64_tr_b16 %0,%1 offset:%c2":"=&v"(hi[ks]):"v"(vb),"i"(d0*4096+ks*1024+512):"memory");}
    asm volatile("s_waitcnt lgkmcnt(0)":::"memory");SBAR();
    #define PK(k) (bf16x8){lo[k][0],lo[k][1],lo[k][2],lo[k][3],hi[k][0],hi[k][1],hi[k][2],hi[k][3]}
    o[d0]=__builtin_amdgcn_mfma_f32_32x32x16_bf16(pa0,PK(0),o[d0],0,0,0);
    o[d0]=__builtin_amdgcn_mfma_f32_32x32x16_bf16(pa1,PK(1),o[d0],0,0,0);
    o[d0]=__builtin_amdgcn_mfma_f32_32x32x16_bf16(pa2,PK(2),o[d0],0,0,0);
    o[d0]=__builtin_amdgcn_mfma_f32_32x32x16_bf16(pa3,PK(3),o[d0],0,0,0);
    #undef PK
  }
}
template<int THRL,bool COMBINE> __device__ __forceinline__ void attn_unit128(int b,int qcol,int kcol,int vcol,int ocol,int qb,const bf16*Q,const bf16*__restrict__ K,const bf16*__restrict__ V,bf16*O,char*shm,const int wv,
    bf16*HBo,const float lam,const float*subg,const float osc){
  int tid_=wv*64+lane_id_(); asm volatile("":"+v"(tid_)); const int tid=tid_,lane=tid&63,r32=lane&31,hi=lane>>5; const int wid=__builtin_amdgcn_readfirstlane(tid>>6);
  const long rowbase=(long)b*SEQ; const int q0=qb*QB;
  const bf16*Qw=Q+(rowbase+q0+wid*QBLK)*DM+qcol;
  const bf16*Kh=K+rowbase*DM+kcol,*Vh=V+rowbase*DM+vcol;
  const unsigned lds0=(unsigned)(uintptr_t)shm;
  float*wsf=(float*)(shm+LDS2_WS)+wid*64;
  const unsigned koff=(unsigned)(lane*DM+wid*8)*2u, voff=(unsigned)((16*(wid&3)+(lane>>2))*DM+(wid>>2)*32+(lane&3)*8)*2u;
  const unsigned kdst=lds0+LDS_K+wid*1024, vdst=lds0+LDS_V+wid*1024;
  #define DMA_K(t,slot) glds16s(Kh+(long)(t)*KVBLK*DM,koff,(unsigned)__builtin_amdgcn_readfirstlane(kdst+(slot)))
  #define DMA_V(t,slot) do{ glds16s(Vh+(long)(t)*KVBLK*DM,voff,(unsigned)__builtin_amdgcn_readfirstlane(vdst+2*(slot))); glds16s(Vh+(long)(t)*KVBLK*DM+64,voff,(unsigned)__builtin_amdgcn_readfirstlane(vdst+2*(slot)+8192)); }while(0)
  const int vb0=(int)(lds0+LDS_V)+((lane>>4)&1)*32+(lane&3)*8+(4*hi+((lane&15)>>2))*64;
  const char*Kbase=shm+LDS_K; bf16x8 kf[8];
  const lds_cptr shm3=(lds_cptr)shm; const lds_cptr kp0=shm3+LDS_K+hi*1024+r32*16; const lds_cptr vp0=shm3+LDS_V+((lane>>4)&1)*32+(lane&3)*8+(4*hi+((lane&15)>>2))*64;
  const int NT=(q0+QB)/KVBLK;
  DMA_K(0,0);DMA_V(0,0);DMA_K(1,SLOTB);
  bf16x8 qr[4];
  #pragma unroll
  for(int d0=0;d0<4;++d0)qr[d0]=*reinterpret_cast<const bf16x8*>(&Qw[(long)r32*DM+d0*16+hi*8]);
  float mhat=0.f,l_reg=0.f;float z_=0.f; asm volatile("":"+v"(z_));
  f32x16 o[4]; f32x16 negm;
  _Pragma("unroll") for(int r=0;r<16;++r){o[0][r]=z_;o[1][r]=z_;o[2][r]=z_;o[3][r]=z_;negm[r]=z_;} asm volatile("":"+v"(negm));
  const int qrel=wid*QBLK+r32;
  #define CMASK(P0,P1,t) do{int jb_=(t)-(NT-4); if(jb_>=0)cmask(P0,P1,jb_,qrel,hi);}while(0)
  bool resc=false;
  #define START(P0,P1) do{ const float rm=rowmax(P0,P1); resc=false; \
    { const float dl=rm; mhat=fadd_s(mhat,dl); \
      _Pragma("unroll") for(int r=0;r<16;++r){P0[r]=fsub_s(P0[r],dl);P1[r]=fsub_s(P1[r],dl);} \
      _Pragma("unroll") for(int r=0;r<16;++r)negm[r]=-mhat; asm volatile("":"+v"(negm)); } \
    _Pragma("unroll") for(int r=0;r<16;++r)P0[r]=__builtin_amdgcn_exp2f(P0[r]); }while(0)
  #define RESC() do{ if(resc){ asm volatile("s_waitcnt lgkmcnt(0)":::"memory"); \
      _Pragma("unroll") for(int d_=0;d_<4;++d_) _Pragma("unroll") for(int r=0;r<16;++r)o[d_][r]*=wsf[crow(r,hi)]; } }while(0)
  f32x16 pA0,pA1,pB0,pB1;
  int sl_prev=0,sl_cur=0,sl_next=SLOTB;
  #define ROT() do{sl_prev=sl_cur;sl_cur=sl_next;sl_next=(sl_next==(NSLOT-1)*SLOTB)?0:sl_next+SLOTB;}while(0)
  DMA_K(2,2*SLOTB);
  WAIT_BAR(3);
  qkt(pA0,pA1,Kbase,qr,negm,r32,hi);asm volatile("s_nop 15\n\ts_nop 7":"+v"(pA0),"+v"(pA1));CMASK(pA0,pA1,0);
  START(pA0,pA1);
  _Pragma("unroll") for(int r=0;r<16;++r)pA1[r]=__builtin_amdgcn_exp2f(pA1[r]);
  WAIT_BAR(0);
  DMA_K(3,0);DMA_V(1,SLOTB);
  ROT();
  kload8(kf,kp0+sl_cur);
  WAIT_BAR(3);
  s16x4 vlo[8],vhi[8]; u32x4 pw0,pw1,pw2,pw3;
  #define PKW(P,B) cvtpk_s(P[B],P[B+1])
  #define PAF(k) __builtin_bit_cast(bf16x8,pw##k)
  #define VFR(i) (bf16x8){vlo[i][0],vlo[i][1],vlo[i][2],vlo[i][3],vhi[i][0],vhi[i][1],vhi[i][2],vhi[i][3]}
  #define PIN(x) asm volatile("":"+v"(x))
  #define MX3(a,b,c) __builtin_fmaxf(__builtin_fmaxf((a),(b)),(c))
  #define GAPA(MF,A0,A1,A2,A3,W0,W1,PW) do{ MF; sacc+=A0; sacc+=A1; sacc+=A2; sacc+=A3; PIN(sacc); W0; W1; PIN(PW); SBAR(); }while(0)
  #define EX(v) __builtin_amdgcn_exp2f(v)
  #define GAPB(MF,X,B) do{ MF; X[B]=EX(X[B]); X[B+1]=EX(X[B+1]); PIN(X); SBAR(); }while(0)
  #define VRD(f) do{ vlo[(f)&7]=vtr(vp_+(((f)&3)*4096+((f)>>2)*1024)); vhi[(f)&7]=vtr(vp_+(((f)&3)*4096+((f)>>2)*1024+512)); }while(0)
  #define KRD(G,j) do{ if(G){ kload2(kf,kp0+sl_next,j); SBAR(); } }while(0)
  #define PVM(f) o[(f)&3]=__builtin_amdgcn_mfma_f32_32x32x16_bf16(PAFN((f)>>2),VFR((f)&7),o[(f)&3],0,0,0)
  #define PAFN(k) ((k)==0?PAF(0):(k)==1?PAF(1):(k)==2?PAF(2):PAF(3))
  #define STEP(C0,C1,P0,P1,t,GK,GV,GL) do{ SBAR(); \
    const lds_cptr vp_=vp0+2*sl_prev; \
    float sacc=(P0[0]+P0[1]); \
    GAPA(C0=__builtin_amdgcn_mfma_f32_32x32x16_bf16(kf[0],qr[0],negm,0,0,0), P0[2],P0[3],P0[4],P0[5],     pw0[0]=PKW(P0,0), pw0[1]=PKW(P0,2), pw0); \
    GAPA(C1=__builtin_amdgcn_mfma_f32_32x32x16_bf16(kf[1],qr[0],negm,0,0,0), P0[6],P0[7],P0[8],P0[9],     pw0[2]=PKW(P0,4), pw0[3]=PKW(P0,6), pw0); \
    VRD(0); SBAR(); GAPA(C0=__builtin_amdgcn_mfma_f32_32x32x16_bf16(kf[2],qr[1],C0,0,0,0),   P0[10],P0[11],P0[12],P0[13], pw1[0]=PKW(P0,8), pw1[1]=PKW(P0,10), pw1); \
    VRD(1); SBAR(); GAPA(C1=__builtin_amdgcn_mfma_f32_32x32x16_bf16(kf[3],qr[1],C1,0,0,0),   P0[14],P0[15],P1[0],P1[1],   pw1[2]=PKW(P0,12),pw1[3]=PKW(P0,14), pw1); \
    VRD(2); SBAR(); GAPA(C0=__builtin_amdgcn_mfma_f32_32x32x16_bf16(kf[4],qr[2],C0,0,0,0),   P1[2],P1[3],P1[4],P1[5],     pw2[0]=PKW(P1,0), pw2[1]=PKW(P1,2), pw2); \
    VRD(3); SBAR(); GAPA(C1=__builtin_amdgcn_mfma_f32_32x32x16_bf16(kf[5],qr[2],C1,0,0,0),   P1[6],P1[7],P1[8],P1[9],     pw2[2]=PKW(P1,4), pw2[3]=PKW(P1,6), pw2); \
    VRD(4); SBAR(); GAPA(C0=__builtin_amdgcn_mfma_f32_32x32x16_bf16(kf[6],qr[3],C0,0,0,0),   P1[10],P1[11],P1[12],P1[13], pw3[0]=PKW(P1,8), pw3[1]=PKW(P1,10), pw3); \
    VRD(5); SBAR(); GAPA(C1=__builtin_amdgcn_mfma_f32_32x32x16_bf16(kf[7],qr[3],C1,0,0,0),   P1[14],P1[15],0.f,0.f,       pw3[2]=PKW(P1,12),pw3[3]=PKW(P1,14), pw3); \
    l_reg+=sacc; \
    if(GK){DMA_K((t)+3,sl_cur);} if(GV){DMA_V((t)+1,sl_next);} \
    CMASK(C0,C1,t); \
    { float a=MX3(C0[0],C0[1],C1[0]),b=MX3(C0[2],C0[3],C1[1]); a=MX3(a,C1[2],C1[3]); \
      _Pragma("unroll") for(int r=4;r<16;r+=4){a=MX3(a,C0[r],C0[r+1]);b=MX3(b,C0[r+2],C0[r+3]);a=MX3(a,C1[r],C1[r+1]);b=MX3(b,C1[r+2],C1[r+3]);} \
      float rm=__builtin_fmaxf(a,b); { auto rr=__builtin_amdgcn_permlane32_swap(__float_as_uint(rm),__float_as_uint(rm),false,false); rm=__builtin_fmaxf(__uint_as_float(rr[0]),__uint_as_float(rr[1])); } \
      resc=false; \
      if(__builtin_expect(__any(rm>(float)THRL),0)){ const float dl=__builtin_fmaxf(rm,0.f); mhat+=dl; \
        _Pragma("unroll") for(int r=0;r<16;++r){C0[r]-=dl;C1[r]-=dl;} \
        _Pragma("unroll") for(int r=0;r<16;++r)negm[r]=-mhat; asm volatile("":"+v"(negm)); \
        const float f=__builtin_amdgcn_exp2f(-dl); l_reg*=f; if(hi==0)wsf[r32]=f; resc=true; } } \
    SBAR(); \
    VRD(6);  SBAR(); GAPB(PVM(0),  C0,0); \
    VRD(7);  SBAR(); GAPB(PVM(1),  C0,2); \
    VRD(8);  SBAR(); GAPB(PVM(2),  C0,4); \
    VRD(9);  SBAR(); GAPB(PVM(3),  C0,6); \
    VRD(10); SBAR(); GAPB(PVM(4),  C0,8); \
    VRD(11); SBAR(); GAPB(PVM(5),  C0,10); \
    VRD(12); SBAR(); GAPB(PVM(6),  C0,12); \
    VRD(13); SBAR(); GAPB(PVM(7),  C0,14); \
    VRD(14); SBAR(); GAPB(PVM(8),  C1,0); \
    VRD(15); SBAR(); GAPB(PVM(9),  C1,2); \
    GAPB(PVM(10), C1,4); \
    GAPB(PVM(11), C1,6); \
    KRD(GL,0); GAPB(PVM(12), C1,8); \
    KRD(GL,1); GAPB(PVM(13), C1,10); \
    KRD(GL,2); GAPB(PVM(14), C1,12); \
    KRD(GL,3); GAPB(PVM(15), C1,14); \
    }while(0)
  int t=1;
  #undef CMASK
  #define CMASK(P0,P1,t) do{}while(0)
  for(;t+5<NT;t+=2){
    STEP(pB0,pB1,pA0,pA1,t,true,true,true);     WAIT_BAR(3); RESC(); ROT();
    STEP(pA0,pA1,pB0,pB1,t+1,true,true,true);   WAIT_BAR(3); RESC(); ROT();
  }
  #undef CMASK
  #define CMASK(P0,P1,t) do{int jb_=(t)-(NT-4); if(jb_>=0)cmask(P0,P1,jb_,qrel,hi);}while(0)
  #define ENDW(tt) do{ if((tt)+3<NT){WAIT_BAR(3);} else if((tt)+2<NT){WAIT_BAR(2);} else {WAIT_BAR(0);} }while(0)
  for(;t+1<NT;t+=2){
    STEP(pB0,pB1,pA0,pA1,t,(t+3<NT),(t+1<NT),(t+1<NT));       ENDW(t);   RESC(); ROT();
    STEP(pA0,pA1,pB0,pB1,t+1,(t+4<NT),(t+2<NT),(t+2<NT));     ENDW(t+1); RESC(); ROT();
  }
  STEP(pB0,pB1,pA0,pA1,NT-1,false,false,false); RESC();
  { float sacc=pB0[0]+pB0[1]; _Pragma("unroll") for(int r=2;r<16;++r)sacc+=pB0[r]; _Pragma("unroll") for(int r=0;r<16;++r)sacc+=pB1[r]; l_reg+=sacc;
    pw0=(u32x4){PKW(pB0,0),PKW(pB0,2),PKW(pB0,4),PKW(pB0,6)};pw1=(u32x4){PKW(pB0,8),PKW(pB0,10),PKW(pB0,12),PKW(pB0,14)};pw2=(u32x4){PKW(pB1,0),PKW(pB1,2),PKW(pB1,4),PKW(pB1,6)};pw3=(u32x4){PKW(pB1,8),PKW(pB1,10),PKW(pB1,12),PKW(pB1,14)};
    SBAR(); pv4(o,vb0+2*sl_cur,PAF(0),PAF(1),PAF(2),PAF(3)); }
  #undef PKW
  #undef PAF
  #undef VFR
  #undef PIN
  #undef MX3
  #undef GAPA
  #undef GAPB
  #undef EX
  #undef VRD
  #undef KRD
  #undef STEP
  #undef PVM
  #undef PAFN
  #undef ENDW
  {auto rr=__builtin_amdgcn_permlane32_swap(__float_as_uint(l_reg),__float_as_uint(l_reg),false,false);l_reg=__uint_as_float(rr[0])+__uint_as_float(rr[1]);}
  if(hi==0)wsf[32+r32]=l_reg;asm volatile("s_waitcnt lgkmcnt(0)":::"memory");
  float rli[16];
  #pragma unroll
  for(int r=0;r<16;++r)rli[r]=__builtin_amdgcn_rcpf(wsf[32+crow(r,hi)]);
  bf16*Ow=O+(rowbase+q0+wid*QBLK)*DM+ocol;
  bf16*stg=(bf16*)(shm+LDS2_OST)+wid*2048;
  if constexpr(!COMBINE){
    #pragma unroll
    for(int hf=0;hf<2;++hf){
      #pragma unroll
      for(int r=0;r<16;++r){const int orow=crow(r,hi);
        #pragma unroll
        for(int d0=0;d0<2;++d0)stg[orow*64+d0*32+r32]=__float2bfloat16(o[2*hf+d0][r]*rli[r]);}
      asm volatile("s_waitcnt lgkmcnt(0)":::"memory");
      #pragma unroll
      for(int i=0;i<4;++i){const int row=i*8+(lane>>3),ch=lane&7; const u32x4 v=*(const u32x4*)(stg+row*64+ch*8); ATTN_STORE16(Ow+(long)row*DM+hf*64+ch*8,v);}
      asm volatile("s_waitcnt lgkmcnt(0)":::"memory"); }
  } else {
    const int ch=lane&7,rw=lane>>3;
    u32x4 v1[2][4];
    #pragma unroll
    for(int hf=0;hf<2;++hf)
      #pragma unroll
      for(int i=0;i<4;++i)v1[hf][i]=*(const u32x4*)(Ow+(long)(i*8+rw)*DM+hf*64+ch*8);
    float cv[2][4][8]; float ss[4]={0.f,0.f,0.f,0.f};
    #pragma unroll
    for(int hf=0;hf<2;++hf){
      #pragma unroll
      for(int r=0;r<16;++r){const int orow=crow(r,hi);
        #pragma unroll
        for(int d0=0;d0<2;++d0)stg[orow*64+d0*32+r32]=__float2bfloat16(o[2*hf+d0][r]*rli[r]);}
      asm volatile("s_waitcnt lgkmcnt(0)":::"memory");
      #pragma unroll
      for(int i=0;i<4;++i){ const u32x4 v2=*(const u32x4*)(stg+(i*8+rw)*64+ch*8);
        #pragma unroll
        for(int e=0;e<4;++e){ const unsigned a=v1[hf][i][e],c2=v2[e];
          const float c0=__uint_as_float(a<<16)-lam*__uint_as_float(c2<<16), c1=__uint_as_float(a&0xffff0000u)-lam*__uint_as_float(c2&0xffff0000u);
          cv[hf][i][2*e]=c0; cv[hf][i][2*e+1]=c1; ss[i]+=c0*c0+c1*c1; } }
      asm volatile("s_waitcnt lgkmcnt(0)":::"memory"); }
    float rs[4];
    #pragma unroll
    for(int i=0;i<4;++i){ float t=ss[i];
      t+=__int_as_float(__builtin_amdgcn_ds_swizzle(__float_as_int(t),(1<<10)|0x1f)); t+=__int_as_float(__builtin_amdgcn_ds_swizzle(__float_as_int(t),(2<<10)|0x1f)); t+=__int_as_float(__builtin_amdgcn_ds_swizzle(__float_as_int(t),(4<<10)|0x1f));
      rs[i]=__builtin_amdgcn_rsqf(t*(1.f/128.f)+1e-6f)*osc; }
    bf16*Hw=HBo+(rowbase+q0+wid*QBLK)*DM+ocol;
    #pragma unroll
    for(int hf=0;hf<2;++hf){ float g8[8];
      #pragma unroll
      for(int e=0;e<8;++e)g8[e]=subg[hf*64+ch*8+e];
      #pragma unroll
      for(int i=0;i<4;++i){ u32x4 w;
        #pragma unroll
        for(int e=0;e<4;++e)w[e]=cvtpk_s(cv[hf][i][2*e]*rs[i]*g8[2*e],cv[hf][i][2*e+1]*rs[i]*g8[2*e+1]);
        ATTN_STORE16(Hw+(long)(i*8+rw)*DM+hf*64+ch*8,w); } }
  }
  asm volatile("s_waitcnt lgkmcnt(0)\n\ts_barrier":::"memory");
  #undef DMA_K
  #undef DMA_V
  #undef CMASK
  #undef START
  #undef RESC
  #undef ROT
}

typedef __attribute__((address_space(3))) volatile unsigned* lds_vu32;
__device__ __forceinline__ void smask(f32x16&p0,f32x16&p1,int jb,int qrel,int hi){
  const float NEG=-INFINITY; const int thr=qrel-64*jb-4*hi;
  #pragma unroll
  for(int r=0;r<16;++r){const int kc=(r&3)+8*(r>>2); if(kc>=thr)p0[r]=NEG; if(kc+32>=thr)p1[r]=NEG;}
}
typedef __attribute__((address_space(3))) u32x4* lds_v4p;
__device__ __forceinline__ void sb_item(int b,int h,int rb,const bf16*Q,const bf16*__restrict__ K,const bf16*__restrict__ V,bf16*O,char*shm,const int wv){
  int tid_=wv*64+lane_id_(); asm volatile("":"+v"(tid_)); const int tid=tid_,lane=tid&63,r32=lane&31,hi=lane>>5; const int wid=__builtin_amdgcn_readfirstlane(tid>>6);
  const long rowbase=(long)b*SEQ; const int r0=rb*QBLK;
  const bf16*Qw=Q+(rowbase+r0)*DM+h*D;
  const bf16*Kh=K+rowbase*DM+h*D,*Vh=V+rowbase*DM+h*D;
  char*wl=shm+wid*16384;
  const lds_cptr wl3=(lds_cptr)wl;
  const unsigned lds0=(unsigned)(uintptr_t)wl;
  const int vb=(int)lds0+8192+((lane>>4)&1)*32+(lane&3)*8+(4*hi+((lane&15)>>2))*64;
  const int lrow=lane>>3,lch=lane&7;
  const lds_v4p kw0=(lds_v4p)(wl3+lch*1024+((lrow^(2*lch))<<4)), kw1=(lds_v4p)(wl3+lch*1024+(((lrow|8)^(2*lch))<<4));
  const lds_v4p vw=(lds_v4p)(wl3+8192+(lch>>2)*4096+lrow*64+(lch&3)*16);
  const bf16*kbase=Kh+(long)lrow*DM+lch*8;
  const bf16*vbase=Vh+(long)lrow*DM+lch*8;
  int koff4[4];
  #pragma unroll
  for(int d0=0;d0<4;++d0)koff4[d0]=(2*d0+hi)*1024+((r32^(2*(2*d0+hi)))<<4);
  bf16x8 qr[4];
  #pragma unroll
  for(int d0=0;d0<4;++d0)qr[d0]=*reinterpret_cast<const bf16x8*>(&Qw[(long)r32*DM+d0*16+hi*8]);
  int t=(r0+QBLK-2)>>6;
  u32x4 ks[8],vs[8]; bf16x8 kf[8];
  #define SB_LD(tt) do{ _Pragma("unroll") for(int i=0;i<8;++i){ ks[i]=*reinterpret_cast<const u32x4*>(kbase+(long)(64*(tt)+8*i)*DM); vs[i]=*reinterpret_cast<const u32x4*>(vbase+(long)(64*(tt)+8*i)*DM); } }while(0)
  #define SB_ST() do{ _Pragma("unroll") for(int i=0;i<8;++i){ if(i&1) kw1[(i>>1)*16]=ks[i]; else kw0[(i>>1)*16]=ks[i]; vw[32*i]=vs[i]; } }while(0)
  #define SB_KF() do{ _Pragma("unroll") for(int d0=0;d0<4;++d0){ kf[2*d0]=*(const __attribute__((address_space(3))) bf16x8*)(wl3+koff4[d0]); kf[2*d0+1]=*(const __attribute__((address_space(3))) bf16x8*)(wl3+koff4[d0]+512); } }while(0)
  SB_LD(t); SB_ST();
  f32x16 o[2];o[0]=f32x16{};o[1]=f32x16{};
  float Cc=1.f; bool first=true;
  for(;;){
    const bool more=t>0; const int tn=more?t-1:0;
    SB_LD(tn);
    SB_KF();
    f32x16 p0,p1;
    #pragma unroll
    for(int d0=0;d0<4;++d0){
      if(d0==0){const f32x16 z=f32x16{};p0=__builtin_amdgcn_mfma_f32_32x32x16_bf16(kf[0],qr[0],z,0,0,0);p1=__builtin_amdgcn_mfma_f32_32x32x16_bf16(kf[1],qr[0],z,0,0,0);}
      else{p0=__builtin_amdgcn_mfma_f32_32x32x16_bf16(kf[2*d0],qr[d0],p0,0,0,0);p1=__builtin_amdgcn_mfma_f32_32x32x16_bf16(kf[2*d0+1],qr[d0],p1,0,0,0);}}
    if(first){ const float NEG=-INFINITY; const int thr=r0+r32-64*t-4*hi;
      #pragma unroll
      for(int r=0;r<16;++r){const int kc=(r&3)+8*(r>>2); if(kc>=thr)p0[r]=NEG; if(kc+32>=thr)p1[r]=NEG;} }
    f32x16 W0,W1;
    #pragma unroll
    for(int r=0;r<16;++r){
      const float e0=__builtin_amdgcn_exp2f(p0[r]),e1=__builtin_amdgcn_exp2f(p1[r]);
      const float w0=__builtin_amdgcn_rcpf(1.0f+e0),w1=__builtin_amdgcn_rcpf(1.0f+e1);
      W0[r]=w0;W1[r]=w1;p0[r]=1.0f-w0;p1[r]=1.0f-w1; }
    float own[8],oth[8],base[8];
    #pragma unroll
    for(int m=0;m<4;++m){ own[m]=(W0[4*m]*W0[4*m+1])*(W0[4*m+2]*W0[4*m+3]); own[4+m]=(W1[4*m]*W1[4*m+1])*(W1[4*m+2]*W1[4*m+3]); }
    #pragma unroll
    for(int m=0;m<8;++m){ auto rr=__builtin_amdgcn_permlane32_swap(__float_as_uint(own[m]),__float_as_uint(own[m]),false,false); oth[m]=__uint_as_float(hi?rr[0]:rr[1]); }
    float tot=Cc;
    #pragma unroll
    for(int m=7;m>=0;--m){ base[m]=hi?tot:tot*oth[m]; tot*=own[m]*oth[m]; }
    Cc=tot;
    #pragma unroll
    for(int m=0;m<4;++m){
      { const float a3=base[m],a2=a3*W0[4*m+3],a1=a2*W0[4*m+2],a0=a1*W0[4*m+1];
        p0[4*m+0]*=a0; p0[4*m+1]*=a1; p0[4*m+2]*=a2; p0[4*m+3]*=a3; }
      { const float a3=base[4+m],a2=a3*W1[4*m+3],a1=a2*W1[4*m+2],a0=a1*W1[4*m+1];
        p1[4*m+0]*=a0; p1[4*m+1]*=a1; p1[4*m+2]*=a2; p1[4*m+3]*=a3; } }
    #define PKW(P,B) cvtpk_s(P[B],P[B+1])
    u32x4 pw0=(u32x4){PKW(p0,0),PKW(p0,2),PKW(p0,4),PKW(p0,6)},pw1=(u32x4){PKW(p0,8),PKW(p0,10),PKW(p0,12),PKW(p0,14)},pw2=(u32x4){PKW(p1,0),PKW(p1,2),PKW(p1,4),PKW(p1,6)},pw3=(u32x4){PKW(p1,8),PKW(p1,10),PKW(p1,12),PKW(p1,14)};
    #undef PKW
    pv(o,vb,__builtin_bit_cast(bf16x8,pw0),__builtin_bit_cast(bf16x8,pw1),__builtin_bit_cast(bf16x8,pw2),__builtin_bit_cast(bf16x8,pw3));
    if(!more||__all(Cc==0.f))break;
    SB_ST();
    --t; first=false;
  }
  #undef SB_LD
  #undef SB_ST
  #undef SB_KF
  bf16*Ow=O+(rowbase+r0)*DM+h*D;
  { bf16*stg=(bf16*)wl;
    #pragma unroll
    for(int r=0;r<16;++r){const int orow=crow(r,hi);
      #pragma unroll
      for(int d0=0;d0<2;++d0)stg[orow*64+d0*32+r32]=__float2bfloat16(o[d0][r]);}
    asm volatile("s_waitcnt lgkmcnt(0)":::"memory");
    #pragma unroll
    for(int i=0;i<4;++i){const int row=i*8+(lane>>3),ch=lane&7; const u32x4 v=*(const u32x4*)(stg+row*64+ch*8); ATTN_STORE16(Ow+(long)row*DM+ch*8,v);} }
  asm volatile("s_waitcnt lgkmcnt(0)":::"memory");
}
constexpr int ATTN_LDS_BYTES=LDS2_BYTES;
template<int THRL> __device__ __forceinline__ void diff_attn_phase(char*lds,const bf16*Q,const bf16*K,const bf16*V,bf16*OA,bf16*HBo,const float lam,const float*subg,const float osc,int G,int vcu,const int wv){
  for(int i=0;;++i){ const int grp=(vcu>>3)+(G>>3)*(i>>2); if(grp>=BATCH*(NHEAD/2))break; const int s=vcu&7,ii=i&3; const int qb=(ii==0)?s:(ii==1)?15-s:(ii==2)?16+s:31-s;
    const int b=grp>>3,h=grp&7; const int vcol=h*128;
    attn_unit128<THRL,false>(b,(2*h)*64,(2*h)*64,vcol,vcol,qb,Q,K,V,OA,lds,wv,HBo,lam,subg,osc);
    attn_unit128<THRL,true>(b,(2*h+1)*64,(2*h+1)*64,vcol,vcol,qb,Q,K,V,OA,lds,wv,HBo,lam,subg,osc); }
}
__device__ __forceinline__ void sb_attn_phase(char*lds,const bf16*Q,const bf16*K,const bf16*V,bf16*O,int G,int vcu,const int wv){
  const int wid=wv;
  for(int i=0;;++i){ const int grp=(vcu>>3)+(G>>3)*(i>>2); if(grp>=BATCH*NHEAD)break; const int rb=(((i&3)*8+(vcu&7))*8+wid);
    sb_item(grp>>4,grp&15,rb,Q,K,V,O,lds,wv); }
}
#undef SBAR
#undef WAIT_BAR
}

constexpr int NWAVES = 8;
constexpr int BATCH = 4, T = 8192, D = 1024, M = BATCH * T, NQKV = 3 * D, NE = 32, FF = 512;
constexpr float NORM_EPS = 1e-6f;
constexpr float C2 = 0.125f * 1.4426950408889634f;
constexpr float LAM_INIT0 = 0.2f;

constexpr size_t MiB = 1u << 20;
constexpr size_t WS_CTL = 0, CTL_ZERO_BYTES = 64 * 1024;
constexpr size_t WS_MOD = 1 * MiB;
constexpr size_t WS_GATEW = 1 * MiB + 256 * 1024;
constexpr size_t WS_WQKV = 2 * MiB, WS_WO = 14 * MiB, WS_W1 = 18 * MiB, WS_W2 = 146 * MiB;
constexpr size_t WS_HB = 210 * MiB;
constexpr size_t WS_Q = 274 * MiB, WS_K = 338 * MiB, WS_V = 402 * MiB, WS_OA = 466 * MiB;
constexpr size_t WS_Y2 = 274 * MiB;
constexpr size_t WS_HID = 402 * MiB;
constexpr size_t WS_LIST = 474 * MiB;
constexpr size_t WS_XR = 478 * MiB;
constexpr size_t WS_END = 542 * MiB;
constexpr int CW_TMO = 0, CW_CODE = 1, CW_BAR = 4096, CW_CNT = 8192;

constexpr int RING_OFF = 0, RING_BYTES = 135168;
constexpr int LDSCTL_OFF = RING_BYTES, MISC_OFF = LDSCTL_OFF + 320;
constexpr int TAB_CNT = LDSCTL_OFF + 512, TAB_PRE = LDSCTL_OFF + 640, TAB_BR = LDSCTL_OFF + 896, TAB_LCNT = LDSCTL_OFF + 1024, TAB_LBASE = LDSCTL_OFF + 1152;
constexpr int TAB_ASG_E = LDSCTL_OFF + 1280, TAB_ASG_S = LDSCTL_OFF + 2304, TAB_ASG_D = LDSCTL_OFF + 3328;
constexpr int LDS_BYTES = 147456;
static_assert(TAB_ASG_D + 1024 <= LDS_BYTES, "LDS map");
#define GAS __attribute__((address_space(1)))
#define LAS __attribute__((address_space(3)))
typedef unsigned short bf16;
typedef unsigned v4u __attribute__((ext_vector_type(4)));
typedef float f32x4 __attribute__((ext_vector_type(4)));
typedef short bf16x8 __attribute__((ext_vector_type(8)));
typedef GAS unsigned gu32;
typedef GAS unsigned long long gu64;
#define RLX_AGENT __ATOMIC_RELAXED, __HIP_MEMORY_SCOPE_AGENT
#define LDS_WAIT() asm volatile("s_waitcnt lgkmcnt(0)" ::: "memory")
#define VM_WAIT() asm volatile("s_waitcnt vmcnt(0)" ::: "memory")
__device__ __forceinline__ unsigned long long rt() { return __builtin_amdgcn_s_memrealtime(); }
__device__ __forceinline__ unsigned f2bf(float f) { unsigned u = __builtin_bit_cast(unsigned, f); return (u + 0x7fffu + ((u >> 16) & 1u)) >> 16; }
__device__ __forceinline__ unsigned pk2(float lo, float hi) { return f2bf(lo) | (f2bf(hi) << 16); }

#define XB_TMO      128
#define XB_XCNT(j)  (256  + 64 * (j))
#define XB_XSUB(j)  (1280 + 64 * (j))
#define XB_XGEN(j)  (2304 + 64 * (j))
#define XB_TOP      3328
#define XB_TOPGEN   3392
#define XCD_BAR_WORDS 3456
#define XB_SPIN_CAP (1u << 18)

__device__ __forceinline__ unsigned xb_ld(unsigned* p)              { return __hip_atomic_load(p, __ATOMIC_RELAXED, __HIP_MEMORY_SCOPE_AGENT); }
__device__ __forceinline__ unsigned xb_add(unsigned* p, unsigned v) { return __hip_atomic_fetch_add(p, v, __ATOMIC_RELAXED, __HIP_MEMORY_SCOPE_AGENT); }
__device__ __forceinline__ unsigned xb_xcc_id() { return (unsigned)__builtin_amdgcn_s_getreg((3 << 11) | 20) & 0xFu; }
#define XB_SPIN(cond, bar) do { unsigned _sp = 0; while (cond) { __builtin_amdgcn_s_sleep(1); \
    if ((++_sp & 255u) == 0u) { if (xb_ld(&(bar)[XB_TMO])) break; if (_sp > XB_SPIN_CAP) { atomicAdd(&(bar)[XB_TMO], 1u); break; } } } } while (0)

struct XcdBarrier {
    unsigned* bar; unsigned x; int wv;
    volatile LAS unsigned* st;
};

__device__ __forceinline__ XcdBarrier xcd_barrier_post(unsigned* bar, volatile LAS unsigned* st, int wv) {
    XcdBarrier b; b.bar = bar; b.x = xb_xcc_id(); b.st = st; b.wv = wv;
    if (threadIdx.x == 0) (void)xb_add(&bar[XB_XCNT(b.x)], 1u);
    return b;
}
__device__ __forceinline__ void xcd_barrier_complete(unsigned* bar, unsigned x, unsigned& nloc, unsigned& nx) {
    const unsigned G = gridDim.x * gridDim.y * gridDim.z;
    unsigned sum, cnt, mine, sp = 0u;
    for (;;) {
        sum = 0u; cnt = 0u; mine = 0u;
#pragma unroll
        for (unsigned j = 0; j < 16; ++j) { const unsigned c = xb_ld(&bar[XB_XCNT(j)]); sum += c; cnt += (c > 0u) ? 1u : 0u; mine = (j == x) ? c : mine; }
        if (sum == G) break;
        __builtin_amdgcn_s_sleep(1);
        if ((++sp & 255u) == 0u) { if (xb_ld(&bar[XB_TMO])) break; if (sp > XB_SPIN_CAP) { atomicAdd(&bar[XB_TMO], 1u); break; } }
    }
    nloc = mine > 0u ? mine : 1u; nx = cnt > 0u ? cnt : 1u;
}

__device__ __forceinline__ void xcd_barrier(const XcdBarrier& b) {
    asm volatile("s_waitcnt vmcnt(0)" ::: "memory");
    __syncthreads();
    if (b.wv == 0 && lane_id_() == 0) {
        unsigned* bar = b.bar; unsigned bx_ = b.x; asm volatile("" : "+s"(bx_));
        __builtin_amdgcn_s_waitcnt(0);
        unsigned nloc = b.st[0], nx = b.st[1];
        if (nloc == 0u) { xcd_barrier_complete(bar, bx_, nloc, nx); b.st[0] = nloc; b.st[1] = nx; }
        const unsigned old = xb_add(&bar[XB_XSUB(bx_)], 1u);
        const unsigned gen = old / nloc;
        if (old + 1u == (gen + 1u) * nloc) {
            __builtin_amdgcn_fence(__ATOMIC_RELEASE, "agent");
            asm volatile("s_waitcnt vmcnt(0)" ::: "memory");
            const unsigned og = xb_add(&bar[XB_TOP], 1u);
            const unsigned tg = og / nx;
            if (og + 1u == (tg + 1u) * nx) xb_add(&bar[XB_TOPGEN], 1u);
            else XB_SPIN(xb_ld(&bar[XB_TOPGEN]) == tg, bar);
            __builtin_amdgcn_fence(__ATOMIC_ACQUIRE, "agent");
            xb_add(&bar[XB_XGEN(bx_)], 1u);
            asm volatile("s_waitcnt vmcnt(0)" ::: "memory");
        } else {
            XB_SPIN(xb_ld(&bar[XB_XGEN(bx_)]) == gen, bar);
            __builtin_amdgcn_fence(__ATOMIC_ACQUIRE, "agent");
            asm volatile("s_waitcnt vmcnt(0)" ::: "memory");
        }
    }
    __syncthreads();
}

struct Args { const void* in[16]; float* out; unsigned char* ws; };
struct Frame {
    LAS unsigned char* lds;
    volatile LAS unsigned* MISC;
    gu32* ctl;
    int tid, lane, wave;
    int vcu, G;
    const __attribute__((address_space(4))) Args* a;
};
#define FIN(i)   ((const float*)F.a->in[i])
#define F_x FIN(0)
#define F_c FIN(1)
#define F_pos ((const int*)F.a->in[2])
#define F_w_ada FIN(3)
#define F_b_ada FIN(4)
#define F_norm_g FIN(5)
#define F_w_in FIN(6)
#define F_w_out FIN(7)
#define F_diff_lambda FIN(8)
#define F_subln_g FIN(9)
#define F_w_router FIN(10)
#define F_b_router FIN(11)
#define F_w_gate FIN(12)
#define F_w_up FIN(13)
#define F_w_down FIN(14)
#define F_final_g FIN(15)
#define F_out (F.a->out)
#define F_mod ((float*)(F.a->ws + WS_MOD))
#define F_gatew ((float*)(F.a->ws + WS_GATEW))
#define F_Wqkv_t ((bf16*)(F.a->ws + WS_WQKV))
#define F_Wo_t ((bf16*)(F.a->ws + WS_WO))
#define F_W1_t ((bf16*)(F.a->ws + WS_W1))
#define F_W2_t ((bf16*)(F.a->ws + WS_W2))
#define F_HB ((bf16*)(F.a->ws + WS_HB))
#define F_QB ((bf16*)(F.a->ws + WS_Q))
#define F_KB ((bf16*)(F.a->ws + WS_K))
#define F_VB ((bf16*)(F.a->ws + WS_V))
#define F_OA ((bf16*)(F.a->ws + WS_OA))
#define F_Y2 ((bf16*)(F.a->ws + WS_Y2))
#define F_HID ((bf16*)(F.a->ws + WS_HID))
#define F_list ((int*)(F.a->ws + WS_LIST))
#define F_XR ((bf16*)(F.a->ws + WS_XR))
typedef unsigned long long u64;
template <int X> __device__ __forceinline__ float swz_xor(float v) { return __int_as_float(__builtin_amdgcn_ds_swizzle(__float_as_int(v), (X << 10) | 0x1f)); }
__device__ __forceinline__ float half_sum(float v) {
    v += swz_xor<1>(v); v += swz_xor<2>(v); v += swz_xor<4>(v); v += swz_xor<8>(v); v += swz_xor<16>(v); return v;
}
__device__ __forceinline__ float wave_sum(float v) {
    v = half_sum(v);
    const auto rr = __builtin_amdgcn_permlane32_swap(__float_as_uint(v), __float_as_uint(v), false, false);
    return __uint_as_float(rr[0]) + __uint_as_float(rr[1]);
}
__device__ __forceinline__ float bf_lo(unsigned w) { return __uint_as_float(w << 16); }
__device__ __forceinline__ float bf_hi(unsigned w) { return __uint_as_float(w & 0xffff0000u); }
__device__ __forceinline__ f32x4 bf4_to_f32(u64 w) { const unsigned lo = (unsigned)w, hi = (unsigned)(w >> 32); return (f32x4){bf_lo(lo), bf_hi(lo), bf_lo(hi), bf_hi(hi)}; }
__device__ __forceinline__ u64 f32_to_bf4(f32x4 v) { return (u64)pg8::cvt_pk_bf16(v.x, v.y) | ((u64)pg8::cvt_pk_bf16(v.z, v.w) << 32); }

__device__ __forceinline__ int rowmap(int mode, int n) {
    if (mode == 1) { if (n >= 2048) return n; const int d = n & 63; const int p = d < 8 ? 2 * d : (d < 16 ? 2 * (d - 8) + 1 : d); return (n & ~63) + p; }
    if (mode == 2) return 256 * (n >> 7) + (n & 127);
    if (mode == 3) return 256 * (n >> 7) + 128 + (n & 127);
    return n;
}
struct P0Item { const float* W; bf16* WT; int N, K, mode, k0, n0; };
__device__ __forceinline__ void p0_item_load(f32x4 (&w)[16], const P0Item& it, int lane) {
    const float* p = it.W + (size_t)(it.k0 + (lane >> 4)) * it.N + it.n0 + 4 * (lane & 15);
#pragma unroll
    for (int i = 0; i < 16; ++i) w[i] = *(const f32x4*)(p + (size_t)(4 * i) * it.N);
}
__device__ __forceinline__ void p0_item_store(const f32x4 (&w)[16], const P0Item& it, LAS float* scr, int lane) {
    LAS float* wp = scr + (lane >> 4) * 65 + 4 * (lane & 15);
#pragma unroll
    for (int i = 0; i < 16; ++i) { LAS float* q = wp + (4 * i) * 65; q[0] = w[i].x; q[1] = w[i].y; q[2] = w[i].z; q[3] = w[i].w; }
    LDS_WAIT(); asm volatile("" ::: "memory");
    const int c = lane & 7;
#pragma unroll
    for (int j = 0; j < 8; ++j) { const int n = (lane >> 3) + 8 * j; const LAS float* s = scr + (8 * c) * 65 + n;
        v4u o; o.x = pg8::cvt_pk_bf16(s[0 * 65], s[1 * 65]); o.y = pg8::cvt_pk_bf16(s[2 * 65], s[3 * 65]); o.z = pg8::cvt_pk_bf16(s[4 * 65], s[5 * 65]); o.w = pg8::cvt_pk_bf16(s[6 * 65], s[7 * 65]);
        *(GAS v4u*)(it.WT + (size_t)rowmap(it.mode, it.n0 + n) * it.K + it.k0 + 8 * c) = o; }
    LDS_WAIT(); asm volatile("" ::: "memory");
}
__device__ __forceinline__ void p0_prologue(Frame& F) {
    {
        LAS float* sc = (LAS float*)(F.lds);
        LAS float* red = (LAS float*)(F.lds + 16384);
        for (int i = F.tid; i < BATCH * D; i += NWAVES * 64) { const float cv = F_c[i]; sc[i] = cv / (1.f + __expf(-cv)); }
        __syncthreads();
        const int kg = F.tid >> 5, cc = F.tid & 31;
        for (int task = blockIdx.x; task < 2 * 192; task += F.G) {
            const int l = task / 192, col0 = (task % 192) * 32;
            const float* W = F_w_ada + (size_t)l * D * 6144 + col0 + cc;
            float a0 = 0.f, a1 = 0.f, a2 = 0.f, a3 = 0.f;
#pragma unroll 8
            for (int k = kg * 64; k < kg * 64 + 64; ++k) { const float w = W[(size_t)k * 6144]; a0 += sc[k] * w; a1 += sc[1024 + k] * w; a2 += sc[2048 + k] * w; a3 += sc[3072 + k] * w; }
            red[(kg * 4 + 0) * 32 + cc] = a0; red[(kg * 4 + 1) * 32 + cc] = a1; red[(kg * 4 + 2) * 32 + cc] = a2; red[(kg * 4 + 3) * 32 + cc] = a3;
            __syncthreads();
            if (F.tid < 128) { const int b = F.tid >> 5; float s = F_b_ada[l * 6144 + col0 + cc];
#pragma unroll
                for (int g = 0; g < 16; ++g) s += red[(g * 4 + b) * 32 + cc];
                F_mod[(size_t)(l * 4 + b) * 6144 + col0 + cc] = s; }
            __syncthreads();
        }
    }
    const int gw = F.vcu * NWAVES + F.wave, NGW = F.G * NWAVES;
    constexpr int I_IN = (D / 64) * (NQKV / 64), I_O = (D / 64) * (D / 64), I_GU = (D / 64) * (FF / 64), I_DN = (FF / 64) * (D / 64);
    constexpr int N_IN = 2 * I_IN, N_O = 2 * I_O, N_GU = 2 * NE * 2 * I_GU, N_DN = 2 * NE * I_DN, N_ALL = N_IN + N_O + N_GU + N_DN;
#define P0_DECODE(it_, X) do { int r = (it_); \
        if (r < N_IN) { const int l = r / I_IN, q = r % I_IN; X.W = F_w_in + (size_t)l * D * NQKV; X.WT = F_Wqkv_t + (size_t)l * NQKV * D; X.N = NQKV; X.K = D; X.mode = (l == 0) ? 1 : 0; X.k0 = 64 * (q / (NQKV / 64)); X.n0 = 64 * (q % (NQKV / 64)); break; } r -= N_IN; \
        if (r < N_O) { const int l = r / I_O, q = r % I_O; X.W = F_w_out + (size_t)l * D * D; X.WT = F_Wo_t + (size_t)l * D * D; X.N = D; X.K = D; X.mode = 0; X.k0 = 64 * (q / (D / 64)); X.n0 = 64 * (q % (D / 64)); break; } r -= N_O; \
        if (r < N_GU) { const int mat = r / I_GU, q = r % I_GU, le = mat >> 1, gu = mat & 1; X.W = (gu ? F_w_up : F_w_gate) + (size_t)le * D * FF; X.WT = F_W1_t + (size_t)le * 2 * FF * D; X.N = FF; X.K = D; X.mode = 2 + gu; X.k0 = 64 * (q / (FF / 64)); X.n0 = 64 * (q % (FF / 64)); break; } r -= N_GU; \
        { const int le = r / I_DN, q = r % I_DN; X.W = F_w_down + (size_t)le * FF * D; X.WT = F_W2_t + (size_t)le * D * FF; X.N = D; X.K = FF; X.mode = 0; X.k0 = 64 * (q / (D / 64)); X.n0 = 64 * (q % (D / 64)); } } while (0)
    f32x4 wa[16], wb[16]; P0Item ia, ib; LAS float* scr = (LAS float*)(F.lds + RING_OFF + F.wave * 16640);
    int it = gw;
    { const int c0 = it < N_ALL ? it : N_ALL - 1; P0_DECODE(c0, ia); p0_item_load(wa, ia, F.lane); }
    while (it < N_ALL) {
        const int it1 = it + NGW, c1 = it1 < N_ALL ? it1 : N_ALL - 1;
        P0_DECODE(c1, ib); p0_item_load(wb, ib, F.lane);
        p0_item_store(wa, ia, scr, F.lane);
        const int it2 = it1 + NGW, c2 = it2 < N_ALL ? it2 : N_ALL - 1;
        P0_DECODE(c2, ia); p0_item_load(wa, ia, F.lane);
        if (it1 < N_ALL) p0_item_store(wb, ib, scr, F.lane);
        it = it2;
    }
#undef P0_DECODE
}

template <bool COMBINE> __device__ __forceinline__ void n1_phase(Frame& F, const int l, const float* xin, float* xout) {
    const int gw = F.vcu * NWAVES + F.wave, NGW = F.G * NWAVES, RPW = (M + NGW - 1) / NGW;
    const int m0 = gw * RPW, m1 = (m0 + RPW < M) ? m0 + RPW : M;
    int bcur = -1; f32x4 gs[4], sh[4], gm[4];
#pragma unroll
    for (int j = 0; j < 4; ++j) { gs[j] = (f32x4){0.f, 0.f, 0.f, 0.f}; sh[j] = gs[j]; gm[j] = gs[j]; }
    const float* ng = F_norm_g + (size_t)(l * 2 + 0) * D;
    for (int m = m0; m < m1; ++m) {
        const int b = m / T;
        if (b != bcur) { bcur = b; const float* mp = F_mod + (size_t)(l * 4 + b) * 6144;
#pragma unroll
            for (int j = 0; j < 4; ++j) { const int col = 4 * F.lane + 256 * j; const f32x4 g = *(const f32x4*)(ng + col), sc = *(const f32x4*)(mp + 1024 + col);
                gs[j] = g * (sc + 1.0f); sh[j] = *(const f32x4*)(mp + col);
                if (COMBINE) gm[j] = *(const f32x4*)(F_mod + (size_t)((l - 1) * 4 + b) * 6144 + 5120 + col); } }
        f32x4 v[4];
        if (COMBINE) { const GAS u64* xr = (const GAS u64*)(F_XR + (size_t)m * D) + F.lane;
#pragma unroll
            for (int j = 0; j < 4; ++j) v[j] = bf4_to_f32(xr[64 * j]); }
        else { const GAS f32x4* xr = (const GAS f32x4*)(xin + (size_t)m * D) + F.lane;
#pragma unroll
            for (int j = 0; j < 4; ++j) v[j] = xr[64 * j]; }
        if (COMBINE) { const GAS u64* ya = (const GAS u64*)(F_Y2 + (size_t)(2 * m) * D) + F.lane; const GAS u64* yb = ya + D / 4;
            GAS u64* xo = (GAS u64*)(F_XR + (size_t)m * D) + F.lane;
            const float w0 = F_gatew[2 * m], w1 = F_gatew[2 * m + 1];
#pragma unroll
            for (int j = 0; j < 4; ++j) { const f32x4 fa = bf4_to_f32(ya[64 * j]), fb = bf4_to_f32(yb[64 * j]); v[j] = v[j] + gm[j] * (fa * w0 + fb * w1); xo[64 * j] = f32_to_bf4(v[j]); v[j] = bf4_to_f32(f32_to_bf4(v[j])); } }
        float s2 = 0.f;
#pragma unroll
        for (int j = 0; j < 4; ++j) s2 += (v[j].x * v[j].x + v[j].y * v[j].y) + (v[j].z * v[j].z + v[j].w * v[j].w);
        const float rstd = __builtin_amdgcn_rsqf(wave_sum(s2) * (1.f / D) + NORM_EPS);
        GAS u64* o8 = (GAS u64*)(F_HB + (size_t)m * D) + F.lane;
#pragma unroll
        for (int j = 0; j < 4; ++j) o8[64 * j] = f32_to_bf4(v[j] * rstd * gs[j] + sh[j]);
    }
}
__device__ __forceinline__ void final_phase(Frame& F, const float* xin, float* xout) {
    const int gw = F.vcu * NWAVES + F.wave, NGW = F.G * NWAVES, RPW = (M + NGW - 1) / NGW;
    const int m0 = gw * RPW, m1 = (m0 + RPW < M) ? m0 + RPW : M;
    int bcur = -1; f32x4 fg[4], gm[4];
#pragma unroll
    for (int j = 0; j < 4; ++j) { fg[j] = *(const f32x4*)(F_final_g + 4 * F.lane + 256 * j); gm[j] = (f32x4){0.f, 0.f, 0.f, 0.f}; }
    for (int m = m0; m < m1; ++m) {
        const int b = m / T;
        if (b != bcur) { bcur = b;
#pragma unroll
            for (int j = 0; j < 4; ++j) gm[j] = *(const f32x4*)(F_mod + (size_t)(1 * 4 + b) * 6144 + 5120 + 4 * F.lane + 256 * j); }
        const GAS u64* xr = (const GAS u64*)(F_XR + (size_t)m * D) + F.lane;
        const GAS u64* ya = (const GAS u64*)(F_Y2 + (size_t)(2 * m) * D) + F.lane; const GAS u64* yb = ya + D / 4;
        f32x4 v[4]; float s2 = 0.f; const float w0 = F_gatew[2 * m], w1 = F_gatew[2 * m + 1];
#pragma unroll
        for (int j = 0; j < 4; ++j) { v[j] = bf4_to_f32(xr[64 * j]) + gm[j] * (bf4_to_f32(ya[64 * j]) * w0 + bf4_to_f32(yb[64 * j]) * w1); s2 += (v[j].x * v[j].x + v[j].y * v[j].y) + (v[j].z * v[j].z + v[j].w * v[j].w); }
        const float rstd = __builtin_amdgcn_rsqf(wave_sum(s2) * (1.f / D) + NORM_EPS);
        GAS f32x4* xo = (GAS f32x4*)(xout + (size_t)m * D) + F.lane;
#pragma unroll
        for (int j = 0; j < 4; ++j) xo[64 * j] = v[j] * rstd * fg[j];
    }
}
__device__ __forceinline__ int crow_(int r, int hi) { return (r & 3) + 8 * (r >> 2) + 4 * hi; }
template <bool XBF> __device__ __forceinline__ void n2_phase(Frame& F, const int l, const float* xin, const int cset) {
    typedef float f32x16 __attribute__((ext_vector_type(16)));
    LAS float* tileA = (LAS float*)F.lds;
    LAS float* part = (LAS float*)F.lds;
    LAS float* logit = (LAS float*)(F.lds + 65536);
    LAS int* lcnt = (LAS int*)(F.lds + TAB_LCNT); LAS int* lbase = (LAS int*)(F.lds + TAB_LBASE);
    LAS int* asg_e = (LAS int*)(F.lds + TAB_ASG_E); LAS int* asg_s = (LAS int*)(F.lds + TAB_ASG_S); LAS int* asg_d = (LAS int*)(F.lds + TAB_ASG_D);
    LAS float* br = (LAS float*)(F.lds + TAB_BR);
    if (F.tid < 32) { lcnt[F.tid] = 0; br[F.tid] = F_b_router[F.tid]; }
    __syncthreads();
    gu32* gcnt = F.ctl + CW_CNT + 64 * cset;
    const float* ng = F_norm_g + (size_t)(l * 2 + 1) * D;
    const int ei = F.lane & 31, kk = F.lane >> 5;
    typedef short bf16x8_t __attribute__((ext_vector_type(8)));
    bf16x8_t whi[8], wlo[8];
#pragma unroll
    for (int sx = 0; sx < 8; ++sx) { v4u h4, l4;
#pragma unroll
        for (int jp = 0; jp < 4; ++jp) { const int k0 = 128 * F.wave + 16 * sx + 8 * kk + 2 * jp; const float w0 = F_w_router[k0 * 32 + ei], w1 = F_w_router[(k0 + 1) * 32 + ei];
            const unsigned hp = pg8::cvt_pk_bf16(w0, w1); h4[jp] = hp; l4[jp] = pg8::cvt_pk_bf16(w0 - bf_lo(hp), w1 - bf_hi(hp)); }
        whi[sx] = __builtin_bit_cast(bf16x8_t, h4); wlo[sx] = __builtin_bit_cast(bf16x8_t, l4); }
    constexpr int NT32 = M / 32;
#define N2_TILE(n) (F.vcu * 4 + ((n) >> 2) * F.G * 4 + ((n) & 3))
#define N2_LOAD(tile_) do { _Pragma("unroll") for (int rr = 0; rr < 4; ++rr) { const size_t m_ = (size_t)((tile_) * 32 + 4 * F.wave + rr); \
        if (XBF) { const GAS u64* xr = (const GAS u64*)(F_XR + m_ * D) + F.lane; _Pragma("unroll") for (int j = 0; j < 4; ++j) v[rr][j] = bf4_to_f32(xr[64 * j]); } \
        else { const GAS f32x4* xr = (const GAS f32x4*)(xin + m_ * D) + F.lane; _Pragma("unroll") for (int j = 0; j < 4; ++j) v[rr][j] = xr[64 * j]; } } } while (0)
    f32x4 v[4][4];
    int n = 0, tile = N2_TILE(0); bool have = tile < NT32;
    if (have) N2_LOAD(tile);
    while (have) {
        const int ti = n & 3, row0 = tile * 32, b = row0 / T; u64 mx[4][4];
#pragma unroll
        for (int rr = 0; rr < 4; ++rr) { const GAS u64* mr = (const GAS u64*)(F_QB + (size_t)(row0 + 4 * F.wave + rr) * D) + F.lane;
#pragma unroll
            for (int j = 0; j < 4; ++j) mx[rr][j] = mr[64 * j]; }
        const float* mp = F_mod + (size_t)(l * 4 + b) * 6144 + 3072;
        float s2[4] = {0.f, 0.f, 0.f, 0.f};
#pragma unroll
        for (int j = 0; j < 4; ++j) { const int col = 4 * F.lane + 256 * j; const f32x4 gaj = *(const f32x4*)(mp - 1024 + col);
#pragma unroll
            for (int rr = 0; rr < 4; ++rr) { const u64 xb = f32_to_bf4(v[rr][j] + gaj * bf4_to_f32(mx[rr][j])); const f32x4 x1 = bf4_to_f32(xb); v[rr][j] = x1;
                *((GAS u64*)(F_XR + (size_t)(row0 + 4 * F.wave + rr) * D + col)) = xb; s2[rr] += (x1.x * x1.x + x1.y * x1.y) + (x1.z * x1.z + x1.w * x1.w); } }
#pragma unroll
        for (int rr = 0; rr < 4; ++rr) s2[rr] = wave_sum(s2[rr]);
        float rstd[4];
#pragma unroll
        for (int rr = 0; rr < 4; ++rr) rstd[rr] = __builtin_amdgcn_rsqf(s2[rr] * (1.f / D) + NORM_EPS);
#pragma unroll
        for (int j = 0; j < 4; ++j) { const int col = 4 * F.lane + 256 * j; const f32x4 g = *(const f32x4*)(ng + col), sc = *(const f32x4*)(mp + 1024 + col), shj = *(const f32x4*)(mp + col); const f32x4 gsj = g * (sc + 1.0f);
#pragma unroll
            for (int rr = 0; rr < 4; ++rr) { const int r = 4 * F.wave + rr; const f32x4 h = v[rr][j] * rstd[rr] * gsj + shj;
                *((GAS u64*)(F_HB + (size_t)(row0 + r) * D + col)) = f32_to_bf4(h); *(LAS f32x4*)(tileA + r * 1028 + col) = h; } }
        const int n1 = n + 1, tile1 = N2_TILE(n1); const bool have1 = tile1 < NT32;
        if (have1) N2_LOAD(tile1);
        __syncthreads();
        f32x16 acc = {};
#pragma unroll
        for (int sx = 0; sx < 8; ++sx) { const LAS float* ap = tileA + ei * 1028 + 128 * F.wave + 16 * sx + 8 * kk; const f32x4 a0 = *(const LAS f32x4*)ap, a1 = *(const LAS f32x4*)(ap + 4);
            v4u h4, l4;
            h4[0] = pg8::cvt_pk_bf16(a0.x, a0.y); h4[1] = pg8::cvt_pk_bf16(a0.z, a0.w); h4[2] = pg8::cvt_pk_bf16(a1.x, a1.y); h4[3] = pg8::cvt_pk_bf16(a1.z, a1.w);
            l4[0] = pg8::cvt_pk_bf16(a0.x - bf_lo(h4[0]), a0.y - bf_hi(h4[0])); l4[1] = pg8::cvt_pk_bf16(a0.z - bf_lo(h4[1]), a0.w - bf_hi(h4[1]));
            l4[2] = pg8::cvt_pk_bf16(a1.x - bf_lo(h4[2]), a1.y - bf_hi(h4[2])); l4[3] = pg8::cvt_pk_bf16(a1.z - bf_lo(h4[3]), a1.w - bf_hi(h4[3]));
            const bf16x8_t ahi = __builtin_bit_cast(bf16x8_t, h4), alo = __builtin_bit_cast(bf16x8_t, l4);
            acc = __builtin_amdgcn_mfma_f32_32x32x16_bf16(ahi, whi[sx], acc, 0, 0, 0); acc = __builtin_amdgcn_mfma_f32_32x32x16_bf16(ahi, wlo[sx], acc, 0, 0, 0);
            acc = __builtin_amdgcn_mfma_f32_32x32x16_bf16(alo, whi[sx], acc, 0, 0, 0); }
        __syncthreads();
#pragma unroll
        for (int r = 0; r < 16; ++r) part[(F.wave * 32 + crow_(r, kk)) * 33 + ei] = acc[r];
        __syncthreads();
        { const int row = F.tid >> 4;
#pragma unroll
            for (int e2 = 0; e2 < 32; e2 += 16) { const int e = (F.tid & 15) + e2; float s = 0.f;
#pragma unroll
                for (int w = 0; w < 8; ++w) s += part[(w * 32 + row) * 33 + e];
                logit[row * 33 + e] = s; } }
        __syncthreads();
        if (F.tid < 32) { const int row = F.tid, m = row0 + row; const LAS float* lg = logit + row * 33;
            float mx = lg[0];
#pragma unroll
            for (int e = 1; e < 32; ++e) mx = fmaxf(mx, lg[e]);
            float sum = 0.f;
#pragma unroll
            for (int e = 0; e < 32; ++e) sum += __expf(lg[e] - mx);
            const float inv = 1.0f / sum;
            float bestg = -INFINITY; int gb = 0;
#pragma unroll
            for (int g = 0; g < 4; ++g) { float t1 = -INFINITY, t2 = -INFINITY;
#pragma unroll
                for (int jj = 0; jj < 8; ++jj) { const int e = 8 * g + jj; const float sv = __expf(lg[e] - mx) * inv + br[e]; if (sv > t1) { t2 = t1; t1 = sv; } else if (sv > t2) t2 = sv; }
                const float gsv = t1 + t2; if (gsv > bestg) { bestg = gsv; gb = g; } }
            float t1 = -INFINITY, t2 = -INFINITY; int i1 = 0, i2 = 0;
#pragma unroll
            for (int jj = 0; jj < 8; ++jj) { const int e = 8 * gb + jj; const float sv = __expf(lg[e] - mx) * inv + br[e]; if (sv > t1) { t2 = t1; i2 = i1; t1 = sv; i1 = jj; } else if (sv > t2) { t2 = sv; i2 = jj; } }
            const int e1 = 8 * gb + i1, e2 = 8 * gb + i2;
            const float sc1 = __expf(lg[e1] - mx) * inv, sc2 = __expf(lg[e2] - mx) * inv, ig = 1.0f / (sc1 + sc2);
            const int a = (ti * 32 + row) * 2;
            asg_e[a] = e1; asg_s[a] = atomicAdd((int*)(lcnt + e1), 1); asg_d[a] = 2 * m; F_gatew[2 * m] = sc1 * ig;
            asg_e[a + 1] = e2; asg_s[a + 1] = atomicAdd((int*)(lcnt + e2), 1); asg_d[a + 1] = 2 * m + 1; F_gatew[2 * m + 1] = sc2 * ig; }
        __syncthreads();
        if (ti == 3 || !have1) {
            if (F.tid < 32) { int te = F.tid; asm volatile("" : "+v"(te));
                const int cnum = lcnt[te]; lbase[te] = cnum ? (int)__hip_atomic_fetch_add(gcnt + te, (unsigned)cnum, RLX_AGENT) : 0; lcnt[te] = 0; }
            __syncthreads();
            if (F.tid < 64 * (ti + 1)) { const int e = asg_e[F.tid]; F_list[(size_t)e * M + lbase[e] + asg_s[F.tid]] = asg_d[F.tid]; }
            __syncthreads();
        }
        n = n1; tile = tile1; have = have1;
    }
#undef N2_TILE
#undef N2_LOAD
}
__device__ __forceinline__ void load_counts(Frame& F, const int l) {
    LAS int* cnt = (LAS int*)(F.lds + TAB_CNT); LAS int* pre = (LAS int*)(F.lds + TAB_PRE);
    if (F.tid < 32) cnt[F.tid] = (int)__hip_atomic_load(F.ctl + CW_CNT + 64 * l + F.tid, RLX_AGENT);
    __syncthreads();
    if (F.tid == 0) { int s = 0; for (int e = 0; e < 32; ++e) { pre[e] = s; s += (cnt[e] + 255) >> 8; } pre[32] = s; }
    __syncthreads();
}

__global__ void __launch_bounds__(NWAVES * 64, 2) fwd_kernel(Args args) {
    extern __shared__ __attribute__((aligned(16))) unsigned char lds[];
    Frame F;
    F.lds = (LAS unsigned char*)lds;
    F.MISC = (volatile LAS unsigned*)(F.lds + MISC_OFF);
    F.tid = threadIdx.x; F.lane = F.tid & 63; F.wave = __builtin_amdgcn_readfirstlane(F.tid >> 6);
    F.G = gridDim.x; { const int bx = blockIdx.x; F.vcu = (F.G % 8 == 0) ? (bx % 8) * (F.G / 8) + bx / 8 : bx; }
    F.a = (const __attribute__((address_space(4))) Args*)__builtin_amdgcn_kernarg_segment_ptr(); (void)args; F.ctl = (gu32*)(F.a->ws + WS_CTL);
    for (int u = F.tid; u < (LDS_BYTES - LDSCTL_OFF) / 4; u += NWAVES * 64) ((LAS unsigned*)(F.lds + LDSCTL_OFF))[u] = 0u;
    __syncthreads();
    XcdBarrier bar = xcd_barrier_post((unsigned*)(F.ctl + CW_BAR), F.MISC + 8, F.wave);
#define GRID_BAR() xcd_barrier(bar)
#ifndef PH_MASK
#define PH_MASK 0xFFFFFFu
#endif
#ifndef DUP_MASK
#define DUP_MASK 0u
#endif
#ifndef STAMP_PH
#define STAMP_PH (-1)
#endif
#ifndef STAMP_BLK
#define STAMP_BLK 0
#endif
#ifndef STAMP_AMP
#define STAMP_AMP 4
#endif
    unsigned long long tsa_ = 0ull, tsb_ = 0ull; if (STAMP_PH == 100) tsa_ = rt();
#define PH(k) if constexpr (((PH_MASK) >> (k)) & 1u) _Pragma("unroll") for (int rep_ = 0, phk_ = (k); rep_ < 1 + (int)(((DUP_MASK) >> (k)) & 1u); ++rep_)
#define PHASE_END() do { if (STAMP_PH >= 200 && phk_ == STAMP_PH - 200) tsb_ = rt(); } while (0)
#define PHASE_BEGIN() do { if (STAMP_PH >= 0 && (phk_ == STAMP_PH || phk_ == STAMP_PH - 200)) tsa_ = rt(); if (STAMP_PH >= 0 && STAMP_PH < 100 && phk_ > STAMP_PH && tsb_ == 0ull) tsb_ = rt(); int t_ = F.wave * 64 + lane_id_(); asm volatile("" : "+v"(t_)); F.tid = t_; F.lane = t_ & 63; unsigned long long ka_ = (unsigned long long)F.a; asm volatile("" : "+s"(ka_)); F.a = (const __attribute__((address_space(4))) Args*)ka_; } while (0)
    const LAS int* tcnt = (const LAS int*)(F.lds + TAB_CNT); const LAS int* tpre = (const LAS int*)(F.lds + TAB_PRE);

    PH(0) { if (rep_) GRID_BAR(); PHASE_BEGIN();
    p0_prologue(F);
    PHASE_END(); }
    GRID_BAR();
    PH(1) { if (rep_) GRID_BAR(); PHASE_BEGIN();

    n1_phase<false>(F, 0, F_x, nullptr);
    PHASE_END(); }
    GRID_BAR();
    PH(2) { if (rep_) GRID_BAR(); PHASE_BEGIN();
    {
        pg8::StaticOrder S; S.init(F_HB, F_Wqkv_t, M, NQKV, D, F.G, (int)blockIdx.x);
        pg8::EpiQKV E{F_QB, (size_t)(WS_K - WS_Q) / 2, C2, F_pos, 1};
        pg8::gemm_phase<pg8::EpiQKV, pg8::StaticOrder, true, false>(F.lds + RING_OFF, D, S, E, F.wave);
    }
    PHASE_END(); }
    GRID_BAR();
    PH(3) { if (rep_) GRID_BAR(); PHASE_BEGIN();
    {
        const float s1 = wave_sum(F_diff_lambda[F.lane] * F_diff_lambda[64 + F.lane]), s2l = wave_sum(F_diff_lambda[128 + F.lane] * F_diff_lambda[192 + F.lane]);
        const float lam = __expf(s1) - __expf(s2l) + LAM_INIT0;
        attn_body::diff_attn_phase<8>((char*)lds + RING_OFF, (const attn_body::bf16*)F_QB, (const attn_body::bf16*)F_KB, (const attn_body::bf16*)F_VB, (attn_body::bf16*)F_out, (attn_body::bf16*)F_HB,
                                      lam, F_subln_g, 1.0f - LAM_INIT0, F.G, F.vcu, F.wave);
    }
    PHASE_END(); }
    GRID_BAR();
    PH(5) { if (rep_) GRID_BAR(); PHASE_BEGIN();
    {
        pg8::StaticOrder S; S.init(F_HB, F_Wo_t, M, D, D, F.G, (int)blockIdx.x);
        pg8::EpiPlain E{F_QB, D};
        pg8::gemm_phase<pg8::EpiPlain, pg8::StaticOrder, true, false>(F.lds + RING_OFF, D, S, E, F.wave);
    }
    PHASE_END(); }
    GRID_BAR();
    PH(6) { if (rep_) GRID_BAR(); PHASE_BEGIN();
    n2_phase<false>(F, 0, F_x, rep_ ? 2 : 0);
    PHASE_END(); }
    GRID_BAR();
    PH(7) { if (rep_) GRID_BAR(); PHASE_BEGIN();
    load_counts(F, 0);
    {
        pg8::GroupedOrder<4, true> S{tcnt, tpre, F.G, F.vcu, D, M, (const char*)F_HB, (const char*)F_W1_t, (size_t)2 * FF * D * 2, F_list};
        pg8::EpiSwiGLU E{F_HID};
        pg8::gemm_phase<pg8::EpiSwiGLU, pg8::GroupedOrder<4, true>, true, true>(F.lds + RING_OFF, D, S, E, F.wave);
    }
    PHASE_END(); }
    GRID_BAR();
    PH(8) { if (rep_) GRID_BAR(); PHASE_BEGIN();
    {
        pg8::GroupedOrder<4, false> S{tcnt, tpre, F.G, F.vcu, FF, M, (const char*)F_HID, (const char*)F_W2_t, (size_t)D * FF * 2, F_list};
        pg8::EpiDown E{F_Y2, F_list, tcnt, M};
        pg8::gemm_phase<pg8::EpiDown, pg8::GroupedOrder<4, false>, true, false>(F.lds + RING_OFF, FF, S, E, F.wave);
    }
    PHASE_END(); }
    GRID_BAR();
    PH(9) { if (rep_) GRID_BAR(); PHASE_BEGIN();

    n1_phase<true>(F, 1, nullptr, nullptr);
    PHASE_END(); }
    GRID_BAR();
    PH(10) { if (rep_) GRID_BAR(); PHASE_BEGIN();
    {
        pg8::StaticOrder S; S.init(F_HB, F_Wqkv_t + (size_t)NQKV * D, M, NQKV, D, F.G, (int)blockIdx.x);
        pg8::EpiQKV E{F_QB, (size_t)(WS_K - WS_Q) / 2, C2, F_pos, 0};
        pg8::gemm_phase<pg8::EpiQKV, pg8::StaticOrder, true, false>(F.lds + RING_OFF, D, S, E, F.wave);
    }
    PHASE_END(); }
    GRID_BAR();
    PH(11) { if (rep_) GRID_BAR(); PHASE_BEGIN();
    attn_body::sb_attn_phase((char*)lds + RING_OFF, (const attn_body::bf16*)F_QB, (const attn_body::bf16*)F_KB, (const attn_body::bf16*)F_VB, (attn_body::bf16*)F_out, F.G, F.vcu, F.wave);
    PHASE_END(); }
    GRID_BAR();
    PH(12) { if (rep_) GRID_BAR(); PHASE_BEGIN();
    {
        pg8::StaticOrder S; S.init((const bf16*)F_out, F_Wo_t + (size_t)D * D, M, D, D, F.G, (int)blockIdx.x);
        pg8::EpiPlain E{F_QB, D};
        pg8::gemm_phase<pg8::EpiPlain, pg8::StaticOrder, true, false>(F.lds + RING_OFF, D, S, E, F.wave);
    }
    PHASE_END(); }
    GRID_BAR();
    PH(13) { if (rep_) GRID_BAR(); PHASE_BEGIN();
    n2_phase<true>(F, 1, nullptr, rep_ ? 3 : 1);
    PHASE_END(); }
    GRID_BAR();
    PH(14) { if (rep_) GRID_BAR(); PHASE_BEGIN();
    load_counts(F, 1);
    {
        pg8::GroupedOrder<4, true> S{tcnt, tpre, F.G, F.vcu, D, M, (const char*)F_HB, (const char*)(F_W1_t + (size_t)NE * 2 * FF * D), (size_t)2 * FF * D * 2, F_list};
        pg8::EpiSwiGLU E{F_HID};
        pg8::gemm_phase<pg8::EpiSwiGLU, pg8::GroupedOrder<4, true>, true, true>(F.lds + RING_OFF, D, S, E, F.wave);
    }
    PHASE_END(); }
    GRID_BAR();
    PH(15) { if (rep_) GRID_BAR(); PHASE_BEGIN();
    {
        pg8::GroupedOrder<4, false> S{tcnt, tpre, F.G, F.vcu, FF, M, (const char*)F_HID, (const char*)(F_W2_t + (size_t)NE * D * FF), (size_t)D * FF * 2, F_list};
        pg8::EpiDown E{F_Y2, F_list, tcnt, M};
        pg8::gemm_phase<pg8::EpiDown, pg8::GroupedOrder<4, false>, true, false>(F.lds + RING_OFF, FF, S, E, F.wave);
    }
    PHASE_END(); }
    GRID_BAR();
    PH(16) { if (rep_) GRID_BAR(); PHASE_BEGIN();
    final_phase(F, nullptr, F_out);

    }
    if (STAMP_PH >= 0 && blockIdx.x == STAMP_BLK && F.wave == 0 && lane_id_() == 0) { const unsigned long long tend = rt(); if (STAMP_PH == 16 || STAMP_PH == 100) tsb_ = tend;
        const unsigned long long need = (unsigned long long)STAMP_AMP * (tsb_ - tsa_); while (rt() - tend < need) __builtin_amdgcn_s_sleep(8); }
#undef GRID_BAR
}

extern "C" void kernel_launch(void* const* d_in, const int* in_sizes, int n_in, void* d_out, int out_size, void* d_ws, size_t ws_size, hipStream_t stream) {
    static int grid = 0;
    if (grid == 0) {
        if (n_in != 16 || in_sizes[0] != M * D || out_size != M * D || ws_size < WS_END) { fprintf(stderr, "kernel_launch: built for 16 inputs, x and out of %d floats, >= %zu bytes of workspace; got n_in %d, in0 %d, out %d, ws %zu; nothing launched\n", M * D, (size_t)WS_END, n_in, n_in > 0 ? in_sizes[0] : -1, out_size, ws_size); grid = -1; return; }
        int dev = 0, cus = 0, per_cu = 0;
        if (hipGetDevice(&dev) != hipSuccess || hipDeviceGetAttribute(&cus, hipDeviceAttributeMultiprocessorCount, dev) != hipSuccess) { fprintf(stderr, "kernel_launch: hipGetDevice / hipDeviceGetAttribute failed\n"); grid = -1; return; }
        if (hipFuncSetAttribute((const void*)fwd_kernel, hipFuncAttributeMaxDynamicSharedMemorySize, LDS_BYTES) != hipSuccess) { fprintf(stderr, "kernel_launch: hipFuncSetAttribute failed\n"); grid = -1; return; }
        if (hipOccupancyMaxActiveBlocksPerMultiprocessor(&per_cu, (const void*)fwd_kernel, NWAVES * 64, LDS_BYTES) != hipSuccess || per_cu < 1) { fprintf(stderr, "kernel_launch: occupancy query reports %d workgroups per CU\n", per_cu); }
        (void)hipGetLastError();
        grid = cus;
        if (grid > 256) grid = 256;
        grid -= grid % 8;
    }
    if (grid <= 0) return;
    if (hipMemsetAsync((char*)d_ws + WS_CTL, 0, CTL_ZERO_BYTES, stream) != hipSuccess) { fprintf(stderr, "kernel_launch: hipMemsetAsync failed\n"); return; }
    Args a{};
    for (int i = 0; i < 16; ++i) a.in[i] = d_in[i];
    a.out = (float*)d_out; a.ws = (unsigned char*)d_ws;
    hipLaunchKernelGGL(fwd_kernel, dim3(grid), dim3(NWAVES * 64), LDS_BYTES, stream, a);
    const hipError_t le = hipPeekAtLastError();
    if (le != hipSuccess) fprintf(stderr, "kernel_launch: launch failed: %s\n", hipGetErrorName(le));
}
```

```cpp
#include <hip/hip_runtime.h>
#include <hip/hip_bf16.h>
#include <cstdio>
#include <cstdint>
#include <cmath>
__device__ __forceinline__ int lane_id_() { int r; asm volatile("v_mbcnt_lo_u32_b32 %0, -1, 0\n\tv_mbcnt_hi_u32_b32 %0, -1, %0" : "=v"(r)); return r; }
namespace pg8 {
#define PG8_LAS __attribute__((address_space(3)))
typedef unsigned short bf16_t;
typedef short bf16x8 __attribute__((ext_vector_type(8)));
typedef float f32x4 __attribute__((ext_vector_type(4)));
typedef unsigned u32x4 __attribute__((ext_vector_type(4)));
constexpr int BM = 256, BK = 64, HALF = 128, HTB = HALF * BK * 2  , STAGE_BYTES = 8 * HTB, NXCD = 8, WGM = 8;

__host__ __device__ __forceinline__ int lds_byte(int r, int c) { const int st = (r >> 4) * 2 + (c >> 5), rr = r & 15, cc = c & 31, ob = rr * 64 + cc * 2; return st * 1024 + (ob ^ (((ob >> 9) & 1) << 5)); }
__host__ __device__ __forceinline__ void stage_rc(int b, int& R, int& C) { const int st = b / 1024, sb = b % 1024, swz = sb ^ (((sb >> 9) & 1) << 5); R = (st >> 1) * 16 + swz / 64; C = (st & 1) * 32 + (swz % 64) / 2; }
__host__ __device__ __forceinline__ int perm32(int rho) { const int n = rho >> 4, i = rho & 15; return 8 * (i >> 2) + 4 * n + (i & 3); }


struct Unit { int pm, pn, e, rb; };

struct StaticOrder {
    int nM, nN, nwg, G, c; const char* A; const char* Bt; int K;
    __device__ void init(const void* A_, const void* Bt_, int M, int N, int K_, int G_, int c_) { A = (const char*)A_; Bt = (const char*)Bt_; K = K_; nM = M / BM; nN = N / BM; nwg = nM * nN; G = G_; c = c_; }
    __device__ bool next(int i, Unit& u) const {
        const long L = (long)i * G + c; if (L >= nwg) return false;
        int wgid = (int)L; { const int q = nwg / NXCD, r = nwg % NXCD, xcd = wgid % NXCD, off = wgid / NXCD; wgid = (xcd < r ? xcd * (q + 1) : r * (q + 1) + (xcd - r) * q) + off; }
        const int nig = WGM * nN, gid = wgid / nig, fm = gid * WGM, gsz = (nM - fm) < WGM ? (nM - fm) : WGM;
        u.pm = fm + ((wgid % nig) % gsz); u.pn = (wgid % nig) / gsz; u.e = 0; u.rb = 0; return true;
    }
    __device__ __forceinline__ const char* a_ptr(const Unit& u) const { return A + (size_t)u.pm * ((size_t)BM * K * 2); }
    __device__ __forceinline__ const char* b_ptr(const Unit& u) const { return Bt + (size_t)u.pn * ((size_t)BM * K * 2); }
    __device__ __forceinline__ unsigned a_rowoff(const Unit&, int R) const { return (unsigned)R * (unsigned)K * 2u; }
};
template <int NPN, bool GATHER_> struct GroupedOrder {
    const PG8_LAS int* cnt; const PG8_LAS int* pre; int G, vc, K, Mtok;
    const char* A; const char* W; size_t wstride; const int* list;
    __device__ bool next(int i, Unit& u) const {
        const int total = pre[32] * NPN; const int L = i * G + vc; if (L >= total) return false;
        const int rbg = L / NPN;
        const int ln = lane_id_() & 31; const int pj = pre[ln];
        const unsigned bal = (unsigned)__builtin_amdgcn_ballot_w64(ln >= 1 && pj <= rbg);
        int e = __builtin_popcount(bal);
        e = __builtin_amdgcn_readfirstlane(e); const int rb = __builtin_amdgcn_readfirstlane(rbg - pre[e]);
        u.e = e; u.rb = rb; u.pm = __builtin_amdgcn_readfirstlane(rbg); u.pn = __builtin_amdgcn_readfirstlane(L % NPN); return true;
    }
    __device__ __forceinline__ const char* a_ptr(const Unit& u) const { return GATHER_ ? A : A + (size_t)u.pm * ((size_t)BM * K * 2); }
    __device__ __forceinline__ const char* b_ptr(const Unit& u) const { return W + (size_t)u.e * wstride + (size_t)u.pn * ((size_t)BM * K * 2); }
    __device__ __forceinline__ unsigned a_rowoff(const Unit& u, int R) const {
        if (!GATHER_) return (unsigned)R * (unsigned)K * 2u;
        const int idx = u.rb * BM + R; const int v = list[(size_t)u.e * Mtok + idx]; const int tok = (idx < cnt[u.e]) ? (v >> 1) : 0;
        return (unsigned)tok * (unsigned)K * 2u;
    }
};

__device__ __forceinline__ unsigned cvt_pk_bf16(float lo, float hi) { unsigned r; asm volatile("v_cvt_pk_bf16_f32 %0, %1, %2" : "=v"(r) : "v"(lo), "v"(hi)); return r; }
typedef float f32x2 __attribute__((ext_vector_type(2)));
__device__ __forceinline__ void sincos_rad(float ang, float& s, float& c) {
    double r = (double)ang * 0.15915494309189535; r = r - __builtin_floor(r);
    const float rf = (float)r; s = __builtin_amdgcn_sinf(rf); c = __builtin_amdgcn_cosf(rf);
}
struct EpiQKV {
    static constexpr bool PERM = true, AFTER_DRAIN = false, HAS_META = false, BALANCED = true;
    bf16_t* O; size_t split_stride; float scale0; const int* pos; int rope;
    __device__ __forceinline__ void operator()(const f32x4 (&acc)[2][2][4][2], const Unit& u, int wr, int wc, int fr, int fq) const {
        int dd[8]; { const int* pp = pos + u.pm * BM + wr * 64 + fr;
#pragma unroll
            for (int ai = 0; ai < 2; ++ai)
#pragma unroll
                for (int m = 0; m < 4; ++m) dd[ai * 4 + m] = pp[ai * HALF + m * 16]; }
        const int t = u.pn >> 2; bf16_t* base = O + (size_t)t * split_stride;
        const float sc = (t == 0) ? scale0 : 1.f;
        const int row0 = u.pm * BM + wr * 64 + fr, col0 = (u.pn & 3) * BM + wc * 32 + 8 * fq;
        const bool dorope = rope && t < 2 && (wc & 1) == 0 && fq < 2;
        const float f0 = fq ? 0.0014142135623842478f : 1.0f, f1 = fq ? 0.00027424818836152554f : 0.1939227432012558f,
                    f2 = fq ? 5.318296098266728e-05f : 0.03760603070259094f, f3 = fq ? 1.0313386155758053e-05f : 0.007292664609849453f;
#pragma unroll
        for (int ai = 0; ai < 2; ++ai)
#pragma unroll
            for (int m = 0; m < 4; ++m) { const int row = row0 + ai * HALF + m * 16; bf16_t* rowp = base + (size_t)row * 1024 + col0;
                float s0 = 0.f, s1 = 0.f, s2 = 0.f, s3 = 0.f, c0 = 1.f, c1 = 1.f, c2 = 1.f, c3 = 1.f;
                if (dorope) { const float p = (float)dd[ai * 4 + m]; sincos_rad(p * f0, s0, c0); sincos_rad(p * f1, s1, c1); sincos_rad(p * f2, s2, c2); sincos_rad(p * f3, s3, c3); }
#pragma unroll
                for (int bj = 0; bj < 2; ++bj) { f32x4 v0 = acc[ai][bj][m][0], v1 = acc[ai][bj][m][1];
                    { const float a0 = v0[0], b0 = v0[1], a1 = v0[2], b1 = v0[3], a2 = v1[0], b2 = v1[1], a3 = v1[2], b3 = v1[3];
                      v0[0] = a0 * c0 - b0 * s0; v0[1] = b0 * c0 + a0 * s0; v0[2] = a1 * c1 - b1 * s1; v0[3] = b1 * c1 + a1 * s1;
                      v1[0] = a2 * c2 - b2 * s2; v1[1] = b2 * c2 + a2 * s2; v1[2] = a3 * c3 - b3 * s3; v1[3] = b3 * c3 + a3 * s3; }
                    v0 = v0 * sc; v1 = v1 * sc; u32x4 w; w.x = cvt_pk_bf16(v0[0], v0[1]); w.y = cvt_pk_bf16(v0[2], v0[3]); w.z = cvt_pk_bf16(v1[0], v1[1]); w.w = cvt_pk_bf16(v1[2], v1[3]);
                    *(u32x4*)(rowp + bj * HALF) = w; } }
    }
};
struct EpiPlain {
    static constexpr bool PERM = true, AFTER_DRAIN = false, HAS_META = false, BALANCED = true;
    bf16_t* O; int ldc;
    __device__ __forceinline__ void operator()(const f32x4 (&acc)[2][2][4][2], const Unit& u, int wr, int wc, int fr, int fq) const {
        const int row0 = u.pm * BM + wr * 64 + fr, col0 = u.pn * BM + wc * 32 + 8 * fq;
#pragma unroll
        for (int ai = 0; ai < 2; ++ai)
#pragma unroll
            for (int m = 0; m < 4; ++m) { bf16_t* rowp = O + (size_t)(row0 + ai * HALF + m * 16) * ldc + col0;
#pragma unroll
                for (int bj = 0; bj < 2; ++bj) { const f32x4 v0 = acc[ai][bj][m][0], v1 = acc[ai][bj][m][1];
                    u32x4 w; w.x = cvt_pk_bf16(v0[0], v0[1]); w.y = cvt_pk_bf16(v0[2], v0[3]); w.z = cvt_pk_bf16(v1[0], v1[1]); w.w = cvt_pk_bf16(v1[2], v1[3]);
                    *(u32x4*)(rowp + bj * HALF) = w; } }
    }
};
template <bool XF32> struct EpiResid {
    static constexpr bool PERM = true, AFTER_DRAIN = false, HAS_META = false, BALANCED = true;
    bf16_t* XO; const float* xf; const float* ga; int Tn;
    __device__ __forceinline__ void operator()(const f32x4 (&acc)[2][2][4][2], const Unit& u, int wr, int wc, int fr, int fq) const {
        const int row0 = u.pm * BM + wr * 64 + fr, col0 = u.pn * BM + wc * 32 + 8 * fq; const int b = (u.pm * BM) / Tn;
        const float* gp = ga + (size_t)b * 6144 + col0;
        f32x4 g[2][2];
#pragma unroll
        for (int bj = 0; bj < 2; ++bj)
#pragma unroll
            for (int n = 0; n < 2; ++n) g[bj][n] = *(const f32x4*)(gp + bj * HALF + 4 * n);
        if constexpr (XF32) {
#pragma unroll
            for (int ai = 0; ai < 2; ++ai)
#pragma unroll
                for (int mh = 0; mh < 2; ++mh) { f32x4 xv[2][2][2];
#pragma unroll
                    for (int mi = 0; mi < 2; ++mi)
#pragma unroll
                        for (int bj = 0; bj < 2; ++bj)
#pragma unroll
                            for (int n = 0; n < 2; ++n) xv[mi][bj][n] = *(const f32x4*)(xf + (size_t)(row0 + ai * HALF + (2 * mh + mi) * 16) * 1024 + col0 + bj * HALF + 4 * n);
#pragma unroll
                    for (int mi = 0; mi < 2; ++mi) { const int m = 2 * mh + mi; bf16_t* rowp = XO + (size_t)(row0 + ai * HALF + m * 16) * 1024 + col0;
#pragma unroll
                        for (int bj = 0; bj < 2; ++bj) { const f32x4 v0 = xv[mi][bj][0] + g[bj][0] * acc[ai][bj][m][0], v1 = xv[mi][bj][1] + g[bj][1] * acc[ai][bj][m][1];
                            u32x4 w; w.x = cvt_pk_bf16(v0[0], v0[1]); w.y = cvt_pk_bf16(v0[2], v0[3]); w.z = cvt_pk_bf16(v1[0], v1[1]); w.w = cvt_pk_bf16(v1[2], v1[3]);
                            *(u32x4*)(rowp + bj * HALF) = w; } } }
        } else {
#pragma unroll
            for (int ai = 0; ai < 2; ++ai) { u32x4 xr[4][2];
#pragma unroll
                for (int m = 0; m < 4; ++m)
#pragma unroll
                    for (int bj = 0; bj < 2; ++bj) xr[m][bj] = *(const u32x4*)(XO + (size_t)(row0 + ai * HALF + m * 16) * 1024 + col0 + bj * HALF);
#pragma unroll
                for (int m = 0; m < 4; ++m) { bf16_t* rowp = XO + (size_t)(row0 + ai * HALF + m * 16) * 1024 + col0;
#pragma unroll
                    for (int bj = 0; bj < 2; ++bj) { const u32x4 x = xr[m][bj];
                        const f32x4 x0 = {__uint_as_float(x.x << 16), __uint_as_float(x.x & 0xffff0000u), __uint_as_float(x.y << 16), __uint_as_float(x.y & 0xffff0000u)},
                                    x1 = {__uint_as_float(x.z << 16), __uint_as_float(x.z & 0xffff0000u), __uint_as_float(x.w << 16), __uint_as_float(x.w & 0xffff0000u)};
                        const f32x4 v0 = x0 + g[bj][0] * acc[ai][bj][m][0], v1 = x1 + g[bj][1] * acc[ai][bj][m][1];
                        u32x4 w; w.x = cvt_pk_bf16(v0[0], v0[1]); w.y = cvt_pk_bf16(v0[2], v0[3]); w.z = cvt_pk_bf16(v1[0], v1[1]); w.w = cvt_pk_bf16(v1[2], v1[3]);
                        *(u32x4*)(rowp + bj * HALF) = w; } } }
        }
    }
};
__device__ __forceinline__ float silu_mul(float g, float u) { return g * u * __builtin_amdgcn_rcpf(1.0f + __builtin_amdgcn_exp2f(-1.4426950408889634f * g)); }
struct EpiSwiGLU {
    static constexpr bool PERM = true, AFTER_DRAIN = false, HAS_META = false, BALANCED = false;
    bf16_t* hid;
    __device__ __forceinline__ void operator()(const f32x4 (&acc)[2][2][4][2], const Unit& u, int wr, int wc, int fr, int fq) const {
        const int row0 = u.pm * BM + wr * 64 + fr, col0 = u.pn * HALF + wc * 32 + 8 * fq;
#pragma unroll
        for (int ai = 0; ai < 2; ++ai)
#pragma unroll
            for (int m = 0; m < 4; ++m) { const f32x4 g0 = acc[ai][0][m][0], g1 = acc[ai][0][m][1], u0 = acc[ai][1][m][0], u1 = acc[ai][1][m][1];
                u32x4 w; w.x = cvt_pk_bf16(silu_mul(g0[0], u0[0]), silu_mul(g0[1], u0[1])); w.y = cvt_pk_bf16(silu_mul(g0[2], u0[2]), silu_mul(g0[3], u0[3]));
                w.z = cvt_pk_bf16(silu_mul(g1[0], u1[0]), silu_mul(g1[1], u1[1])); w.w = cvt_pk_bf16(silu_mul(g1[2], u1[2]), silu_mul(g1[3], u1[3]));
                *(u32x4*)(hid + (size_t)(row0 + ai * HALF + m * 16) * 512 + col0) = w; }
    }
};
struct EpiDown {
    static constexpr bool PERM = true, AFTER_DRAIN = false, HAS_META = true, BALANCED = false;
    bf16_t* y2; const int* list; const PG8_LAS int* cnt; int Mtok;
    __device__ __forceinline__ void prefetch(int (&dd)[8], const Unit& u, int wr, int fr) const {
        const int nvalid = cnt[u.e] - u.rb * BM; const int* lp = list + (size_t)u.e * Mtok + u.rb * BM;
#pragma unroll
        for (int ai = 0; ai < 2; ++ai)
#pragma unroll
            for (int m = 0; m < 4; ++m) { const int r = ai * HALF + wr * 64 + m * 16 + fr; dd[ai * 4 + m] = (r < nvalid) ? lp[r] : -1; }
    }
    __device__ __forceinline__ void operator()(const f32x4 (&acc)[2][2][4][2], const Unit& u, int wr, int wc, int fr, int fq, const int (&dd)[8]) const {
        const int col0 = u.pn * BM + wc * 32 + 8 * fq;
#pragma unroll
        for (int ai = 0; ai < 2; ++ai)
#pragma unroll
            for (int m = 0; m < 4; ++m) if (dd[ai * 4 + m] >= 0) { bf16_t* rowp = y2 + (size_t)dd[ai * 4 + m] * 1024 + col0;
#pragma unroll
                for (int bj = 0; bj < 2; ++bj) { const f32x4 v0 = acc[ai][bj][m][0], v1 = acc[ai][bj][m][1];
                    u32x4 w; w.x = cvt_pk_bf16(v0[0], v0[1]); w.y = cvt_pk_bf16(v0[2], v0[3]); w.z = cvt_pk_bf16(v1[0], v1[1]); w.w = cvt_pk_bf16(v1[2], v1[3]);
                    *(u32x4*)(rowp + bj * HALF) = w; } }
    }
};

template <class Epi, class Sched, bool ALIGN_EPI, bool GATHER>
__device__ __forceinline__ void gemm_phase(PG8_LAS unsigned char* lds, const int K, const Sched& S, const Epi& E, const int wv) {
    int tid_ = wv * 64 + lane_id_(); asm volatile("" : "+v"(tid_));
    const int tid = tid_, wid = __builtin_amdgcn_readfirstlane(tid >> 6), lane = tid & 63, wr = wid >> 2, wc = wid & 3, fr = lane & 15, fq = lane >> 4;
    const int nt = K / BK;
    constexpr bool BAL = !GATHER && Epi::BALANCED;
    unsigned vA0[2], vA1[2], nA0[2], nA1[2], voffB[2];
#pragma unroll
    for (int i = 0; i < 2; ++i) { int R, C; stage_rc(tid * 16 + i * 8192, R, C); const int Rb = Epi::PERM ? ((R & ~31) + perm32(R & 31)) : R;
        voffB[i] = (unsigned)(Rb * K + C) * 2u; }
    const size_t kstep = (size_t)(BK * 2);
    const size_t hstep = (size_t)HALF * K * 2;
    const unsigned ldsw = (unsigned)wid * 1024u;
    const int aoff = lds_byte(wr * 64 + fr, fq * 8), boff = lds_byte(wc * 32 + fr, fq * 8);
#define PG8_SA(b, h) (((b) * 2 + (h)) * HTB)
#define PG8_SB(b, h) ((4 + (b) * 2 + (h)) * HTB)
#define PG8_STAGE(bufoff, gbase, voff) do { _Pragma("unroll") for (int _i = 0; _i < 2; ++_i) \
        __builtin_amdgcn_global_load_lds((const unsigned*)((const char*)(gbase) + (voff)[_i]), (PG8_LAS unsigned*)(lds + (bufoff) + ldsw + _i * 8192), 16, 0, 0); } while (0)
#define PG8_LDA(dst, b, h) do { _Pragma("unroll") for (int m = 0; m < 4; ++m) _Pragma("unroll") for (int k = 0; k < 2; ++k) dst[m][k] = *(const PG8_LAS bf16x8*)(lds + PG8_SA(b, h) + aoff + m * 2048 + k * 1024); } while (0)
#define PG8_LDB(dst, b, h) do { _Pragma("unroll") for (int n = 0; n < 2; ++n) _Pragma("unroll") for (int k = 0; k < 2; ++k) dst[n][k] = *(const PG8_LAS bf16x8*)(lds + PG8_SB(b, h) + boff + n * 2048 + k * 1024); } while (0)
#define PG8_MMA(ai, bj, At, Bt) do { __builtin_amdgcn_s_setprio(1); _Pragma("unroll") for (int m = 0; m < 4; ++m) _Pragma("unroll") for (int n = 0; n < 2; ++n) _Pragma("unroll") for (int k = 0; k < 2; ++k) \
        acc[ai][bj][m][n] = __builtin_amdgcn_mfma_f32_16x16x32_bf16(Bt[n][k], At[m][k], acc[ai][bj][m][n], 0, 0, 0); __builtin_amdgcn_s_setprio(0); } while (0)
#define PG8_WAIT_V(n) asm volatile("s_waitcnt vmcnt(" #n ")" ::: "memory")
#define PG8_WAIT_L(n) asm volatile("s_waitcnt lgkmcnt(" #n ")" ::: "memory")
#define PG8_BAR __builtin_amdgcn_s_barrier()
#define PG8_SCHED __builtin_amdgcn_sched_barrier(0)
#define PG8_AOFFS(u, d0, d1) do { int t_ = tid; asm volatile("" : "+v"(t_));   \
        _Pragma("unroll") for (int _i = 0; _i < 2; ++_i) { int R_, C_; stage_rc(t_ * 16 + _i * 8192, R_, C_); d0[_i] = S.a_rowoff(u, R_) + (unsigned)(C_ * 2); d1[_i] = S.a_rowoff(u, HALF + R_) + (unsigned)(C_ * 2); } } while (0)
    Unit cur, nxt; int ui = 0;
    if (!S.next(0, cur)) return;
    f32x4 acc[2][2][4][2];
#pragma unroll
    for (int a = 0; a < 2; ++a)
#pragma unroll
        for (int b = 0; b < 2; ++b)
#pragma unroll
            for (int m = 0; m < 4; ++m)
#pragma unroll
                for (int n = 0; n < 2; ++n) acc[a][b][m][n] = (f32x4){0.f, 0.f, 0.f, 0.f};
    bf16x8 At[4][2], B0[2][2], B1[2][2]; int meta[8];
    const char* cA = S.a_ptr(cur); const char* cB = S.b_ptr(cur);
    PG8_AOFFS(cur, vA0, vA1);
    {
        PG8_STAGE(PG8_SB(0, 0), cB, voffB); PG8_STAGE(PG8_SB(0, 1), cB + hstep, voffB); PG8_STAGE(PG8_SA(0, 0), cA, vA0); PG8_STAGE(PG8_SA(0, 1), cA, vA1);
        if (wr == 1) PG8_BAR;
        PG8_WAIT_V(2); PG8_BAR;
        PG8_STAGE(PG8_SB(1, 0), cB + kstep, voffB); PG8_STAGE(PG8_SA(1, 0), cA + kstep, vA0); if constexpr (!BAL) PG8_STAGE(PG8_SB(1, 1), cB + hstep + kstep, voffB);
        if constexpr (!BAL) PG8_WAIT_V(6); else PG8_WAIT_V(4);
        PG8_BAR;
    }
    for (;;) {
        const bool has_next = S.next(ui + 1, nxt);
        if constexpr (Epi::HAS_META) E.prefetch(meta, cur, wr, fr);
        const char* nA = has_next ? S.a_ptr(nxt) : cA; const char* nB = has_next ? S.b_ptr(nxt) : cB;
        if constexpr (GATHER) { if (has_next) { PG8_AOFFS(nxt, nA0, nA1); } else {
#pragma unroll
            for (int _i = 0; _i < 2; ++_i) { nA0[_i] = vA0[_i]; nA1[_i] = vA1[_i]; } } }
        for (int t = 0; t < nt; t += 2) {
            const bool last = (t == nt - 2);
            const char* a1 = cA + (size_t)(t + 1) * kstep;
            const char* a2 = last ? nA : cA + (size_t)(t + 2) * kstep; const char* b2 = last ? nB : cB + (size_t)(t + 2) * kstep;
            const char* a3 = a2 + kstep; const char* b3 = b2 + kstep;
            if constexpr (BAL) {
            const char* b1 = cB + (size_t)(t + 1) * kstep;
            PG8_LDB(B0, 0, 0); PG8_LDB(B1, 0, 1); PG8_SCHED; PG8_LDA(At, 0, 0); PG8_STAGE(PG8_SB(1, 1), b1 + hstep, voffB); PG8_STAGE(PG8_SA(1, 1), a1, vA1);
            if constexpr (GATHER) { if (last) {
#pragma unroll
                for (int _i = 0; _i < 2; ++_i) { vA0[_i] = nA0[_i]; vA1[_i] = nA1[_i]; } } }
            PG8_WAIT_V(8); PG8_WAIT_L(0); PG8_BAR; PG8_MMA(0, 0, At, B0); PG8_MMA(0, 1, At, B1); PG8_BAR; PG8_SCHED;
            PG8_LDA(At, 0, 1); PG8_STAGE(PG8_SB(0, 0), b2, voffB); PG8_STAGE(PG8_SA(0, 0), a2, vA0);
            PG8_WAIT_V(6); PG8_WAIT_L(0); PG8_BAR; PG8_MMA(1, 0, At, B0); PG8_MMA(1, 1, At, B1); PG8_BAR; PG8_SCHED;
            PG8_LDB(B0, 1, 0); PG8_LDB(B1, 1, 1); PG8_SCHED; PG8_LDA(At, 1, 0); PG8_STAGE(PG8_SB(0, 1), b2 + hstep, voffB); PG8_STAGE(PG8_SA(0, 1), a2, vA1);
            PG8_WAIT_V(8); PG8_WAIT_L(0); PG8_BAR; PG8_MMA(0, 0, At, B0); PG8_MMA(0, 1, At, B1); PG8_BAR; PG8_SCHED;
            PG8_LDA(At, 1, 1); PG8_STAGE(PG8_SB(1, 0), b3, voffB); PG8_STAGE(PG8_SA(1, 0), a3, vA0);
            PG8_WAIT_V(6); PG8_WAIT_L(0); PG8_BAR; PG8_MMA(1, 0, At, B0); PG8_MMA(1, 1, At, B1); PG8_BAR; PG8_SCHED;
            } else {
            PG8_LDB(B0, 0, 0); PG8_LDB(B1, 0, 1); PG8_SCHED; PG8_LDA(At, 0, 0); PG8_STAGE(PG8_SA(1, 1), a1, vA1);
            if constexpr (GATHER) { if (last) {
#pragma unroll
                for (int _i = 0; _i < 2; ++_i) { vA0[_i] = nA0[_i]; vA1[_i] = nA1[_i]; } } }
            PG8_WAIT_V(8); PG8_WAIT_L(0); PG8_BAR; PG8_MMA(0, 0, At, B0); PG8_MMA(0, 1, At, B1); PG8_BAR; PG8_SCHED;
            PG8_LDA(At, 0, 1); PG8_STAGE(PG8_SB(0, 0), b2, voffB); PG8_STAGE(PG8_SB(0, 1), b2 + hstep, voffB); PG8_STAGE(PG8_SA(0, 0), a2, vA0);
            PG8_WAIT_V(8); PG8_WAIT_L(0); PG8_BAR; PG8_MMA(1, 0, At, B0); PG8_MMA(1, 1, At, B1); PG8_BAR; PG8_SCHED;
            PG8_LDB(B0, 1, 0); PG8_LDB(B1, 1, 1); PG8_SCHED; PG8_LDA(At, 1, 0); PG8_STAGE(PG8_SA(0, 1), a2, vA1);
            PG8_WAIT_V(8); PG8_WAIT_L(0); PG8_BAR; PG8_MMA(0, 0, At, B0); PG8_MMA(0, 1, At, B1); PG8_BAR; PG8_SCHED;
            PG8_LDA(At, 1, 1); PG8_STAGE(PG8_SB(1, 0), b3, voffB); PG8_STAGE(PG8_SB(1, 1), b3 + hstep, voffB); PG8_STAGE(PG8_SA(1, 0), a3, vA0);
            PG8_WAIT_V(8); PG8_WAIT_L(0); PG8_BAR; PG8_MMA(1, 0, At, B0); PG8_MMA(1, 1, At, B1); PG8_BAR; PG8_SCHED;
            }
        }
        if constexpr (ALIGN_EPI) { if (wr == 0) PG8_BAR; }
        if constexpr (Epi::HAS_META) E(acc, cur, wr, wc, fr, fq, meta); else E(acc, cur, wr, wc, fr, fq);
        if (!has_next) break;
#pragma unroll
        for (int a = 0; a < 2; ++a)
#pragma unroll
            for (int b = 0; b < 2; ++b)
#pragma unroll
                for (int m = 0; m < 4; ++m)
#pragma unroll
                    for (int n = 0; n < 2; ++n) acc[a][b][m][n] = (f32x4){0.f, 0.f, 0.f, 0.f};
        cur = nxt; cA = nA; cB = nB; ++ui;
        if constexpr (ALIGN_EPI) { if (wr == 1) PG8_BAR; }
    }
    PG8_WAIT_V(0);
    if constexpr (!ALIGN_EPI) { if (wr == 0) PG8_BAR; }
    PG8_BAR;
#undef PG8_SA
#undef PG8_SB
#undef PG8_STAGE
#undef PG8_LDA
#undef PG8_LDB
#undef PG8_MMA
#undef PG8_WAIT_V
#undef PG8_WAIT_L
#undef PG8_BAR
#undef PG8_SCHED
#undef PG8_AOFFS
}
}
#include <hip/hip_bf16.h>
#include <cmath>
namespace attn_body {
using bf16=__hip_bfloat16;
using bf16x8=__attribute__((ext_vector_type(8)))short;
using s16x4=__attribute__((ext_vector_type(4)))short;
using f32x16=__attribute__((ext_vector_type(16)))float;
using u32x4=__attribute__((ext_vector_type(4)))unsigned;
constexpr int BATCH=4,NHEAD=16,SEQ=8192,D=64,DM=NHEAD*D;
constexpr int NW=8,QBLK=32,QB=QBLK*NW,KVBLK=64,NQB=SEQ/QB;
constexpr int ATTN_PITCH=DM, ATTN_UNIT_ROWS=QB;
__device__ __forceinline__ int crow(int r,int hi){return (r&3)+8*(r>>2)+4*hi;}
#define SBAR() __builtin_amdgcn_sched_barrier(0)
__device__ __forceinline__ void cmask(f32x16&p0,f32x16&p1,int jb,int qrel,int hi){
  const float NEG=-INFINITY; const int thr=qrel-64*jb-4*hi;
  #pragma unroll
  for(int r=0;r<16;++r){const int kc=(r&3)+8*(r>>2); if(kc>thr)p0[r]=NEG; if(kc+32>thr)p1[r]=NEG;}
}

constexpr int NSLOT=3, SLOTB=8192;
constexpr int LDS_K=0, LDS_V=NSLOT*SLOTB, LDS_WS=2*NSLOT*SLOTB, LDS_OST=LDS_WS+NW*64*4, LDS_BYTES=LDS_OST+NW*4096;
constexpr float C2=0.125f*1.4426950408889634f;
__device__ __forceinline__ void glds16(const void*gsrc,unsigned lds_dst){unsigned keep;
  asm volatile("s_mov_b32 %0, m0\n\ts_mov_b32 m0, %2\n\ts_nop 0\n\tglobal_load_lds_dwordx4 %1, off\n\ts_mov_b32 m0, %0":"=&s"(keep):"v"(gsrc),"s"(lds_dst):"memory");}
__device__ __forceinline__ void glds16s(const void*sbase,unsigned voff,unsigned lds_dst){unsigned keep;
  asm volatile("s_mov_b32 %0, m0\n\ts_mov_b32 m0, %3\n\ts_nop 0\n\tglobal_load_lds_dwordx4 %1, %2\n\ts_mov_b32 m0, %0":"=&s"(keep):"v"(voff),"s"(sbase),"s"(lds_dst):"memory");}
__device__ __forceinline__ float max3f(float a,float b,float c){float r;asm("v_max3_f32 %0, %1, %2, %3":"=v"(r):"v"(a),"v"(b),"v"(c));return r;}
__device__ __forceinline__ float max2f(float a,float b){float r;asm("v_max_f32_e32 %0, %1, %2":"=v"(r):"v"(a),"v"(b));return r;}
__device__ __forceinline__ float fadd_s(float a,float b){float r;asm("v_add_f32_e32 %0, %1, %2":"=v"(r):"v"(a),"v"(b));return r;}
__device__ __forceinline__ float fsub_s(float a,float b){float r;asm("v_sub_f32_e32 %0, %1, %2":"=v"(r):"v"(a),"v"(b));return r;}
typedef float f32x2_t __attribute__((ext_vector_type(2))); typedef __bf16 bf16x2_t __attribute__((ext_vector_type(2)));
__device__ __forceinline__ unsigned cvtpk_s(float lo,float hi){f32x2_t v={lo,hi};bf16x2_t b=__builtin_convertvector(v,bf16x2_t);return __builtin_bit_cast(unsigned,b);}
#define WAIT_BAR(N) asm volatile("s_waitcnt vmcnt(" #N ") lgkmcnt(0)\n\ts_barrier":::"memory")

__device__ __forceinline__ void qkt(f32x16&p0,f32x16&p1,const char*Kslot,const bf16x8*qr,const f32x16&negm,int r32,int hi){
  const char*kb=Kslot+hi*1024+r32*16;
  #pragma unroll
  for(int d0=0;d0<4;++d0){
    const bf16x8 b0=*reinterpret_cast<const bf16x8*>(kb+d0*2048);
    const bf16x8 b1=*reinterpret_cast<const bf16x8*>(kb+d0*2048+512);
    if(d0==0){p0=__builtin_amdgcn_mfma_f32_32x32x16_bf16(b0,qr[0],negm,0,0,0);p1=__builtin_amdgcn_mfma_f32_32x32x16_bf16(b1,qr[0],negm,0,0,0);}
    else{p0=__builtin_amdgcn_mfma_f32_32x32x16_bf16(b0,qr[d0],p0,0,0,0);p1=__builtin_amdgcn_mfma_f32_32x32x16_bf16(b1,qr[d0],p1,0,0,0);}}
}
typedef __attribute__((address_space(3))) const char* lds_cptr;
typedef short v4i16_t __attribute__((ext_vector_type(4)));
__device__ __forceinline__ void kload8(bf16x8*kf,lds_cptr kp){
  kf[0]=*(const __attribute__((address_space(3))) bf16x8*)(kp);      kf[1]=*(const __attribute__((address_space(3))) bf16x8*)(kp+512);
  kf[2]=*(const __attribute__((address_space(3))) bf16x8*)(kp+2048); kf[3]=*(const __attribute__((address_space(3))) bf16x8*)(kp+2560);
  kf[4]=*(const __attribute__((address_space(3))) bf16x8*)(kp+4096); kf[5]=*(const __attribute__((address_space(3))) bf16x8*)(kp+4608);
  kf[6]=*(const __attribute__((address_space(3))) bf16x8*)(kp+6144); kf[7]=*(const __attribute__((address_space(3))) bf16x8*)(kp+6656);
}
__device__ __forceinline__ void kload2(bf16x8*kf,lds_cptr kp,int j){ kf[2*j]=*(const __attribute__((address_space(3))) bf16x8*)(kp+j*2048); kf[2*j+1]=*(const __attribute__((address_space(3))) bf16x8*)(kp+j*2048+512); }
__device__ __forceinline__ s16x4 vtr(lds_cptr p){ return __builtin_bit_cast(s16x4,__builtin_amdgcn_ds_read_tr16_b64_v4i16((__attribute__((address_space(3))) v4i16_t*)p)); }
__device__ __forceinline__ float rowmax(const f32x16&p0,const f32x16&p1){
  float a=max3f(p0[0],p0[1],p1[0]),b=max3f(p0[2],p0[3],p1[1]);a=max3f(a,p1[2],p1[3]);
  #pragma unroll
  for(int r=4;r<16;r+=4){a=max3f(a,p0[r],p0[r+1]);b=max3f(b,p0[r+2],p0[r+3]);a=max3f(a,p1[r],p1[r+1]);b=max3f(b,p1[r+2],p1[r+3]);}
  const float m=max2f(a,b);
  auto rr=__builtin_amdgcn_permlane32_swap(__float_as_uint(m),__float_as_uint(m),false,false);
  return max2f(__uint_as_float(rr[0]),__uint_as_float(rr[1]));
}
__device__ __forceinline__ void pv(f32x16*o,int vb,bf16x8 pa0,bf16x8 pa1,bf16x8 pa2,bf16x8 pa3){
  #pragma unroll
  for(int d0=0;d0<2;++d0){s16x4 lo[4],hi[4];
    #pragma unroll
    for(int ks=0;ks<4;++ks){
      asm volatile("ds_read_b64_tr_b16 %0,%1 offset:%c2":"=&v"(lo[ks]):"v"(vb),"i"(d0*4096+ks*1024):"memory");
      asm volatile("ds_read_b64_tr_b16 %0,%1 offset:%c2":"=&v"(hi[ks]):"v"(vb),"i"(d0*4096+ks*1024+512):"memory");}
    asm volatile("s_waitcnt lgkmcnt(0)":::"memory");SBAR();
    #define PK(k) (bf16x8){lo[k][0],lo[k][1],lo[k][2],lo[k][3],hi[k][0],hi[k][1],hi[k][2],hi[k][3]}
    o[d0]=__builtin_amdgcn_mfma_f32_32x32x16_bf16(pa0,PK(0),o[d0],0,0,0);
    o[d0]=__builtin_amdgcn_mfma_f32_32x32x16_bf16(pa1,PK(1),o[d0],0,0,0);
    o[d0]=__builtin_amdgcn_mfma_f32_32x32x16_bf16(pa2,PK(2),o[d0],0,0,0);
    o[d0]=__builtin_amdgcn_mfma_f32_32x32x16_bf16(pa3,PK(3),o[d0],0,0,0);
    #undef PK
  }
}

#ifndef ATTN_STORE16
#define ATTN_STORE16(p,v) (*(u32x4*)(p)=(v))
#endif
constexpr int LDS2_WS=LDS_V+NSLOT*2*SLOTB, LDS2_OST=LDS2_WS+NW*64*4, LDS2_BYTES=LDS2_OST+NW*4096;
__device__ __forceinline__ void pv4(f32x16*o,int vb,bf16x8 pa0,bf16x8 pa1,bf16x8 pa2,bf16x8 pa3){
  #pragma unroll
  for(int d0=0;d0<4;++d0){s16x4 lo[4],hi[4];
    #pragma unroll
    for(int ks=0;ks<4;++ks){
      asm volatile("ds_read_b64_tr_b16 %0,%1 offset:%c2":"=&v"(lo[ks]):"v"(vb),"i"(d0*4096+ks*1024):"memory");
      asm volatile("ds_read_b64_tr_b16 %0,%1 offset:%c2":"=&v"(hi[ks]):"v"(vb),"i"(d0*4096+ks*1024+512):"memory");}
    asm volatile("s_waitcnt lgkmcnt(0)":::"memory");SBAR();
    #define PK(k) (bf16x8){lo[k][0],lo[k][1],lo[k][2],lo[k][3],hi[k][0],hi[k][1],hi[k][2],hi[k][3]}
    o[d0]=__builtin_amdgcn_mfma_f32_32x32x16_bf16(pa0,PK(0),o[d0],0,0,0);
    o[d0]=__builtin_amdgcn_mfma_f32_32x32x16_bf16(pa1,PK(1),o[d0],0,0,0);
    o[d0]=__builtin_amdgcn_mfma_f32_32x32x16_bf16(pa2,PK(2),o[d0],0,0,0);
    o[d0]=__builtin_amdgcn_mfma_f32_32x32x16_bf16(pa3,PK(3),o[d0],0,0,0);
    #undef PK
  }
}
template<int THRL,bool COMBINE> __device__ __forceinline__ void attn_unit128(int b,int qcol,int kcol,int vcol,int ocol,int qb,const bf16*Q,const bf16*__restrict__ K,const bf16*__restrict__ V,bf16*O,char*shm,const int wv,
    bf16*HBo,const float lam,const float*subg,const float osc,const bool pre,const bf16*Kn){
  int tid_=wv*64+lane_id_(); asm volatile("":"+v"(tid_)); const int tid=tid_,lane=tid&63,r32=lane&31,hi=lane>>5; const int wid=__builtin_amdgcn_readfirstlane(tid>>6);
  const long rowbase=(long)b*SEQ; const int q0=qb*QB;
  const bf16*Qw=Q+(rowbase+q0+wid*QBLK)*DM+qcol;
  const bf16*Kh=K+rowbase*DM+kcol,*Vh=V+rowbase*DM+vcol;
  const unsigned lds0=(unsigned)(uintptr_t)shm;
  float*wsf=(float*)(shm+LDS2_WS)+wid*64;
  const unsigned koff=(unsigned)(lane*DM+wid*8)*2u, voff=(unsigned)((16*(wid&3)+(lane>>2))*DM+(wid>>2)*32+(lane&3)*8)*2u;
  const unsigned kdst=lds0+LDS_K+wid*1024, vdst=lds0+LDS_V+wid*1024;
  #define DMA_K(t,slot) glds16s(Kh+(long)(t)*KVBLK*DM,koff,(unsigned)__builtin_amdgcn_readfirstlane(kdst+(slot)))
  #define DMA_V(t,slot) do{ glds16s(Vh+(long)(t)*KVBLK*DM,voff,(unsigned)__builtin_amdgcn_readfirstlane(vdst+2*(slot))); glds16s(Vh+(long)(t)*KVBLK*DM+64,voff,(unsigned)__builtin_amdgcn_readfirstlane(vdst+2*(slot)+8192)); }while(0)
  const int vb0=(int)(lds0+LDS_V)+((lane>>4)&1)*32+(lane&3)*8+(4*hi+((lane&15)>>2))*64;
  const char*Kbase=shm+LDS_K; bf16x8 kf[8];
  const lds_cptr shm3=(lds_cptr)shm; const lds_cptr kp0=shm3+LDS_K+hi*1024+r32*16; const lds_cptr vp0=shm3+LDS_V+((lane>>4)&1)*32+(lane&3)*8+(4*hi+((lane&15)>>2))*64;
  const int NT=(q0+QB)/KVBLK;
  #define DMA_KN(t,slot) glds16s(Kn+(long)(t)*KVBLK*DM,koff,(unsigned)__builtin_amdgcn_readfirstlane(kdst+(slot)))
  if(!pre){DMA_K(0,0);} DMA_V(0,0); if(!pre){DMA_K(1,SLOTB);}
  bf16x8 qr[4];
  #pragma unroll
  for(int d0=0;d0<4;++d0)qr[d0]=*reinterpret_cast<const bf16x8*>(&Qw[(long)r32*DM+d0*16+hi*8]);
  float mhat=0.f,l_reg=0.f;float z_=0.f; asm volatile("":"+v"(z_));
  f32x16 o[4]; f32x16 negm;
  _Pragma("unroll") for(int r=0;r<16;++r){o[0][r]=z_;o[1][r]=z_;o[2][r]=z_;o[3][r]=z_;negm[r]=z_;} asm volatile("":"+v"(negm));
  const int qrel=wid*QBLK+r32;
  #define CMASK(P0,P1,t) do{int jb_=(t)-(NT-4); if(jb_>=0)cmask(P0,P1,jb_,qrel,hi);}while(0)
  bool resc=false;
  #define START(P0,P1) do{ const float rm=rowmax(P0,P1); resc=false; \
    { const float dl=rm; mhat=fadd_s(mhat,dl); \
      _Pragma("unroll") for(int r=0;r<16;++r){P0[r]=fsub_s(P0[r],dl);P1[r]=fsub_s(P1[r],dl);} \
      _Pragma("unroll") for(int r=0;r<16;++r)negm[r]=-mhat; asm volatile("":"+v"(negm)); } \
    _Pragma("unroll") for(int r=0;r<16;++r)P0[r]=__builtin_amdgcn_exp2f(P0[r]); }while(0)
  #define RESC() do{ if(resc){ asm volatile("s_waitcnt lgkmcnt(0)":::"memory"); \
      _Pragma("unroll") for(int d_=0;d_<4;++d_) _Pragma("unroll") for(int r=0;r<16;++r)o[d_][r]*=wsf[crow(r,hi)]; } }while(0)
  f32x16 pA0,pA1,pB0,pB1;
  int sl_prev=0,sl_cur=0,sl_next=SLOTB;
  #define ROT() do{sl_prev=sl_cur;sl_cur=sl_next;sl_next=(sl_next==(NSLOT-1)*SLOTB)?0:sl_next+SLOTB;}while(0)
  if(!pre){DMA_K(2,2*SLOTB);}
  WAIT_BAR(3);
  qkt(pA0,pA1,Kbase,qr,negm,r32,hi);asm volatile("s_nop 15\n\ts_nop 7":"+v"(pA0),"+v"(pA1));CMASK(pA0,pA1,0);
  START(pA0,pA1);
  _Pragma("unroll") for(int r=0;r<16;++r)pA1[r]=__builtin_amdgcn_exp2f(pA1[r]);
  WAIT_BAR(0);
  DMA_K(3,0);DMA_V(1,SLOTB);
  ROT();
  kload8(kf,kp0+sl_cur);
  WAIT_BAR(3);
  s16x4 vlo[8],vhi[8]; u32x4 pw0,pw1,pw2,pw3;
  #define PKW(P,B) cvtpk_s(P[B],P[B+1])
  #define PAF(k) __builtin_bit_cast(bf16x8,pw##k)
  #define VFR(i) (bf16x8){vlo[i][0],vlo[i][1],vlo[i][2],vlo[i][3],vhi[i][0],vhi[i][1],vhi[i][2],vhi[i][3]}
  #define PIN(x) asm volatile("":"+v"(x))
  #define MX3(a,b,c) __builtin_fmaxf(__builtin_fmaxf((a),(b)),(c))
  #define GAPA(MF,A0,A1,A2,A3,W0,W1,PW) do{ MF; sacc+=A0; sacc+=A1; sacc+=A2; sacc+=A3; PIN(sacc); W0; W1; PIN(PW); SBAR(); }while(0)
  #define EX(v) __builtin_amdgcn_exp2f(v)
  #define GAPB(MF,X,B) do{ MF; X[B]=EX(X[B]); X[B+1]=EX(X[B+1]); PIN(X); SBAR(); }while(0)
  #define GAPC(MF,E0,E1,E2,XA,XB) do{ MF; E0=EX(E0); E1=EX(E1); E2=EX(E2); PIN(XA); PIN(XB); SBAR(); }while(0)
  #define VRD(f) do{ vlo[(f)&7]=vtr(vp_+(((f)&3)*4096+((f)>>2)*1024)); vhi[(f)&7]=vtr(vp_+(((f)&3)*4096+((f)>>2)*1024+512)); }while(0)
  #define KRD(G,j) do{ if(G){ kload2(kf,kp0+sl_next,j); SBAR(); } }while(0)
  #define PVM(f) o[(f)&3]=__builtin_amdgcn_mfma_f32_32x32x16_bf16(PAFN((f)>>2),VFR((f)&7),o[(f)&3],0,0,0)
  #define PAFN(k) ((k)==0?PAF(0):(k)==1?PAF(1):(k)==2?PAF(2):PAF(3))
  #define STEP(C0,C1,P0,P1,t,GK,GV,GL) do{ SBAR(); \
    const lds_cptr vp_=vp0+2*sl_prev; \
    float sacc=(P0[0]+P0[1]); \
    GAPA(C0=__builtin_amdgcn_mfma_f32_32x32x16_bf16(kf[0],qr[0],negm,0,0,0), P0[2],P0[3],P0[4],P0[5],     pw0[0]=PKW(P0,0), pw0[1]=PKW(P0,2), pw0); \
    GAPA(C1=__builtin_amdgcn_mfma_f32_32x32x16_bf16(kf[1],qr[0],negm,0,0,0), P0[6],P0[7],P0[8],P0[9],     pw0[2]=PKW(P0,4), pw0[3]=PKW(P0,6), pw0); \
    VRD(0); SBAR(); GAPA(C0=__builtin_amdgcn_mfma_f32_32x32x16_bf16(kf[2],qr[1],C0,0,0,0),   P0[10],P0[11],P0[12],P0[13], pw1[0]=PKW(P0,8), pw1[1]=PKW(P0,10), pw1); \
    VRD(1); SBAR(); GAPA(C1=__builtin_amdgcn_mfma_f32_32x32x16_bf16(kf[3],qr[1],C1,0,0,0),   P0[14],P0[15],P1[0],P1[1],   pw1[2]=PKW(P0,12),pw1[3]=PKW(P0,14), pw1); \
    VRD(2); SBAR(); GAPA(C0=__builtin_amdgcn_mfma_f32_32x32x16_bf16(kf[4],qr[2],C0,0,0,0),   P1[2],P1[3],P1[4],P1[5],     pw2[0]=PKW(P1,0), pw2[1]=PKW(P1,2), pw2); \
    VRD(3); SBAR(); GAPA(C1=__builtin_amdgcn_mfma_f32_32x32x16_bf16(kf[5],qr[2],C1,0,0,0),   P1[6],P1[7],P1[8],P1[9],     pw2[2]=PKW(P1,4), pw2[3]=PKW(P1,6), pw2); \
    VRD(4); SBAR(); GAPA(C0=__builtin_amdgcn_mfma_f32_32x32x16_bf16(kf[6],qr[3],C0,0,0,0),   P1[10],P1[11],P1[12],P1[13], pw3[0]=PKW(P1,8), pw3[1]=PKW(P1,10), pw3); \
    VRD(5); SBAR(); GAPA(C1=__builtin_amdgcn_mfma_f32_32x32x16_bf16(kf[7],qr[3],C1,0,0,0),   P1[14],P1[15],0.f,0.f,       pw3[2]=PKW(P1,12),pw3[3]=PKW(P1,14), pw3); \
    l_reg+=sacc; \
    if(GK){DMA_K((t)+3,sl_cur);} if(GV){DMA_V((t)+1,sl_next);} \
    CMASK(C0,C1,t); \
    SBAR();   \
    VRD(6);  SBAR(); PVM(0); SBAR(); \
    VRD(7);  SBAR(); PVM(1); SBAR(); \
    VRD(8);  SBAR(); PVM(2); SBAR(); \
    VRD(9);  SBAR(); PVM(3); SBAR(); \
    { float a=MX3(C0[0],C0[1],C1[0]),b=MX3(C0[2],C0[3],C1[1]); a=MX3(a,C1[2],C1[3]); \
      _Pragma("unroll") for(int r=4;r<16;r+=4){a=MX3(a,C0[r],C0[r+1]);b=MX3(b,C0[r+2],C0[r+3]);a=MX3(a,C1[r],C1[r+1]);b=MX3(b,C1[r+2],C1[r+3]);} \
      float rm=__builtin_fmaxf(a,b); { auto rr=__builtin_amdgcn_permlane32_swap(__float_as_uint(rm),__float_as_uint(rm),false,false); rm=__builtin_fmaxf(__uint_as_float(rr[0]),__uint_as_float(rr[1])); } \
      resc=false; \
      if(__builtin_expect(__any(rm>(float)THRL),0)){ const float dl=__builtin_fmaxf(rm,0.f); mhat+=dl; \
        _Pragma("unroll") for(int r=0;r<16;++r){C0[r]-=dl;C1[r]-=dl;} \
        _Pragma("unroll") for(int r=0;r<16;++r)negm[r]=-mhat; asm volatile("":"+v"(negm)); \
        const float f=__builtin_amdgcn_exp2f(-dl); l_reg*=f; if(hi==0)wsf[r32]=f; resc=true; } } \
    SBAR(); \
    VRD(10); SBAR(); GAPC(PVM(4),  C0[0],C0[1],C0[2],   C0,C0); \
    VRD(11); SBAR(); GAPC(PVM(5),  C0[3],C0[4],C0[5],   C0,C0); \
    VRD(12); SBAR(); GAPC(PVM(6),  C0[6],C0[7],C0[8],   C0,C0); \
    VRD(13); SBAR(); GAPC(PVM(7),  C0[9],C0[10],C0[11], C0,C0); \
    VRD(14); SBAR(); GAPC(PVM(8),  C0[12],C0[13],C0[14],C0,C0); \
    VRD(15); SBAR(); GAPC(PVM(9),  C0[15],C1[0],C1[1],  C0,C1); \
    GAPC(PVM(10), C1[2],C1[3],C1[4], C1,C1); \
    GAPC(PVM(11), C1[5],C1[6],C1[7], C1,C1); \
    KRD(GL,0); GAPB(PVM(12), C1,8); \
    KRD(GL,1); GAPB(PVM(13), C1,10); \
    KRD(GL,2); GAPB(PVM(14), C1,12); \
    KRD(GL,3); GAPB(PVM(15), C1,14); \
    }while(0)
  int t=1;
  #undef CMASK
  #define CMASK(P0,P1,t) do{}while(0)
  for(;t+5<NT;t+=2){
    STEP(pB0,pB1,pA0,pA1,t,true,true,true);     WAIT_BAR(3); RESC(); ROT();
    STEP(pA0,pA1,pB0,pB1,t+1,true,true,true);   WAIT_BAR(3); RESC(); ROT();
  }
  #undef CMASK
  #define CMASK(P0,P1,t) do{int jb_=(t)-(NT-4); if(jb_>=0)cmask(P0,P1,jb_,qrel,hi);}while(0)
  #define ENDW(tt) do{ if((tt)+3<NT){WAIT_BAR(3);} else if((tt)+2<NT){WAIT_BAR(2);} else {WAIT_BAR(0);} }while(0)
  for(;t+1<NT;t+=2){
    STEP(pB0,pB1,pA0,pA1,t,(t+3<NT),(t+1<NT),(t+1<NT));       ENDW(t);   RESC(); ROT();
    STEP(pA0,pA1,pB0,pB1,t+1,(t+4<NT),(t+2<NT),(t+2<NT));     ENDW(t+1); RESC(); ROT();
  }
  if(Kn){ DMA_KN(0,0); DMA_KN(1,SLOTB); DMA_KN(2,2*SLOTB); }
  STEP(pB0,pB1,pA0,pA1,NT-1,false,false,false); RESC();
  { float sacc=pB0[0]+pB0[1]; _Pragma("unroll") for(int r=2;r<16;++r)sacc+=pB0[r]; _Pragma("unroll") for(int r=0;r<16;++r)sacc+=pB1[r]; l_reg+=sacc;
    pw0=(u32x4){PKW(pB0,0),PKW(pB0,2),PKW(pB0,4),PKW(pB0,6)};pw1=(u32x4){PKW(pB0,8),PKW(pB0,10),PKW(pB0,12),PKW(pB0,14)};pw2=(u32x4){PKW(pB1,0),PKW(pB1,2),PKW(pB1,4),PKW(pB1,6)};pw3=(u32x4){PKW(pB1,8),PKW(pB1,10),PKW(pB1,12),PKW(pB1,14)};
    SBAR(); pv4(o,vb0+2*sl_cur,PAF(0),PAF(1),PAF(2),PAF(3)); }
  #undef PKW
  #undef PAF
  #undef VFR
  #undef PIN
  #undef MX3
  #undef GAPA
  #undef GAPB
  #undef GAPC
  #undef EX
  #undef VRD
  #undef KRD
  #undef STEP
  #undef PVM
  #undef PAFN
  #undef ENDW
  {auto rr=__builtin_amdgcn_permlane32_swap(__float_as_uint(l_reg),__float_as_uint(l_reg),false,false);l_reg=__uint_as_float(rr[0])+__uint_as_float(rr[1]);}
  if(hi==0)wsf[32+r32]=l_reg;asm volatile("s_waitcnt lgkmcnt(0)":::"memory");
  float rli[16];
  #pragma unroll
  for(int r=0;r<16;++r)rli[r]=__builtin_amdgcn_rcpf(wsf[32+crow(r,hi)]);
  bf16*Ow=O+(rowbase+q0+wid*QBLK)*DM+ocol;
  bf16*stg=(bf16*)(shm+LDS2_OST)+wid*2048;
  if constexpr(!COMBINE){
    #pragma unroll
    for(int hf=0;hf<2;++hf){
      #pragma unroll
      for(int r=0;r<16;++r){const int orow=crow(r,hi);
        #pragma unroll
        for(int d0=0;d0<2;++d0)stg[orow*64+d0*32+r32]=__float2bfloat16(o[2*hf+d0][r]*rli[r]);}
      asm volatile("s_waitcnt lgkmcnt(0)":::"memory");
      #pragma unroll
      for(int i=0;i<4;++i){const int row=i*8+(lane>>3),ch=lane&7; const u32x4 v=*(const u32x4*)(stg+row*64+ch*8); ATTN_STORE16(Ow+(long)row*DM+hf*64+ch*8,v);}
      asm volatile("s_waitcnt lgkmcnt(0)":::"memory"); }
  } else {
    const int ch=lane&7,rw=lane>>3;
    u32x4 v1[2][4];
    #pragma unroll
    for(int hf=0;hf<2;++hf)
      #pragma unroll
      for(int i=0;i<4;++i)v1[hf][i]=*(const u32x4*)(Ow+(long)(i*8+rw)*DM+hf*64+ch*8);
    float cv[2][4][8]; float ss[4]={0.f,0.f,0.f,0.f};
    #pragma unroll
    for(int hf=0;hf<2;++hf){
      #pragma unroll
      for(int r=0;r<16;++r){const int orow=crow(r,hi);
        #pragma unroll
        for(int d0=0;d0<2;++d0)stg[orow*64+d0*32+r32]=__float2bfloat16(o[2*hf+d0][r]*rli[r]);}
      asm volatile("s_waitcnt lgkmcnt(0)":::"memory");
      #pragma unroll
      for(int i=0;i<4;++i){ const u32x4 v2=*(const u32x4*)(stg+(i*8+rw)*64+ch*8);
        #pragma unroll
        for(int e=0;e<4;++e){ const unsigned a=v1[hf][i][e],c2=v2[e];
          const float c0=__uint_as_float(a<<16)-lam*__uint_as_float(c2<<16), c1=__uint_as_float(a&0xffff0000u)-lam*__uint_as_float(c2&0xffff0000u);
          cv[hf][i][2*e]=c0; cv[hf][i][2*e+1]=c1; ss[i]+=c0*c0+c1*c1; } }
      asm volatile("s_waitcnt lgkmcnt(0)":::"memory"); }
    float rs[4];
    #pragma unroll
    for(int i=0;i<4;++i){ float t=ss[i];
      t+=__int_as_float(__builtin_amdgcn_ds_swizzle(__float_as_int(t),(1<<10)|0x1f)); t+=__int_as_float(__builtin_amdgcn_ds_swizzle(__float_as_int(t),(2<<10)|0x1f)); t+=__int_as_float(__builtin_amdgcn_ds_swizzle(__float_as_int(t),(4<<10)|0x1f));
      rs[i]=__builtin_amdgcn_rsqf(t*(1.f/128.f)+1e-6f)*osc; }
    bf16*Hw=HBo+(rowbase+q0+wid*QBLK)*DM+ocol;
    #pragma unroll
    for(int hf=0;hf<2;++hf){ float g8[8];
      #pragma unroll
      for(int e=0;e<8;++e)g8[e]=subg[hf*64+ch*8+e];
      #pragma unroll
      for(int i=0;i<4;++i){ u32x4 w;
        #pragma unroll
        for(int e=0;e<4;++e)w[e]=cvtpk_s(cv[hf][i][2*e]*rs[i]*g8[2*e],cv[hf][i][2*e+1]*rs[i]*g8[2*e+1]);
        ATTN_STORE16(Hw+(long)(i*8+rw)*DM+hf*64+ch*8,w); } }
  }
  asm volatile("s_waitcnt lgkmcnt(0)\n\ts_barrier":::"memory");
  #undef DMA_K
  #undef DMA_KN
  #undef DMA_V
  #undef CMASK
  #undef START
  #undef RESC
  #undef ROT
}

typedef __attribute__((address_space(3))) volatile unsigned* lds_vu32;
__device__ __forceinline__ void smask(f32x16&p0,f32x16&p1,int jb,int qrel,int hi){
  const float NEG=-INFINITY; const int thr=qrel-64*jb-4*hi;
  #pragma unroll
  for(int r=0;r<16;++r){const int kc=(r&3)+8*(r>>2); if(kc>=thr)p0[r]=NEG; if(kc+32>=thr)p1[r]=NEG;}
}
typedef __attribute__((address_space(3))) u32x4* lds_v4p;
__device__ __forceinline__ void sb_item(int b,int h,int rb,const bf16*Q,const bf16*__restrict__ K,const bf16*__restrict__ V,bf16*O,char*shm,const int wv){
  int tid_=wv*64+lane_id_(); asm volatile("":"+v"(tid_)); const int tid=tid_,lane=tid&63,r32=lane&31,hi=lane>>5; const int wid=__builtin_amdgcn_readfirstlane(tid>>6);
  const long rowbase=(long)b*SEQ; const int r0=rb*QBLK;
  const bf16*Qw=Q+(rowbase+r0)*DM+h*D;
  const bf16*Kh=K+rowbase*DM+h*D,*Vh=V+rowbase*DM+h*D;
  char*wl=shm+wid*16384;
  const lds_cptr wl3=(lds_cptr)wl;
  const unsigned lds0=(unsigned)(uintptr_t)wl;
  const int vb=(int)lds0+8192+((lane>>4)&1)*32+(lane&3)*8+(4*hi+((lane&15)>>2))*64;
  const int lrow=lane>>3,lch=lane&7;
  const lds_v4p kw0=(lds_v4p)(wl3+lch*1024+((lrow^(2*lch))<<4)), kw1=(lds_v4p)(wl3+lch*1024+(((lrow|8)^(2*lch))<<4));
  const lds_v4p vw=(lds_v4p)(wl3+8192+(lch>>2)*4096+lrow*64+(lch&3)*16);
  const bf16*kbase=Kh+(long)lrow*DM+lch*8;
  const bf16*vbase=Vh+(long)lrow*DM+lch*8;
  int koff4[4];
  #pragma unroll
  for(int d0=0;d0<4;++d0)koff4[d0]=(2*d0+hi)*1024+((r32^(2*(2*d0+hi)))<<4);
  bf16x8 qr[4];
  #pragma unroll
  for(int d0=0;d0<4;++d0)qr[d0]=*reinterpret_cast<const bf16x8*>(&Qw[(long)r32*DM+d0*16+hi*8]);
  int t=(r0+QBLK-2)>>6;
  u32x4 ks[8],vs[8]; bf16x8 kf[8];
  #define SB_LD(tt) do{ _Pragma("unroll") for(int i=0;i<8;++i){ ks[i]=*reinterpret_cast<const u32x4*>(kbase+(long)(64*(tt)+8*i)*DM); vs[i]=*reinterpret_cast<const u32x4*>(vbase+(long)(64*(tt)+8*i)*DM); } }while(0)
  #define SB_ST() do{ _Pragma("unroll") for(int i=0;i<8;++i){ if(i&1) kw1[(i>>1)*16]=ks[i]; else kw0[(i>>1)*16]=ks[i]; vw[32*i]=vs[i]; } }while(0)
  #define SB_KF() do{ _Pragma("unroll") for(int d0=0;d0<4;++d0){ kf[2*d0]=*(const __attribute__((address_space(3))) bf16x8*)(wl3+koff4[d0]); kf[2*d0+1]=*(const __attribute__((address_space(3))) bf16x8*)(wl3+koff4[d0]+512); } }while(0)
  SB_LD(t); SB_ST();
  f32x16 o[2];o[0]=f32x16{};o[1]=f32x16{};
  float Cc=1.f; bool first=true;
  for(;;){
    const bool more=t>0; const int tn=more?t-1:0;
    SB_LD(tn);
    SB_KF();
    f32x16 p0,p1;
    #pragma unroll
    for(int d0=0;d0<4;++d0){
      if(d0==0){const f32x16 z=f32x16{};p0=__builtin_amdgcn_mfma_f32_32x32x16_bf16(kf[0],qr[0],z,0,0,0);p1=__builtin_amdgcn_mfma_f32_32x32x16_bf16(kf[1],qr[0],z,0,0,0);}
      else{p0=__builtin_amdgcn_mfma_f32_32x32x16_bf16(kf[2*d0],qr[d0],p0,0,0,0);p1=__builtin_amdgcn_mfma_f32_32x32x16_bf16(kf[2*d0+1],qr[d0],p1,0,0,0);}}
    if(first){ const float NEG=-INFINITY; const int thr=r0+r32-64*t-4*hi;
      #pragma unroll
      for(int r=0;r<16;++r){const int kc=(r&3)+8*(r>>2); if(kc>=thr)p0[r]=NEG; if(kc+32>=thr)p1[r]=NEG;} }
    f32x16 W0,W1;
    #pragma unroll
    for(int r=0;r<16;++r){
      const float e0=__builtin_amdgcn_exp2f(p0[r]),e1=__builtin_amdgcn_exp2f(p1[r]);
      const float w0=__builtin_amdgcn_rcpf(1.0f+e0),w1=__builtin_amdgcn_rcpf(1.0f+e1);
      W0[r]=w0;W1[r]=w1; }
    float own[8],oth[8],base[8];
    #pragma unroll
    for(int m=0;m<4;++m){ own[m]=(W0[4*m]*W0[4*m+1])*(W0[4*m+2]*W0[4*m+3]); own[4+m]=(W1[4*m]*W1[4*m+1])*(W1[4*m+2]*W1[4*m+3]); }
    #pragma unroll
    for(int m=0;m<8;++m){ auto rr=__builtin_amdgcn_permlane32_swap(__float_as_uint(own[m]),__float_as_uint(own[m]),false,false); oth[m]=__uint_as_float(hi?rr[0]:rr[1]); }
    float tot=Cc;
    #pragma unroll
    for(int m=7;m>=0;--m){ base[m]=hi?tot:tot*oth[m]; tot*=own[m]*oth[m]; }
    Cc=tot;
    #pragma unroll
    for(int m=0;m<4;++m){
      { const float s3=base[m],s2=s3*W0[4*m+3],s1=s2*W0[4*m+2],s0=s1*W0[4*m+1],sm=s0*W0[4*m+0];
        p0[4*m+0]=s0-sm; p0[4*m+1]=s1-s0; p0[4*m+2]=s2-s1; p0[4*m+3]=s3-s2; }
      { const float s3=base[4+m],s2=s3*W1[4*m+3],s1=s2*W1[4*m+2],s0=s1*W1[4*m+1],sm=s0*W1[4*m+0];
        p1[4*m+0]=s0-sm; p1[4*m+1]=s1-s0; p1[4*m+2]=s2-s1; p1[4*m+3]=s3-s2; } }
    #define PKW(P,B) cvtpk_s(P[B],P[B+1])
    u32x4 pw0=(u32x4){PKW(p0,0),PKW(p0,2),PKW(p0,4),PKW(p0,6)},pw1=(u32x4){PKW(p0,8),PKW(p0,10),PKW(p0,12),PKW(p0,14)},pw2=(u32x4){PKW(p1,0),PKW(p1,2),PKW(p1,4),PKW(p1,6)},pw3=(u32x4){PKW(p1,8),PKW(p1,10),PKW(p1,12),PKW(p1,14)};
    #undef PKW
    pv(o,vb,__builtin_bit_cast(bf16x8,pw0),__builtin_bit_cast(bf16x8,pw1),__builtin_bit_cast(bf16x8,pw2),__builtin_bit_cast(bf16x8,pw3));
    if(!more||__all(Cc==0.f))break;
    SB_ST();
    --t; first=false;
  }
  #undef SB_LD
  #undef SB_ST
  #undef SB_KF
  bf16*Ow=O+(rowbase+r0)*DM+h*D;
  { bf16*stg=(bf16*)wl;
    #pragma unroll
    for(int r=0;r<16;++r){const int orow=crow(r,hi);
      #pragma unroll
      for(int d0=0;d0<2;++d0)stg[orow*64+d0*32+r32]=__float2bfloat16(o[d0][r]);}
    asm volatile("s_waitcnt lgkmcnt(0)":::"memory");
    #pragma unroll
    for(int i=0;i<4;++i){const int row=i*8+(lane>>3),ch=lane&7; const u32x4 v=*(const u32x4*)(stg+row*64+ch*8); ATTN_STORE16(Ow+(long)row*DM+ch*8,v);} }
  asm volatile("s_waitcnt lgkmcnt(0)":::"memory");
}
constexpr int ATTN_LDS_BYTES=LDS2_BYTES;
template<int THRL> __device__ __forceinline__ void diff_attn_phase(char*lds,const bf16*Q,const bf16*K,const bf16*V,bf16*OA,bf16*HBo,const float lam,const float*subg,const float osc,int G,int vcu,const int wv){
  for(int i=0;;++i){ const int grp=(vcu>>3)+(G>>3)*(i>>2); if(grp>=BATCH*(NHEAD/2))break; const int s=vcu&7,ii=i&3; const int qb=(ii==0)?s:(ii==1)?15-s:(ii==2)?16+s:31-s;
    const int b=grp>>3,h=grp&7; const int vcol=h*128;
    attn_unit128<THRL,false>(b,(2*h)*64,(2*h)*64,vcol,vcol,qb,Q,K,V,OA,lds,wv,HBo,lam,subg,osc,false,nullptr);
    attn_unit128<THRL,true>(b,(2*h+1)*64,(2*h+1)*64,vcol,vcol,qb,Q,K,V,OA,lds,wv,HBo,lam,subg,osc,false,nullptr); }
}
__device__ __forceinline__ void sb_attn_phase(char*lds,const bf16*Q,const bf16*K,const bf16*V,bf16*O,int G,int vcu,const int wv){
  const int wid=wv;
  for(int i=0;;++i){ const int grp=(vcu>>3)+(G>>3)*(i>>2); if(grp>=BATCH*NHEAD)break; const int rb=(((i&3)*8+(vcu&7))*8+wid);
    sb_item(grp>>4,grp&15,rb,Q,K,V,O,lds,wv); }
}
#undef SBAR
#undef WAIT_BAR
}

constexpr int NWAVES = 8;
constexpr int BATCH = 4, T = 8192, D = 1024, M = BATCH * T, NQKV = 3 * D, NE = 32, FF = 512;
constexpr float NORM_EPS = 1e-6f;
constexpr float C2 = 0.125f * 1.4426950408889634f;
constexpr float LAM_INIT0 = 0.2f;

constexpr size_t MiB = 1u << 20;
constexpr size_t WS_CTL = 0, CTL_ZERO_BYTES = 64 * 1024;
constexpr size_t WS_MOD = 1 * MiB;
constexpr size_t WS_GATEW = 1 * MiB + 256 * 1024;
constexpr size_t WS_RFRAG = 1 * MiB + 512 * 1024;
constexpr size_t WS_WQKV = 2 * MiB, WS_WO = 14 * MiB, WS_W1 = 18 * MiB, WS_W2 = 146 * MiB;
constexpr size_t WS_HB = 210 * MiB;
constexpr size_t WS_Q = 274 * MiB, WS_K = 338 * MiB, WS_V = 402 * MiB, WS_OA = 466 * MiB;
constexpr size_t WS_Y2 = 274 * MiB;
constexpr size_t WS_HID = 402 * MiB;
constexpr size_t WS_LIST = 474 * MiB;
constexpr size_t WS_XR = 478 * MiB;
constexpr size_t WS_END = 542 * MiB;
constexpr int CW_TMO = 0, CW_CODE = 1, CW_BAR = 4096, CW_CNT = 8192;

constexpr int RING_OFF = 0, RING_BYTES = 135168;
constexpr int LDSCTL_OFF = RING_BYTES, MISC_OFF = LDSCTL_OFF + 320;
constexpr int TAB_CNT = LDSCTL_OFF + 512, TAB_PRE = LDSCTL_OFF + 640, TAB_BR = LDSCTL_OFF + 896, TAB_LCNT = LDSCTL_OFF + 1024, TAB_LBASE = LDSCTL_OFF + 1152;
constexpr int TAB_ASG_E = LDSCTL_OFF + 1280, TAB_ASG_S = LDSCTL_OFF + 2304, TAB_ASG_D = LDSCTL_OFF + 3328;
constexpr int LDS_BYTES = 147456;
static_assert(TAB_ASG_D + 1024 <= LDS_BYTES, "LDS map");
#define GAS __attribute__((address_space(1)))
#define LAS __attribute__((address_space(3)))
typedef unsigned short bf16;
typedef unsigned v4u __attribute__((ext_vector_type(4)));
typedef float f32x4 __attribute__((ext_vector_type(4)));
typedef short bf16x8 __attribute__((ext_vector_type(8)));
typedef GAS unsigned gu32;
typedef GAS unsigned long long gu64;
#define RLX_AGENT __ATOMIC_RELAXED, __HIP_MEMORY_SCOPE_AGENT
#define LDS_WAIT() asm volatile("s_waitcnt lgkmcnt(0)" ::: "memory")
#define VM_WAIT() asm volatile("s_waitcnt vmcnt(0)" ::: "memory")
__device__ __forceinline__ unsigned long long rt() { return __builtin_amdgcn_s_memrealtime(); }
__device__ __forceinline__ unsigned f2bf(float f) { unsigned u = __builtin_bit_cast(unsigned, f); return (u + 0x7fffu + ((u >> 16) & 1u)) >> 16; }
__device__ __forceinline__ unsigned pk2(float lo, float hi) { return f2bf(lo) | (f2bf(hi) << 16); }

#define XB_TMO      128
#define XB_XCNT(j)  (256  + 64 * (j))
#define XB_XSUB(j)  (1280 + 64 * (j))
#define XB_XGEN(j)  (2304 + 64 * (j))
#define XB_TOP      3328
#define XB_TOPGEN   3392
#define XCD_BAR_WORDS 3456
#define XB_SPIN_CAP (1u << 18)

__device__ __forceinline__ unsigned xb_ld(unsigned* p)              { return __hip_atomic_load(p, __ATOMIC_RELAXED, __HIP_MEMORY_SCOPE_AGENT); }
__device__ __forceinline__ unsigned xb_add(unsigned* p, unsigned v) { return __hip_atomic_fetch_add(p, v, __ATOMIC_RELAXED, __HIP_MEMORY_SCOPE_AGENT); }
__device__ __forceinline__ unsigned xb_xcc_id() { return (unsigned)__builtin_amdgcn_s_getreg((3 << 11) | 20) & 0xFu; }
#define XB_SPIN(cond, bar) do { unsigned _sp = 0; while (cond) { __builtin_amdgcn_s_sleep(1); \
    if ((++_sp & 255u) == 0u) { if (xb_ld(&(bar)[XB_TMO])) break; if (_sp > XB_SPIN_CAP) { atomicAdd(&(bar)[XB_TMO], 1u); break; } } } } while (0)

struct XcdBarrier {
    unsigned* bar; unsigned x; int wv;
    volatile LAS unsigned* st;
};

__device__ __forceinline__ XcdBarrier xcd_barrier_post(unsigned* bar, volatile LAS unsigned* st, int wv) {
    XcdBarrier b; b.bar = bar; b.x = xb_xcc_id(); b.st = st; b.wv = wv;
    if (threadIdx.x == 0) (void)xb_add(&bar[XB_XCNT(b.x)], 1u);
    return b;
}
__device__ __forceinline__ void xcd_barrier_complete(unsigned* bar, unsigned x, unsigned& nloc, unsigned& nx) {
    const unsigned G = gridDim.x * gridDim.y * gridDim.z;
    unsigned sum, cnt, mine, sp = 0u;
    for (;;) {
        sum = 0u; cnt = 0u; mine = 0u;
#pragma unroll
        for (unsigned j = 0; j < 16; ++j) { const unsigned c = xb_ld(&bar[XB_XCNT(j)]); sum += c; cnt += (c > 0u) ? 1u : 0u; mine = (j == x) ? c : mine; }
        if (sum == G) break;
        __builtin_amdgcn_s_sleep(1);
        if ((++sp & 255u) == 0u) { if (xb_ld(&bar[XB_TMO])) break; if (sp > XB_SPIN_CAP) { atomicAdd(&bar[XB_TMO], 1u); break; } }
    }
    nloc = mine > 0u ? mine : 1u; nx = cnt > 0u ? cnt : 1u;
}

__device__ __forceinline__ void xcd_barrier(const XcdBarrier& b) {
    asm volatile("s_waitcnt vmcnt(0)" ::: "memory");
    __syncthreads();
    if (b.wv == 0 && lane_id_() == 0) {
        unsigned* bar = b.bar; unsigned bx_ = b.x; asm volatile("" : "+s"(bx_));
        __builtin_amdgcn_s_waitcnt(0);
        unsigned nloc = b.st[0], nx = b.st[1];
        if (nloc == 0u) { xcd_barrier_complete(bar, bx_, nloc, nx); b.st[0] = nloc; b.st[1] = nx; }
        const unsigned old = xb_add(&bar[XB_XSUB(bx_)], 1u);
        const unsigned gen = old / nloc;
        if (old + 1u == (gen + 1u) * nloc) {
            __builtin_amdgcn_fence(__ATOMIC_RELEASE, "agent");
            asm volatile("s_waitcnt vmcnt(0)" ::: "memory");
            const unsigned og = xb_add(&bar[XB_TOP], 1u);
            const unsigned tg = og / nx;
            if (og + 1u == (tg + 1u) * nx) xb_add(&bar[XB_TOPGEN], 1u);
            else XB_SPIN(xb_ld(&bar[XB_TOPGEN]) == tg, bar);
            __builtin_amdgcn_fence(__ATOMIC_ACQUIRE, "agent");
            xb_add(&bar[XB_XGEN(bx_)], 1u);
            asm volatile("s_waitcnt vmcnt(0)" ::: "memory");
        } else {
            XB_SPIN(xb_ld(&bar[XB_XGEN(bx_)]) == gen, bar);
            __builtin_amdgcn_fence(__ATOMIC_ACQUIRE, "agent");
            asm volatile("s_waitcnt vmcnt(0)" ::: "memory");
        }
    }
    __syncthreads();
}

struct Args { const void* in[16]; float* out; unsigned char* ws; };
struct Frame {
    LAS unsigned char* lds;
    volatile LAS unsigned* MISC;
    gu32* ctl;
    int tid, lane, wave;
    int vcu, G;
    const __attribute__((address_space(4))) Args* a;
};
#define FIN(i)   ((const float*)F.a->in[i])
#define F_x FIN(0)
#define F_c FIN(1)
#define F_pos ((const int*)F.a->in[2])
#define F_w_ada FIN(3)
#define F_b_ada FIN(4)
#define F_norm_g FIN(5)
#define F_w_in FIN(6)
#define F_w_out FIN(7)
#define F_diff_lambda FIN(8)
#define F_subln_g FIN(9)
#define F_w_router FIN(10)
#define F_b_router FIN(11)
#define F_w_gate FIN(12)
#define F_w_up FIN(13)
#define F_w_down FIN(14)
#define F_final_g FIN(15)
#define F_out (F.a->out)
#define F_mod ((float*)(F.a->ws + WS_MOD))
#define F_gatew ((float*)(F.a->ws + WS_GATEW))
#define F_Wqkv_t ((bf16*)(F.a->ws + WS_WQKV))
#define F_Wo_t ((bf16*)(F.a->ws + WS_WO))
#define F_W1_t ((bf16*)(F.a->ws + WS_W1))
#define F_W2_t ((bf16*)(F.a->ws + WS_W2))
#define F_HB ((bf16*)(F.a->ws + WS_HB))
#define F_QB ((bf16*)(F.a->ws + WS_Q))
#define F_KB ((bf16*)(F.a->ws + WS_K))
#define F_VB ((bf16*)(F.a->ws + WS_V))
#define F_OA ((bf16*)(F.a->ws + WS_OA))
#define F_Y2 ((bf16*)(F.a->ws + WS_Y2))
#define F_HID ((bf16*)(F.a->ws + WS_HID))
#define F_list ((int*)(F.a->ws + WS_LIST))
#define F_XR ((bf16*)(F.a->ws + WS_XR))
#define F_RFRAG ((unsigned*)(F.a->ws + WS_RFRAG))
typedef unsigned long long u64;
template <int X> __device__ __forceinline__ float swz_xor(float v) { return __int_as_float(__builtin_amdgcn_ds_swizzle(__float_as_int(v), (X << 10) | 0x1f)); }
__device__ __forceinline__ float half_sum(float v) {
    v += swz_xor<1>(v); v += swz_xor<2>(v); v += swz_xor<4>(v); v += swz_xor<8>(v); v += swz_xor<16>(v); return v;
}
__device__ __forceinline__ float wave_sum(float v) {
    v = half_sum(v);
    const auto rr = __builtin_amdgcn_permlane32_swap(__float_as_uint(v), __float_as_uint(v), false, false);
    return __uint_as_float(rr[0]) + __uint_as_float(rr[1]);
}
__device__ __forceinline__ float bf_lo(unsigned w) { return __uint_as_float(w << 16); }
__device__ __forceinline__ float bf_hi(unsigned w) { return __uint_as_float(w & 0xffff0000u); }
__device__ __forceinline__ f32x4 bf4_to_f32(u64 w) { const unsigned lo = (unsigned)w, hi = (unsigned)(w >> 32); return (f32x4){bf_lo(lo), bf_hi(lo), bf_lo(hi), bf_hi(hi)}; }
__device__ __forceinline__ u64 f32_to_bf4(f32x4 v) { return (u64)pg8::cvt_pk_bf16(v.x, v.y) | ((u64)pg8::cvt_pk_bf16(v.z, v.w) << 32); }

__device__ __forceinline__ int rowmap(int mode, int n) {
    if (mode == 1) { if (n >= 2048) return n; const int d = n & 63; const int p = d < 8 ? 2 * d : (d < 16 ? 2 * (d - 8) + 1 : d); return (n & ~63) + p; }
    if (mode == 2) return 256 * (n >> 7) + (n & 127);
    if (mode == 3) return 256 * (n >> 7) + 128 + (n & 127);
    return n;
}
struct P0Item { const float* W; bf16* WT; int N, K, mode, k0, n0; };
__device__ __forceinline__ void p0_item_load(f32x4 (&w)[16], const P0Item& it, int lane) {
    const float* p = it.W + (size_t)(it.k0 + 16 * (lane >> 4)) * it.N + it.n0 + 4 * (lane & 15);
#pragma unroll
    for (int i = 0; i < 16; ++i) w[i] = *(const f32x4*)(p + (size_t)i * it.N);
}
__device__ __forceinline__ void p0_item_store(const f32x4 (&w)[16], const P0Item& it, int lane) {
    const int kg = lane >> 4, nc = lane & 15;
#pragma unroll
    for (int j = 0; j < 4; ++j) { bf16* rowp = it.WT + (size_t)rowmap(it.mode, it.n0 + 4 * nc + j) * it.K + it.k0 + 16 * kg;
#pragma unroll
        for (int c = 0; c < 2; ++c) { v4u o;
            o.x = pg8::cvt_pk_bf16(w[8 * c + 0][j], w[8 * c + 1][j]); o.y = pg8::cvt_pk_bf16(w[8 * c + 2][j], w[8 * c + 3][j]);
            o.z = pg8::cvt_pk_bf16(w[8 * c + 4][j], w[8 * c + 5][j]); o.w = pg8::cvt_pk_bf16(w[8 * c + 6][j], w[8 * c + 7][j]);
            *(GAS v4u*)(rowp + 8 * c) = o; } }
}
constexpr int P0_I_IN = (D / 64) * (NQKV / 64), P0_I_O = (D / 64) * (D / 64), P0_I_GU = (D / 64) * (FF / 64), P0_I_DN = (FF / 64) * (D / 64);
constexpr int P0_N_IN = 2 * P0_I_IN, P0_N_O = 2 * P0_I_O, P0_N_GU = 2 * NE * 2 * P0_I_GU, P0_N_DN = 2 * NE * P0_I_DN, P0_N_EARLY = P0_N_IN + P0_N_O, P0_N_ALL = P0_N_EARLY + P0_N_GU + P0_N_DN;
#define P0_DECODE(it_, X) do { int r = (it_); \
        if (r < P0_N_IN) { const int l = r / P0_I_IN, q = r % P0_I_IN; X.W = F_w_in + (size_t)l * D * NQKV; X.WT = F_Wqkv_t + (size_t)l * NQKV * D; X.N = NQKV; X.K = D; X.mode = (l == 0) ? 1 : 0; X.k0 = 64 * (q / (NQKV / 64)); X.n0 = 64 * (q % (NQKV / 64)); break; } r -= P0_N_IN; \
        if (r < P0_N_O) { const int l = r / P0_I_O, q = r % P0_I_O; X.W = F_w_out + (size_t)l * D * D; X.WT = F_Wo_t + (size_t)l * D * D; X.N = D; X.K = D; X.mode = 0; X.k0 = 64 * (q / (D / 64)); X.n0 = 64 * (q % (D / 64)); break; } r -= P0_N_O; \
        if (r < P0_N_GU) { const int mat = r / P0_I_GU, q = r % P0_I_GU, le = mat >> 1, gu = mat & 1; X.W = (gu ? F_w_up : F_w_gate) + (size_t)le * D * FF; X.WT = F_W1_t + (size_t)le * 2 * FF * D; X.N = FF; X.K = D; X.mode = 2 + gu; X.k0 = 64 * (q / (FF / 64)); X.n0 = 64 * (q % (FF / 64)); break; } r -= P0_N_GU; \
        { const int le = r / P0_I_DN, q = r % P0_I_DN; X.W = F_w_down + (size_t)le * FF * D; X.WT = F_W2_t + (size_t)le * D * FF; X.N = D; X.K = FF; X.mode = 0; X.k0 = 64 * (q / (D / 64)); X.n0 = 64 * (q % (D / 64)); } } while (0)
__device__ __forceinline__ void p0_copy(Frame& F, int it, const int lim) {
    const int NGW = F.G * NWAVES; int lane = lane_id_(); asm volatile("" : "+v"(lane));
    f32x4 wa[16], wb[16]; P0Item ia, ib;
    { const int c0 = it < lim ? it : lim - 1; P0_DECODE(c0, ia); p0_item_load(wa, ia, lane); }
    while (it < lim) {
        const int it1 = it + NGW, c1 = it1 < lim ? it1 : lim - 1;
        P0_DECODE(c1, ib); p0_item_load(wb, ib, lane);
        p0_item_store(wa, ia, lane);
        const int it2 = it1 + NGW, c2 = it2 < lim ? it2 : lim - 1;
        P0_DECODE(c2, ia); p0_item_load(wa, ia, lane);
        if (it1 < lim) p0_item_store(wb, ib, lane);
        it = it2;
    }
}
constexpr int P0_SLICE = 2;
__device__ __forceinline__ bool p0_slice_exists(const Frame& F, int slot) { return P0_N_EARLY + F.G * NWAVES * P0_SLICE * slot < P0_N_ALL; }
__device__ __forceinline__ void p0_slice(Frame& F, int slot) {
    const int NGW = F.G * NWAVES, first = P0_N_EARLY + NGW * P0_SLICE * slot, end = first + NGW * P0_SLICE, lim = end < P0_N_ALL ? end : P0_N_ALL;
    int lane = lane_id_(); asm volatile("" : "+v"(lane));
    const int i0 = first + F.vcu * NWAVES + F.wave, i1 = i0 + NGW;
    f32x4 wa[16], wb[16]; P0Item a, b;
    { const int q = i0 < lim ? i0 : lim - 1; P0_DECODE(q, a); } p0_item_load(wa, a, lane);
    { const int q = i1 < lim ? i1 : lim - 1; P0_DECODE(q, b); } p0_item_load(wb, b, lane);
    if (i0 < lim) p0_item_store(wa, a, lane);
    if (i1 < lim) p0_item_store(wb, b, lane);
}
__device__ __forceinline__ void p0_prologue(Frame& F) {
    {
        LAS float* sc = (LAS float*)(F.lds);
        LAS float* red = (LAS float*)(F.lds + 16384);
        for (int i = F.tid; i < BATCH * D; i += NWAVES * 64) { const float cv = F_c[i]; sc[i] = cv / (1.f + __expf(-cv)); }
        __syncthreads();
        const int kg = F.tid >> 5, cc = F.tid & 31;
        for (int task = blockIdx.x; task < 2 * 192; task += F.G) {
            const int l = task / 192, col0 = (task % 192) * 32;
            const float* W = F_w_ada + (size_t)l * D * 6144 + col0 + cc;
            float a0 = 0.f, a1 = 0.f, a2 = 0.f, a3 = 0.f; float wv[64];
#pragma unroll
            for (int i = 0; i < 64; ++i) wv[i] = W[(size_t)(kg * 64 + i) * 6144];
#pragma unroll
            for (int i = 0; i < 64; ++i) { const int k = kg * 64 + i; const float w = wv[i]; a0 += sc[k] * w; a1 += sc[1024 + k] * w; a2 += sc[2048 + k] * w; a3 += sc[3072 + k] * w; }
            red[(kg * 4 + 0) * 32 + cc] = a0; red[(kg * 4 + 1) * 32 + cc] = a1; red[(kg * 4 + 2) * 32 + cc] = a2; red[(kg * 4 + 3) * 32 + cc] = a3;
            __syncthreads();
            if (F.tid < 128) { const int b = F.tid >> 5; float s = F_b_ada[l * 6144 + col0 + cc];
#pragma unroll
                for (int g = 0; g < 16; ++g) s += red[(g * 4 + b) * 32 + cc];
                F_mod[(size_t)(l * 4 + b) * 6144 + col0 + cc] = s; }
            __syncthreads();
        }
    }
    if ((int)blockIdx.x >= F.G - 8) { const int ent = ((int)blockIdx.x - (F.G - 8)) * 512 + F.tid, w = ent >> 9, sx = (ent >> 6) & 7, ln = ent & 63, ei = ln & 31, kk = ln >> 5;
        v4u h4, l4;
#pragma unroll
        for (int jp = 0; jp < 4; ++jp) { const int k0 = 128 * w + 16 * sx + 8 * kk + 2 * jp; const float w0 = F_w_router[k0 * 32 + ei], w1 = F_w_router[(k0 + 1) * 32 + ei];
            const unsigned hp = pg8::cvt_pk_bf16(w0, w1); h4[jp] = hp; l4[jp] = pg8::cvt_pk_bf16(w0 - bf_lo(hp), w1 - bf_hi(hp)); }
        ((GAS v4u*)F_RFRAG)[ent] = h4; ((GAS v4u*)F_RFRAG)[4096 + ent] = l4; }
    p0_copy(F, F.vcu * NWAVES + F.wave, P0_N_EARLY);
}

struct RowRaw { f32x4 xf[4]; u64 xb[4], ya[4], yb[4]; float w0, w1; };
template <bool XBF, bool COMBINE> __device__ __forceinline__ void row_load(Frame& F, RowRaw& r, const float* xin, const int m) {
    if (COMBINE) { const pg8::f32x2 gw2 = *(const pg8::f32x2*)(F_gatew + 2 * m); r.w0 = gw2.x; r.w1 = gw2.y; }
    if (XBF) { const GAS u64* xr = (const GAS u64*)(F_XR + (size_t)m * D) + F.lane;
#pragma unroll
        for (int j = 0; j < 4; ++j) r.xb[j] = xr[64 * j]; }
    else { const GAS f32x4* xr = (const GAS f32x4*)(xin + (size_t)m * D) + F.lane;
#pragma unroll
        for (int j = 0; j < 4; ++j) r.xf[j] = xr[64 * j]; }
    if (COMBINE) { const GAS u64* ya = (const GAS u64*)(F_Y2 + (size_t)(2 * m) * D) + F.lane; const GAS u64* yb = ya + D / 4;
#pragma unroll
        for (int j = 0; j < 4; ++j) { r.ya[j] = ya[64 * j]; r.yb[j] = yb[64 * j]; } }
}
template <bool COMBINE> __device__ __forceinline__ void n1_phase(Frame& F, const int l, const float* xin, float* xout) {
    const int NGW = F.G * NWAVES, WPB = NGW / BATCH, gw = F.vcu * NWAVES + F.wave, b = gw / WPB, jw = gw - b * WPB;
    const float* ng = F_norm_g + (size_t)(l * 2 + 0) * D;
    const int mend = (b < BATCH && jw < T) ? (T - jw + WPB - 1) / WPB : 0;
#define ROWOF(k_) (b * T + jw + WPB * (k_))
    int m = 0;
    if (mend > 0) {
        f32x4 gs[4], sh[4], gm[4]; const float* mp = F_mod + (size_t)(l * 4 + b) * 6144;
#pragma unroll
        for (int j = 0; j < 4; ++j) { const int col = 4 * F.lane + 256 * j; const f32x4 g = *(const f32x4*)(ng + col), sc = *(const f32x4*)(mp + 1024 + col);
            gs[j] = g * (sc + 1.0f); sh[j] = *(const f32x4*)(mp + col);
            gm[j] = COMBINE ? *(const f32x4*)(F_mod + (size_t)((l - 1) * 4 + b) * 6144 + 5120 + col) : (f32x4){0.f, 0.f, 0.f, 0.f}; }
        auto process = [&](const RowRaw& cur, const int m) {
            f32x4 v[4];
#pragma unroll
            for (int j = 0; j < 4; ++j) v[j] = COMBINE ? bf4_to_f32(cur.xb[j]) : cur.xf[j];
            if (COMBINE) { GAS u64* xo = (GAS u64*)(F_XR + (size_t)m * D) + F.lane;
#pragma unroll
                for (int j = 0; j < 4; ++j) { const f32x4 fa = bf4_to_f32(cur.ya[j]), fb = bf4_to_f32(cur.yb[j]); v[j] = v[j] + gm[j] * (fa * cur.w0 + fb * cur.w1); const u64 xb = f32_to_bf4(v[j]); xo[64 * j] = xb; v[j] = bf4_to_f32(xb); } }
            float s2 = 0.f;
#pragma unroll
            for (int j = 0; j < 4; ++j) s2 += (v[j].x * v[j].x + v[j].y * v[j].y) + (v[j].z * v[j].z + v[j].w * v[j].w);
            const float rstd = __builtin_amdgcn_rsqf(wave_sum(s2) * (1.f / D) + NORM_EPS);
            GAS u64* o8 = (GAS u64*)(F_HB + (size_t)m * D) + F.lane;
#pragma unroll
            for (int j = 0; j < 4; ++j) o8[64 * j] = f32_to_bf4(v[j] * rstd * gs[j] + sh[j]);
        };
        RowRaw ra, rb; row_load<COMBINE, COMBINE>(F, ra, xin, ROWOF(m));
        while (m < mend) {
            row_load<COMBINE, COMBINE>(F, rb, xin, ROWOF((m + 1 < mend) ? m + 1 : m)); process(ra, ROWOF(m)); ++m;
            if (m >= mend) break;
            row_load<COMBINE, COMBINE>(F, ra, xin, ROWOF((m + 1 < mend) ? m + 1 : m)); process(rb, ROWOF(m)); ++m;
        }
    }
}
__device__ __forceinline__ void final_phase(Frame& F, const float* xin, float* xout) {
    const int NGW = F.G * NWAVES, WPB = NGW / BATCH, gw = F.vcu * NWAVES + F.wave, b = gw / WPB, jw = gw - b * WPB;
    f32x4 fg[4];
#pragma unroll
    for (int j = 0; j < 4; ++j) fg[j] = *(const f32x4*)(F_final_g + 4 * F.lane + 256 * j);
    const int mend = (b < BATCH && jw < T) ? (T - jw + WPB - 1) / WPB : 0;
    int m = 0;
    if (mend > 0) {
        f32x4 gm[4];
#pragma unroll
        for (int j = 0; j < 4; ++j) gm[j] = *(const f32x4*)(F_mod + (size_t)(1 * 4 + b) * 6144 + 5120 + 4 * F.lane + 256 * j);
        auto process = [&](const RowRaw& cur, const int m) {
            f32x4 v[4]; float s2 = 0.f;
#pragma unroll
            for (int j = 0; j < 4; ++j) { v[j] = bf4_to_f32(cur.xb[j]) + gm[j] * (bf4_to_f32(cur.ya[j]) * cur.w0 + bf4_to_f32(cur.yb[j]) * cur.w1); s2 += (v[j].x * v[j].x + v[j].y * v[j].y) + (v[j].z * v[j].z + v[j].w * v[j].w); }
            const float rstd = __builtin_amdgcn_rsqf(wave_sum(s2) * (1.f / D) + NORM_EPS);
            GAS f32x4* xo = (GAS f32x4*)(xout + (size_t)m * D) + F.lane;
#pragma unroll
            for (int j = 0; j < 4; ++j) xo[64 * j] = v[j] * rstd * fg[j];
        };
        RowRaw ra, rb; row_load<true, true>(F, ra, xin, ROWOF(m));
        while (m < mend) {
            row_load<true, true>(F, rb, xin, ROWOF((m + 1 < mend) ? m + 1 : m)); process(ra, ROWOF(m)); ++m;
            if (m >= mend) break;
            row_load<true, true>(F, ra, xin, ROWOF((m + 1 < mend) ? m + 1 : m)); process(rb, ROWOF(m)); ++m;
        }
    }
}
#undef ROWOF
__device__ __forceinline__ int crow_(int r, int hi) { return (r & 3) + 8 * (r >> 2) + 4 * hi; }
template <bool XBF, bool FUSED> __device__ __forceinline__ void n2_phase(Frame& F, const int l, const float* xin, const int cset) {
    typedef float f32x16 __attribute__((ext_vector_type(16)));
    LAS float* tileA = (LAS float*)F.lds;
    LAS float* part = (LAS float*)F.lds;
    LAS float* logit = (LAS float*)(F.lds + 65536);
    LAS int* lcnt = (LAS int*)(F.lds + TAB_LCNT); LAS int* lbase = (LAS int*)(F.lds + TAB_LBASE);
    LAS int* asg_e = (LAS int*)(F.lds + TAB_ASG_E); LAS int* asg_s = (LAS int*)(F.lds + TAB_ASG_S); LAS int* asg_d = (LAS int*)(F.lds + TAB_ASG_D);
    LAS float* br = (LAS float*)(F.lds + TAB_BR);
#ifndef SUBT
#define SUBT (-1)
#endif
    unsigned long long sacc_ = 0ull, st0_ = 0ull;
#define SUB_A(k) do { if (SUBT == (k) && l == 0) st0_ = rt(); } while (0)
#define SUB_B(k) do { if (SUBT == (k) && l == 0) sacc_ += rt() - st0_; } while (0)
    SUB_A(0);
    if (F.tid < 32) { lcnt[F.tid] = 0; br[F.tid] = F_b_router[F.tid]; }
    __syncthreads();
    gu32* gcnt = F.ctl + CW_CNT + 64 * cset;
    const float* ng = F_norm_g + (size_t)(l * 2 + 1) * D;
    const int ei = F.lane & 31, kk = F.lane >> 5;
    typedef short bf16x8_t __attribute__((ext_vector_type(8)));
    constexpr int NT32 = M / 32;
#define N2_TILE(n) (F.vcu * 4 + ((n) >> 2) * F.G * 4 + ((n) & 3))
#define N2_LOAD(tile_) do { _Pragma("unroll") for (int rr = 0; rr < 4; ++rr) { const size_t m_ = (size_t)((tile_) * 32 + 4 * F.wave + rr); \
        if (XBF) { const GAS u64* xr = (const GAS u64*)(F_XR + m_ * D) + F.lane; _Pragma("unroll") for (int j = 0; j < 4; ++j) v[rr][j] = bf4_to_f32(xr[64 * j]); } \
        else { const GAS f32x4* xr = (const GAS f32x4*)(xin + m_ * D) + F.lane; _Pragma("unroll") for (int j = 0; j < 4; ++j) v[rr][j] = xr[64 * j]; } } } while (0)
    f32x4 v[4][4];
    int n = 0, tile = N2_TILE(0); bool have = tile < NT32;
    if (have) N2_LOAD(tile);
    bf16x8_t whi[8], wlo[8];
    { const GAS v4u* wf = (const GAS v4u*)F_RFRAG + (F.wave * 8) * 64 + F.lane;
#pragma unroll
        for (int sx = 0; sx < 8; ++sx) { whi[sx] = __builtin_bit_cast(bf16x8_t, wf[sx * 64]); wlo[sx] = __builtin_bit_cast(bf16x8_t, wf[4096 + sx * 64]); } }
    SUB_B(0);
    while (have) {
        SUB_A(1); SUB_A(6);
        const int ti = n & 3, row0 = tile * 32, b = row0 / T; u64 mx[4][4];
        if constexpr (!FUSED) {
#pragma unroll
        for (int rr = 0; rr < 4; ++rr) { const GAS u64* mr = (const GAS u64*)(F_QB + (size_t)(row0 + 4 * F.wave + rr) * D) + F.lane;
#pragma unroll
            for (int j = 0; j < 4; ++j) mx[rr][j] = mr[64 * j]; } }
        if (SUBT == 6) { asm volatile("s_waitcnt vmcnt(0)" ::: "memory"); } SUB_B(6);
        const float* mp = F_mod + (size_t)(l * 4 + b) * 6144 + 3072;
        float s2[4] = {0.f, 0.f, 0.f, 0.f};
        if constexpr (FUSED) {
#pragma unroll
            for (int j = 0; j < 4; ++j)
#pragma unroll
                for (int rr = 0; rr < 4; ++rr) { const f32x4 x1 = v[rr][j]; s2[rr] += (x1.x * x1.x + x1.y * x1.y) + (x1.z * x1.z + x1.w * x1.w); }
        } else {
        f32x4 gav[4];
#pragma unroll
        for (int j = 0; j < 4; ++j) gav[j] = *(const f32x4*)(mp - 1024 + 4 * F.lane + 256 * j);
#pragma unroll
        for (int j = 0; j < 4; ++j) { const int col = 4 * F.lane + 256 * j; const f32x4 gaj = gav[j];
#pragma unroll
            for (int rr = 0; rr < 4; ++rr) { const u64 xb = f32_to_bf4(v[rr][j] + gaj * bf4_to_f32(mx[rr][j])); const f32x4 x1 = bf4_to_f32(xb); v[rr][j] = x1;
                *((GAS u64*)(F_XR + (size_t)(row0 + 4 * F.wave + rr) * D + col)) = xb; s2[rr] += (x1.x * x1.x + x1.y * x1.y) + (x1.z * x1.z + x1.w * x1.w); } }
        }
#pragma unroll
        for (int rr = 0; rr < 4; ++rr) s2[rr] = wave_sum(s2[rr]);
        float rstd[4];
#pragma unroll
        for (int rr = 0; rr < 4; ++rr) rstd[rr] = __builtin_amdgcn_rsqf(s2[rr] * (1.f / D) + NORM_EPS);
        f32x4 gsv[4], shv[4];
#pragma unroll
        for (int j = 0; j < 4; ++j) { const int col = 4 * F.lane + 256 * j; const f32x4 g = *(const f32x4*)(ng + col), sc = *(const f32x4*)(mp + 1024 + col); shv[j] = *(const f32x4*)(mp + col); gsv[j] = g * (sc + 1.0f); }
#pragma unroll
        for (int j = 0; j < 4; ++j) { const int col = 4 * F.lane + 256 * j; const f32x4 gsj = gsv[j], shj = shv[j];
#pragma unroll
            for (int rr = 0; rr < 4; ++rr) { const int r = 4 * F.wave + rr; const f32x4 h = v[rr][j] * rstd[rr] * gsj + shj;
                *((GAS u64*)(F_HB + (size_t)(row0 + r) * D + col)) = f32_to_bf4(h); *(LAS f32x4*)(tileA + r * 1028 + col) = h; } }
        const int n1 = n + 1, tile1 = N2_TILE(n1); const bool have1 = tile1 < NT32;
        if (have1) N2_LOAD(tile1);
        SUB_B(1); SUB_A(2);
        __syncthreads();
        f32x16 acc = {};
#pragma unroll
        for (int sx = 0; sx < 8; ++sx) { const LAS float* ap = tileA + ei * 1028 + 128 * F.wave + 16 * sx + 8 * kk; const f32x4 a0 = *(const LAS f32x4*)ap, a1 = *(const LAS f32x4*)(ap + 4);
            v4u h4, l4;
            h4[0] = pg8::cvt_pk_bf16(a0.x, a0.y); h4[1] = pg8::cvt_pk_bf16(a0.z, a0.w); h4[2] = pg8::cvt_pk_bf16(a1.x, a1.y); h4[3] = pg8::cvt_pk_bf16(a1.z, a1.w);
            l4[0] = pg8::cvt_pk_bf16(a0.x - bf_lo(h4[0]), a0.y - bf_hi(h4[0])); l4[1] = pg8::cvt_pk_bf16(a0.z - bf_lo(h4[1]), a0.w - bf_hi(h4[1]));
            l4[2] = pg8::cvt_pk_bf16(a1.x - bf_lo(h4[2]), a1.y - bf_hi(h4[2])); l4[3] = pg8::cvt_pk_bf16(a1.z - bf_lo(h4[3]), a1.w - bf_hi(h4[3]));
            const bf16x8_t ahi = __builtin_bit_cast(bf16x8_t, h4), alo = __builtin_bit_cast(bf16x8_t, l4);
            acc = __builtin_amdgcn_mfma_f32_32x32x16_bf16(ahi, whi[sx], acc, 0, 0, 0); acc = __builtin_amdgcn_mfma_f32_32x32x16_bf16(ahi, wlo[sx], acc, 0, 0, 0);
            acc = __builtin_amdgcn_mfma_f32_32x32x16_bf16(alo, whi[sx], acc, 0, 0, 0); }
        SUB_B(2); SUB_A(3);
        __syncthreads();
#pragma unroll
        for (int r = 0; r < 16; ++r) part[(F.wave * 32 + crow_(r, kk)) * 33 + ei] = acc[r];
        __syncthreads();
        { const int row = F.tid >> 4;
#pragma unroll
            for (int e2 = 0; e2 < 32; e2 += 16) { const int e = (F.tid & 15) + e2; float s = 0.f;
#pragma unroll
                for (int w = 0; w < 8; ++w) s += part[(w * 32 + row) * 33 + e];
                logit[row * 33 + e] = s; } }
        __syncthreads();
        SUB_B(3); SUB_A(4);
        if (F.tid < 128) { const int row = F.tid >> 2, g = F.tid & 3, m = row0 + row; const LAS float* lg = logit + row * 33 + 8 * g;
            float pe[8];
#pragma unroll
            for (int jj = 0; jj < 8; ++jj) pe[jj] = lg[jj];
            float mxl = pe[0];
#pragma unroll
            for (int jj = 1; jj < 8; ++jj) mxl = fmaxf(mxl, pe[jj]);
            mxl = fmaxf(mxl, swz_xor<1>(mxl)); mxl = fmaxf(mxl, swz_xor<2>(mxl));
            float sl = 0.f;
#pragma unroll
            for (int jj = 0; jj < 8; ++jj) { pe[jj] = __expf(pe[jj] - mxl); sl += pe[jj]; }
            sl += swz_xor<1>(sl); sl += swz_xor<2>(sl);
            const float inv = 1.0f / sl;
            float t1 = -INFINITY, t2 = -INFINITY, q1 = 0.f, q2 = 0.f; int i1 = 0, i2 = 0;
#pragma unroll
            for (int jj = 0; jj < 8; ++jj) { const float pr = pe[jj] * inv, sv = pr + br[8 * g + jj];
                if (sv > t1) { t2 = t1; i2 = i1; q2 = q1; t1 = sv; i1 = jj; q1 = pr; } else if (sv > t2) { t2 = sv; i2 = jj; q2 = pr; } }
            float best = t1 + t2; int gb = g;
            { const float ob = swz_xor<1>(best); const int og = __builtin_amdgcn_ds_swizzle(gb, (1 << 10) | 0x1f); if (ob > best || (ob == best && og < gb)) { best = ob; gb = og; } }
            { const float ob = swz_xor<2>(best); const int og = __builtin_amdgcn_ds_swizzle(gb, (2 << 10) | 0x1f); if (ob > best || (ob == best && og < gb)) { best = ob; gb = og; } }
            if (gb == g) { const int e1 = 8 * g + i1, e2 = 8 * g + i2; const float ig = 1.0f / (q1 + q2);
                const int a = (ti * 32 + row) * 2;
                asg_e[a] = e1; asg_s[a] = atomicAdd((int*)(lcnt + e1), 1); asg_d[a] = 2 * m; F_gatew[2 * m] = q1 * ig;
                asg_e[a + 1] = e2; asg_s[a + 1] = atomicAdd((int*)(lcnt + e2), 1); asg_d[a + 1] = 2 * m + 1; F_gatew[2 * m + 1] = q2 * ig; } }
        __syncthreads();
        SUB_B(4); SUB_A(5);
        if (ti == 3 || !have1) {
            if (F.tid < 32) { int te = F.tid; asm volatile("" : "+v"(te));
                const int cnum = lcnt[te]; lbase[te] = cnum ? (int)__hip_atomic_fetch_add(gcnt + te, (unsigned)cnum, RLX_AGENT) : 0; lcnt[te] = 0; }
            __syncthreads();
            if (F.tid < 64 * (ti + 1)) { const int e = asg_e[F.tid]; F_list[(size_t)e * M + lbase[e] + asg_s[F.tid]] = asg_d[F.tid]; }
            __syncthreads();
        }
        SUB_B(5);
        n = n1; tile = tile1; have = have1;
    }
    if (SUBT >= 0 && l == 0 && F.wave == 0 && lane_id_() == 0) { F.MISC[16] = (unsigned)sacc_; F.MISC[17] = (unsigned)(sacc_ >> 32); }
#undef N2_TILE
#undef N2_LOAD
}
__device__ __forceinline__ void load_counts(Frame& F, const int l) {
    LAS int* cnt = (LAS int*)(F.lds + TAB_CNT); LAS int* pre = (LAS int*)(F.lds + TAB_PRE);
    if (F.tid < 32) cnt[F.tid] = (int)__hip_atomic_load(F.ctl + CW_CNT + 64 * l + F.tid, RLX_AGENT);
    __syncthreads();
    if (F.tid == 0) { int s = 0; for (int e = 0; e < 32; ++e) { pre[e] = s; s += (cnt[e] + 255) >> 8; } pre[32] = s; }
    __syncthreads();
}

__global__ void __launch_bounds__(NWAVES * 64, 2) fwd_kernel(Args args) {
    extern __shared__ __attribute__((aligned(16))) unsigned char lds[];
    Frame F;
    F.lds = (LAS unsigned char*)lds;
    F.MISC = (volatile LAS unsigned*)(F.lds + MISC_OFF);
    F.tid = threadIdx.x; F.lane = F.tid & 63; F.wave = __builtin_amdgcn_readfirstlane(F.tid >> 6);
    F.G = gridDim.x; { const int bx = blockIdx.x; F.vcu = (F.G % 8 == 0) ? (bx % 8) * (F.G / 8) + bx / 8 : bx; }
    F.a = (const __attribute__((address_space(4))) Args*)__builtin_amdgcn_kernarg_segment_ptr(); (void)args; F.ctl = (gu32*)(F.a->ws + WS_CTL);
    for (int u = F.tid; u < (LDS_BYTES - LDSCTL_OFF) / 4; u += NWAVES * 64) ((LAS unsigned*)(F.lds + LDSCTL_OFF))[u] = 0u;
    __syncthreads();
    XcdBarrier bar = xcd_barrier_post((unsigned*)(F.ctl + CW_BAR), F.MISC + 8, F.wave);
#define GRID_BAR() xcd_barrier(bar)
#ifndef PH_MASK
#define PH_MASK 0xFFFFFFu
#endif
#ifndef DUP_MASK
#define DUP_MASK 0u
#endif
#ifndef STAMP_PH
#define STAMP_PH (-1)
#endif
#ifndef STAMP_BLK
#define STAMP_BLK 0
#endif
#ifndef STAMP_AMP
#define STAMP_AMP 4
#endif
    unsigned long long tsa_ = 0ull, tsb_ = 0ull; if (STAMP_PH == 100) tsa_ = rt();
#define PH(k) if constexpr (((PH_MASK) >> (k)) & 1u) _Pragma("unroll") for (int rep_ = 0, phk_ = (k); rep_ < 1 + (int)(((DUP_MASK) >> (k)) & 1u); ++rep_)
#define PHASE_END() do { if (STAMP_PH >= 200 && phk_ == STAMP_PH - 200) tsb_ = rt(); } while (0)
#define PHASE_BEGIN() do { if (STAMP_PH >= 400 && phk_ == STAMP_PH - 400) tsa_ = __builtin_amdgcn_s_memtime(); if (STAMP_PH >= 400 && phk_ > STAMP_PH - 400 && tsb_ == 0ull) tsb_ = __builtin_amdgcn_s_memtime(); if (STAMP_PH >= 0 && (phk_ == STAMP_PH || phk_ == STAMP_PH - 200)) tsa_ = rt(); if (STAMP_PH >= 0 && STAMP_PH < 100 && phk_ > STAMP_PH && tsb_ == 0ull) tsb_ = rt(); int t_ = F.wave * 64 + lane_id_(); asm volatile("" : "+v"(t_)); F.tid = t_; F.lane = t_ & 63; unsigned long long ka_ = (unsigned long long)F.a; asm volatile("" : "+s"(ka_)); F.a = (const __attribute__((address_space(4))) Args*)ka_; } while (0)
    const LAS int* tcnt = (const LAS int*)(F.lds + TAB_CNT); const LAS int* tpre = (const LAS int*)(F.lds + TAB_PRE);

    PH(0) { if (rep_) GRID_BAR(); PHASE_BEGIN();
    p0_prologue(F);
    PHASE_END(); }
    GRID_BAR();
    PH(1) { if (rep_) GRID_BAR(); PHASE_BEGIN();

    n1_phase<false>(F, 0, F_x, nullptr);
    PHASE_END(); }
    GRID_BAR();
    PH(2) { if (rep_) GRID_BAR(); PHASE_BEGIN();
    {
        pg8::StaticOrder S; S.init(F_HB, F_Wqkv_t, M, NQKV, D, F.G, (int)blockIdx.x);
        pg8::EpiQKV E{F_QB, (size_t)(WS_K - WS_Q) / 2, C2, F_pos, 1};
        pg8::gemm_phase<pg8::EpiQKV, pg8::StaticOrder, true, false>(F.lds + RING_OFF, D, S, E, F.wave);
    }
    PHASE_END(); }
    GRID_BAR();
    PH(3) { if (rep_) GRID_BAR(); PHASE_BEGIN();
    {
        const float s1 = wave_sum(F_diff_lambda[F.lane] * F_diff_lambda[64 + F.lane]), s2l = wave_sum(F_diff_lambda[128 + F.lane] * F_diff_lambda[192 + F.lane]);
        const float lam = __expf(s1) - __expf(s2l) + LAM_INIT0;
        constexpr unsigned long long ORD = 0x2d8778c91b27d82dull;
        constexpr unsigned SKP = 0x63502655u;
        int slot = 0; const int s = F.vcu & 7; const unsigned ord = (unsigned)(ORD >> (8 * s)) & 0xffu, skp = (SKP >> (4 * s)) & 0xfu;
#ifdef SLT
        unsigned long long slt_acc_ = 0ull;
#define SLT_A() const unsigned long long t0_ = rt()
#define SLT_B() slt_acc_ += rt() - t0_
#else
#define SLT_A() do {} while (0)
#define SLT_B() do {} while (0)
#endif
        for (int i = 0;; ++i) { const int grp = (F.vcu >> 3) + (F.G >> 3) * (i >> 2); if (grp >= BATCH * 8) break; const int ii = i & 3, pi = (ord >> (2 * ii)) & 3u;
            const int qb = (pi == 0) ? s : (pi == 1) ? 15 - s : (pi == 2) ? 16 + s : 31 - s;
            const int b = grp >> 3, h = grp & 7, vcol = h * 128;
            const int grpn = (F.vcu >> 3) + (F.G >> 3) * ((i + 1) >> 2);
            const attn_body::bf16* Kn0 = (const attn_body::bf16*)F_KB + (size_t)b * T * D + (2 * h + 1) * 64;
            const attn_body::bf16* Kn1 = (grpn < BATCH * 8) ? (const attn_body::bf16*)F_KB + (size_t)(grpn >> 3) * T * D + (2 * (grpn & 7)) * 64 : nullptr;
            attn_body::attn_unit128<8, false>(b, (2 * h) * 64, (2 * h) * 64, vcol, vcol, qb, (const attn_body::bf16*)F_QB, (const attn_body::bf16*)F_KB, (const attn_body::bf16*)F_VB, (attn_body::bf16*)F_out, (char*)lds + RING_OFF, F.wave, (attn_body::bf16*)F_HB, lam, F_subln_g, 1.0f - LAM_INIT0, i > 0, Kn0);
            if ((unsigned)(2 * ii) != skp && p0_slice_exists(F, slot)) { SLT_A(); p0_slice(F, slot); ++slot; SLT_B(); }
            attn_body::attn_unit128<8, true>(b, (2 * h + 1) * 64, (2 * h + 1) * 64, vcol, vcol, qb, (const attn_body::bf16*)F_QB, (const attn_body::bf16*)F_KB, (const attn_body::bf16*)F_VB, (attn_body::bf16*)F_out, (char*)lds + RING_OFF, F.wave, (attn_body::bf16*)F_HB, lam, F_subln_g, 1.0f - LAM_INIT0, true, Kn1);
            if (ii < 3 && (unsigned)(2 * ii + 1) != skp && p0_slice_exists(F, slot)) { SLT_A(); p0_slice(F, slot); ++slot; SLT_B(); } }
        for (; p0_slice_exists(F, slot); ++slot) p0_slice(F, slot);
#ifdef SLT
        if (F.wave == 0 && lane_id_() == 0) { F.MISC[16] = (unsigned)slt_acc_; F.MISC[17] = (unsigned)(slt_acc_ >> 32); }
#endif
#undef SLT_A
#undef SLT_B
    }
    PHASE_END(); }
    GRID_BAR();
    PH(5) { if (rep_) GRID_BAR(); PHASE_BEGIN();
    {
        pg8::StaticOrder S; S.init(F_HB, F_Wo_t, M, D, D, F.G, (int)blockIdx.x);
        pg8::EpiPlain E{F_QB, D};
        pg8::gemm_phase<pg8::EpiPlain, pg8::StaticOrder, true, false>(F.lds + RING_OFF, D, S, E, F.wave);
    }
    PHASE_END(); }
    GRID_BAR();
    PH(6) { if (rep_) GRID_BAR(); PHASE_BEGIN();
    n2_phase<false, false>(F, 0, F_x, rep_ ? 2 : 0);
    PHASE_END(); }
    GRID_BAR();
    PH(7) { if (rep_) GRID_BAR(); PHASE_BEGIN();
    load_counts(F, 0);
    {
        pg8::GroupedOrder<4, true> S{tcnt, tpre, F.G, F.vcu, D, M, (const char*)F_HB, (const char*)F_W1_t, (size_t)2 * FF * D * 2, F_list};
        pg8::EpiSwiGLU E{F_HID};
        pg8::gemm_phase<pg8::EpiSwiGLU, pg8::GroupedOrder<4, true>, true, true>(F.lds + RING_OFF, D, S, E, F.wave);
    }
    PHASE_END(); }
    GRID_BAR();
    PH(8) { if (rep_) GRID_BAR(); PHASE_BEGIN();
    {
        pg8::GroupedOrder<4, false> S{tcnt, tpre, F.G, F.vcu, FF, M, (const char*)F_HID, (const char*)F_W2_t, (size_t)D * FF * 2, F_list};
        pg8::EpiDown E{F_Y2, F_list, tcnt, M};
        pg8::gemm_phase<pg8::EpiDown, pg8::GroupedOrder<4, false>, true, false>(F.lds + RING_OFF, FF, S, E, F.wave);
    }
    PHASE_END(); }
    GRID_BAR();
    PH(9) { if (rep_) GRID_BAR(); PHASE_BEGIN();

    n1_phase<true>(F, 1, nullptr, nullptr);
    PHASE_END(); }
    GRID_BAR();
    PH(10) { if (rep_) GRID_BAR(); PHASE_BEGIN();
    {
        pg8::StaticOrder S; S.init(F_HB, F_Wqkv_t + (size_t)NQKV * D, M, NQKV, D, F.G, (int)blockIdx.x);
        pg8::EpiQKV E{F_QB, (size_t)(WS_K - WS_Q) / 2, C2, F_pos, 0};
        pg8::gemm_phase<pg8::EpiQKV, pg8::StaticOrder, true, false>(F.lds + RING_OFF, D, S, E, F.wave);
    }
    PHASE_END(); }
    GRID_BAR();
    PH(11) { if (rep_) GRID_BAR(); PHASE_BEGIN();
    attn_body::sb_attn_phase((char*)lds + RING_OFF, (const attn_body::bf16*)F_QB, (const attn_body::bf16*)F_KB, (const attn_body::bf16*)F_VB, (attn_body::bf16*)F_out, F.G, F.vcu, F.wave);
    PHASE_END(); }
    GRID_BAR();
    PH(12) { if (rep_) GRID_BAR(); PHASE_BEGIN();
    {
        pg8::StaticOrder S; S.init((const bf16*)F_out, F_Wo_t + (size_t)D * D, M, D, D, F.G, (int)blockIdx.x);
        pg8::EpiResid<false> E{(pg8::bf16_t*)F_XR, nullptr, F_mod + (size_t)(1 * 4) * 6144 + 2048, T};
        pg8::gemm_phase<pg8::EpiResid<false>, pg8::StaticOrder, true, false>(F.lds + RING_OFF, D, S, E, F.wave);
    }
    PHASE_END(); }
    GRID_BAR();
    PH(13) { if (rep_) GRID_BAR(); PHASE_BEGIN();
    n2_phase<true, true>(F, 1, nullptr, rep_ ? 3 : 1);
    PHASE_END(); }
    GRID_BAR();
    PH(14) { if (rep_) GRID_BAR(); PHASE_BEGIN();
    load_counts(F, 1);
    {
        pg8::GroupedOrder<4, true> S{tcnt, tpre, F.G, F.vcu, D, M, (const char*)F_HB, (const char*)(F_W1_t + (size_t)NE * 2 * FF * D), (size_t)2 * FF * D * 2, F_list};
        pg8::EpiSwiGLU E{F_HID};
        pg8::gemm_phase<pg8::EpiSwiGLU, pg8::GroupedOrder<4, true>, true, true>(F.lds + RING_OFF, D, S, E, F.wave);
    }
    PHASE_END(); }
    GRID_BAR();
    PH(15) { if (rep_) GRID_BAR(); PHASE_BEGIN();
    {
        pg8::GroupedOrder<4, false> S{tcnt, tpre, F.G, F.vcu, FF, M, (const char*)F_HID, (const char*)(F_W2_t + (size_t)NE * D * FF), (size_t)D * FF * 2, F_list};
        pg8::EpiDown E{F_Y2, F_list, tcnt, M};
        pg8::gemm_phase<pg8::EpiDown, pg8::GroupedOrder<4, false>, true, false>(F.lds + RING_OFF, FF, S, E, F.wave);
    }
    PHASE_END(); }
    GRID_BAR();
    PH(16) { if (rep_) GRID_BAR(); PHASE_BEGIN();
    final_phase(F, nullptr, F_out);

    }
    if (STAMP_PH >= 0 && blockIdx.x == STAMP_BLK && F.wave == 0 && lane_id_() == 0) { const unsigned long long tend = rt(); if (STAMP_PH == 16 || STAMP_PH == 100) tsb_ = tend; if (STAMP_PH == 300) { tsa_ = 0ull; tsb_ = (unsigned long long)F.MISC[16] | ((unsigned long long)F.MISC[17] << 32); }
        const unsigned long long need = (STAMP_PH >= 400) ? (unsigned long long)STAMP_AMP * (tsb_ - tsa_) / 24ull : (unsigned long long)STAMP_AMP * (tsb_ - tsa_);     while (rt() - tend < need) __builtin_amdgcn_s_sleep(8); }
#undef GRID_BAR
}

extern "C" void kernel_launch(void* const* d_in, const int* in_sizes, int n_in, void* d_out, int out_size, void* d_ws, size_t ws_size, hipStream_t stream) {
    static int grid = 0;
    if (grid == 0) {
        if (n_in != 16 || in_sizes[0] != M * D || out_size != M * D || ws_size < WS_END) { fprintf(stderr, "kernel_launch: built for 16 inputs, x and out of %d floats, >= %zu bytes of workspace; got n_in %d, in0 %d, out %d, ws %zu; nothing launched\n", M * D, (size_t)WS_END, n_in, n_in > 0 ? in_sizes[0] : -1, out_size, ws_size); grid = -1; return; }
        int dev = 0, cus = 0, per_cu = 0;
        if (hipGetDevice(&dev) != hipSuccess || hipDeviceGetAttribute(&cus, hipDeviceAttributeMultiprocessorCount, dev) != hipSuccess) { fprintf(stderr, "kernel_launch: hipGetDevice / hipDeviceGetAttribute failed\n"); grid = -1; return; }
        if (hipFuncSetAttribute((const void*)fwd_kernel, hipFuncAttributeMaxDynamicSharedMemorySize, LDS_BYTES) != hipSuccess) { fprintf(stderr, "kernel_launch: hipFuncSetAttribute failed\n"); grid = -1; return; }
        if (hipOccupancyMaxActiveBlocksPerMultiprocessor(&per_cu, (const void*)fwd_kernel, NWAVES * 64, LDS_BYTES) != hipSuccess || per_cu < 1) { fprintf(stderr, "kernel_launch: occupancy query reports %d workgroups per CU\n", per_cu); }
        (void)hipGetLastError();
        grid = cus;
        if (grid > 256) grid = 256;
        grid -= grid % 8;
    }
    if (grid <= 0) return;
    if (hipMemsetAsync((char*)d_ws + WS_CTL, 0, CTL_ZERO_BYTES, stream) != hipSuccess) { fprintf(stderr, "kernel_launch: hipMemsetAsync failed\n"); return; }
    Args a{};
    for (int i = 0; i < 16; ++i) a.in[i] = d_in[i];
    a.out = (float*)d_out; a.ws = (unsigned char*)d_ws;
    hipLaunchKernelGGL(fwd_kernel, dim3(grid), dim3(NWAVES * 64), LDS_BYTES, stream, a);
    const hipError_t le = hipPeekAtLastError();
    if (le != hipSuccess) fprintf(stderr, "kernel_launch: launch failed: %s\n", hipGetErrorName(le));
}
```
